# Optimizing an MI355X kernel written in HIP

```python
import jax, jax.numpy as jnp
from jax import lax
import numpy as np

D_MODEL = 1024
BATCH = 16
SEQ = 2048
DEPTH = 1

CONV_CH = 512
CONV_WIDTH = 31
NSA_HEADS = 8
NSA_KV_GROUPS = 2
HEAD_DIM = 64
NSA_Q_PER_G = NSA_HEADS // NSA_KV_GROUPS
NSA_WIDTH = NSA_HEADS * HEAD_DIM
MIX_WIDTH = CONV_CH + NSA_WIDTH
KV_W = NSA_KV_GROUPS * HEAD_DIM
IN_COLS = 2 * CONV_CH + NSA_WIDTH + 6 * KV_W + 3 * NSA_HEADS
ROT_DIM = HEAD_DIM // 4
ROT_HALF = ROT_DIM // 2
ROPE_THETA = 500000.0
CMP_LEN = 32
CMP_STRIDE = 16
CMP_HIDDEN = 128
SEL_BLK = 64
SEL_TOPN = 16
SEL_QCHUNK = 64
WINDOW = 512
WIN_QBLK = 128
N_EXPERTS = 32
TOP_K = 4
D_FF = 1024
SWIGLU_ALPHA = 1.702
SWIGLU_LIMIT = 7.0
MOE_BLOCK = 128
NORM_EPS = 1e-5
NEG_INF = -1e30
FORCE_SCORE = 1e9

kernel_name = "hybrid_conv_nsa_moe_adaln"


def rmsnorm(x, g):
    xf = x.astype(jnp.float32)
    y = xf * lax.rsqrt(jnp.mean(xf * xf, axis=-1, keepdims=True) + NORM_EPS)
    return (y * g.astype(jnp.float32)).astype(x.dtype)


def layernorm(x, g, b):
    xf = x.astype(jnp.float32)
    mu = jnp.mean(xf, axis=-1, keepdims=True)
    var = jnp.mean(jnp.square(xf - mu), axis=-1, keepdims=True)
    y = (xf - mu) * lax.rsqrt(var + NORM_EPS)
    return (y * g.astype(jnp.float32) + b.astype(jnp.float32)).astype(x.dtype)


def rope_tables(S):
    inv = ROPE_THETA ** (-jnp.arange(0, ROT_DIM, 2, dtype=jnp.float32) / ROT_DIM)
    ang = jnp.arange(S, dtype=jnp.float32)[:, None] * inv[None, :]
    return jnp.cos(ang)[:, None, :], jnp.sin(ang)[:, None, :]


def partial_rope(x, cos, sin):
    xr = x[..., :ROT_DIM].astype(jnp.float32)
    x1, x2 = xr[..., :ROT_HALF], xr[..., ROT_HALF:]
    rot = jnp.concatenate([x1 * cos - x2 * sin, x2 * cos + x1 * sin], axis=-1)
    return jnp.concatenate([rot.astype(x.dtype), x[..., ROT_DIM:]], axis=-1)


def conv_module(a, gate, conv_w, conv_b, ln_g, ln_b):
    u = a * jax.nn.sigmoid(gate)
    y = lax.conv_general_dilated(
        u, conv_w.reshape(CONV_WIDTH, 1, CONV_CH).astype(u.dtype),
        window_strides=(1,), padding=[(CONV_WIDTH - 1, 0)],
        dimension_numbers=('NWC', 'WIO', 'NWC'), feature_group_count=CONV_CH)
    y = y + conv_b
    return jax.nn.silu(layernorm(y, ln_g, ln_b))


def compress_blocks(x, cidx, pe, w1, w2):
    B = x.shape[0]
    blk = x[:, cidx] + pe[:, None, :]
    blk = blk.transpose(0, 1, 3, 2, 4).reshape(B, cidx.shape[0], NSA_KV_GROUPS, CMP_LEN * HEAD_DIM)
    return jax.nn.silu(blk @ w1) @ w2


def nsa_mixer(q, k_cmp, v_cmp, k_slc, v_slc, k_win, v_win, gates, pe_k, pe_v, ck_w1, ck_w2, cv_w1, cv_w2):
    B, S = q.shape[0], q.shape[1]
    scale = HEAD_DIM ** -0.5
    t = jnp.arange(S)

    n_cmp = (S - CMP_LEN) // CMP_STRIDE + 1
    cstart = jnp.arange(n_cmp) * CMP_STRIDE
    cidx = cstart[:, None] + jnp.arange(CMP_LEN)[None, :]
    kc = compress_blocks(k_cmp, cidx, pe_k, ck_w1, ck_w2)
    vc = compress_blocks(v_cmp, cidx, pe_v, cv_w1, cv_w2)
    s_c = jnp.einsum('bsgnd,bcgd->bgnsc', q, kc).astype(jnp.float32) * scale
    m_c = (cstart + CMP_LEN - 1)[None, :] <= t[:, None]
    p_c = jax.nn.softmax(jnp.where(m_c, s_c, NEG_INF), axis=-1) * m_c
    o_cmp = jnp.einsum('bgnsc,bcgd->bsgnd', p_c.astype(vc.dtype), vc)

    n_sel = S // SEL_BLK
    jstart = jnp.arange(n_sel) * SEL_BLK
    overlap = ((cstart[:, None] <= jstart[None, :] + SEL_BLK - 1)
               & (cstart[:, None] + CMP_LEN - 1 >= jstart[None, :])).astype(jnp.float32)
    imp = jnp.einsum('bgnsc,cj->bgsj', p_c, overlap)
    jb = jnp.arange(n_sel)[None, :]
    cur = (t // SEL_BLK)[:, None]
    valid = jstart[None, :] <= t[:, None]
    forced = (jb == 0) | (jb == cur) | (jb == cur - 1)
    score = jnp.where(valid, jnp.where(forced, FORCE_SCORE, imp), NEG_INF)
    n_top = min(SEL_TOPN, n_sel)
    _, sel_idx = lax.top_k(score, n_top)

    kblk = k_slc.reshape(B, n_sel, SEL_BLK, NSA_KV_GROUPS, HEAD_DIM).transpose(0, 3, 1, 2, 4)
    vblk = v_slc.reshape(B, n_sel, SEL_BLK, NSA_KV_GROUPS, HEAD_DIM).transpose(0, 3, 1, 2, 4)
    n_ch = S // SEL_QCHUNK
    q_ch = q.reshape(B, n_ch, SEL_QCHUNK, NSA_KV_GROUPS, NSA_Q_PER_G, HEAD_DIM).transpose(1, 0, 2, 3, 4, 5)
    idx_ch = sel_idx.reshape(B, NSA_KV_GROUPS, n_ch, SEL_QCHUNK, n_top).transpose(2, 0, 1, 3, 4)
    t_ch = t.reshape(n_ch, SEL_QCHUNK)
    bi = jnp.arange(B)[:, None, None, None]
    gi = jnp.arange(NSA_KV_GROUPS)[None, :, None, None]
    in_blk = jnp.arange(SEL_BLK)

    def sel_chunk(args):
        qc, ic, tc = args
        kg = kblk[bi, gi, ic]
        vg = vblk[bi, gi, ic]
        s = jnp.einsum('bqgnd,bgqkld->bgnqkl', qc, kg).astype(jnp.float32) * scale
        kpos = ic[..., None] * SEL_BLK + in_blk
        mask = kpos <= tc[None, None, :, None, None]
        s = jnp.where(mask[:, :, None], s, NEG_INF)
        sh = s.shape
        p = jax.nn.softmax(s.reshape(sh[0], sh[1], sh[2], sh[3], -1), axis=-1).reshape(sh)
        return jnp.einsum('bgnqkl,bgqkld->bqgnd', p.astype(vg.dtype), vg)

    o_slc = lax.map(sel_chunk, (q_ch, idx_ch, t_ch))
    o_slc = o_slc.transpose(1, 0, 2, 3, 4, 5).reshape(B, S, NSA_KV_GROUPS, NSA_Q_PER_G, HEAD_DIM)

    n_qb = S // WIN_QBLK
    kp = jnp.pad(k_win, ((0, 0), (WINDOW, 0), (0, 0), (0, 0)))
    vp = jnp.pad(v_win, ((0, 0), (WINDOW, 0), (0, 0), (0, 0)))
    widx = jnp.arange(n_qb)[:, None] * WIN_QBLK + jnp.arange(WINDOW + WIN_QBLK)[None, :]
    kw = kp[:, widx]
    vw = vp[:, widx]
    qw = q.reshape(B, n_qb, WIN_QBLK, NSA_KV_GROUPS, NSA_Q_PER_G, HEAD_DIM)
    s_w = jnp.einsum('biqgnd,bikgd->bignqk', qw, kw).astype(jnp.float32) * scale
    tq = jnp.arange(n_qb)[:, None] * WIN_QBLK + jnp.arange(WIN_QBLK)[None, :]
    pk = widx - WINDOW
    rel = tq[:, :, None] - pk[:, None, :]
    m_w = (rel >= 0) & (rel < WINDOW) & (pk[:, None, :] >= 0)
    p_w = jax.nn.softmax(jnp.where(m_w[None, :, None, None], s_w, NEG_INF), axis=-1)
    o_win = jnp.einsum('bignqk,bikgd->biqgnd', p_w.astype(vw.dtype), vw)
    o_win = o_win.reshape(B, S, NSA_KV_GROUPS, NSA_Q_PER_G, HEAD_DIM)

    o = gates[..., 0:1] * o_cmp + gates[..., 1:2] * o_slc + gates[..., 2:3] * o_win
    return o.reshape(B, S, NSA_WIDTH)


def moe(h, w_router, b_router, w_gate, b_gate, w_up, b_up, w_down, b_down):
    B, S, D = h.shape
    T = B * S
    xf = h.reshape(T, D)
    logits = xf.astype(jnp.float32) @ w_router.astype(jnp.float32) + b_router.astype(jnp.float32)
    top_val, top_idx = lax.top_k(logits, TOP_K)
    gates = jax.nn.softmax(top_val, axis=-1).astype(h.dtype)

    A = T * TOP_K
    flat_e = top_idx.reshape(A)
    order = jnp.argsort(flat_e)
    sorted_e = flat_e[order]
    sorted_tok = order // TOP_K
    counts = jnp.bincount(flat_e, length=N_EXPERTS)
    starts = jnp.cumsum(counts) - counts
    padded = (counts + MOE_BLOCK - 1) // MOE_BLOCK * MOE_BLOCK
    pends = jnp.cumsum(padded)
    pstarts = pends - padded
    dest = pstarts[sorted_e] + (jnp.arange(A) - starts[sorted_e])
    P = ((A + N_EXPERTS * MOE_BLOCK + MOE_BLOCK - 1) // MOE_BLOCK) * MOE_BLOCK
    NB = P // MOE_BLOCK
    buf_tok = jnp.full((P,), T, dtype=jnp.int32).at[dest].set(sorted_tok.astype(jnp.int32))
    xpad = jnp.concatenate([xf, jnp.zeros((1, D), xf.dtype)], axis=0)
    xbuf = xpad[buf_tok].reshape(NB, MOE_BLOCK, D)
    block_e = jnp.minimum(jnp.searchsorted(pends, jnp.arange(NB) * MOE_BLOCK, side='right'), N_EXPERTS - 1)

    def expert_block(args):
        xb, e = args
        g = xb @ w_gate[e] + b_gate[e]
        u = xb @ w_up[e] + b_up[e]
        g = jnp.minimum(g, SWIGLU_LIMIT)
        u = jnp.clip(u, -SWIGLU_LIMIT, SWIGLU_LIMIT)
        act = g * jax.nn.sigmoid(SWIGLU_ALPHA * g) * (u + 1.0)
        return act @ w_down[e] + b_down[e]

    ybuf = lax.map(expert_block, (xbuf, block_e)).reshape(P, D)
    y_assign = jnp.zeros((A, D), ybuf.dtype).at[order].set(ybuf[dest])
    y = jnp.einsum('tkd,tk->td', y_assign.reshape(T, TOP_K, D), gates)
    return y.reshape(B, S, D)


def setup_inputs(seed: int = 0) -> dict:
    key = jax.random.key(seed)
    ks = jax.random.split(key, 32)
    L, D, E, F = DEPTH, D_MODEL, N_EXPERTS, D_FF
    nrm = lambda k, shape, fan_in: jax.random.normal(k, shape, jnp.float32) * (fan_in ** -0.5)
    gain = lambda k, shape: 1.0 + 0.02 * jax.random.normal(k, shape, jnp.float32)
    small = lambda k, shape: 0.01 * jax.random.normal(k, shape, jnp.float32)
    return {
        "x": jax.random.normal(ks[0], (BATCH, SEQ, D), jnp.float32),
        "c": jax.random.normal(ks[1], (BATCH, D), jnp.float32),
        "norm1_g": gain(ks[2], (L, D)),
        "norm2_g": gain(ks[3], (L, D)),
        "w_ada": 0.5 * nrm(ks[4], (L, D, 6 * D), D),
        "b_ada": small(ks[5], (L, 6 * D)),
        "w_in": nrm(ks[6], (L, D, IN_COLS), D),
        "conv_w": nrm(ks[7], (L, CONV_WIDTH, CONV_CH), CONV_WIDTH),
        "conv_b": small(ks[8], (L, CONV_CH)),
        "conv_ln_g": gain(ks[9], (L, CONV_CH)),
        "conv_ln_b": small(ks[10], (L, CONV_CH)),
        "cmp_pe_k": 0.1 * jax.random.normal(ks[11], (L, CMP_LEN, HEAD_DIM), jnp.float32),
        "cmp_pe_v": 0.1 * jax.random.normal(ks[12], (L, CMP_LEN, HEAD_DIM), jnp.float32),
        "cmp_k_w1": nrm(ks[13], (L, CMP_LEN * HEAD_DIM, CMP_HIDDEN), CMP_LEN * HEAD_DIM),
        "cmp_k_w2": nrm(ks[14], (L, CMP_HIDDEN, HEAD_DIM), CMP_HIDDEN),
        "cmp_v_w1": nrm(ks[15], (L, CMP_LEN * HEAD_DIM, CMP_HIDDEN), CMP_LEN * HEAD_DIM),
        "cmp_v_w2": nrm(ks[16], (L, CMP_HIDDEN, HEAD_DIM), CMP_HIDDEN),
        "out_norm_conv": gain(ks[17], (L, CONV_CH)),
        "out_norm_nsa": gain(ks[18], (L, NSA_WIDTH)),
        "w_out": nrm(ks[19], (L, MIX_WIDTH, D), MIX_WIDTH),
        "w_router": nrm(ks[20], (L, D, E), D),
        "b_router": small(ks[21], (L, E)),
        "w_gate": nrm(ks[22], (L, E, D, F), D),
        "b_gate": small(ks[23], (L, E, F)),
        "w_up": nrm(ks[24], (L, E, D, F), D),
        "b_up": small(ks[25], (L, E, F)),
        "w_down": nrm(ks[26], (L, E, F, D), F),
        "b_down": small(ks[27], (L, E, D)),
        "final_norm_g": gain(ks[28], (D,)),
    }


def reference(x, c, norm1_g, norm2_g, w_ada, b_ada, w_in, conv_w, conv_b, conv_ln_g, conv_ln_b,
              cmp_pe_k, cmp_pe_v, cmp_k_w1, cmp_k_w2, cmp_v_w1, cmp_v_w2, out_norm_conv, out_norm_nsa,
              w_out, w_router, b_router, w_gate, b_gate, w_up, b_up, w_down, b_down, final_norm_g):
    B, S, _ = x.shape
    cos, sin = rope_tables(S)
    c_act = jax.nn.silu(c)
    split_pts = [int(v) for v in np.cumsum([CONV_CH, CONV_CH, NSA_WIDTH, KV_W, KV_W, KV_W, KV_W, KV_W, KV_W])]
    G, NQ, HD = NSA_KV_GROUPS, NSA_Q_PER_G, HEAD_DIM
    for l in range(DEPTH):
        mod = c_act @ w_ada[l] + b_ada[l]
        sh1, sc1, gt1, sh2, sc2, gt2 = jnp.split(mod, 6, axis=-1)

        h = rmsnorm(x, norm1_g[l]) * (1.0 + sc1[:, None, :]) + sh1[:, None, :]
        proj = h @ w_in[l]
        a_c, g_c, q, kc, vc, ks_, vs_, kw, vw, gl = jnp.split(proj, split_pts, axis=-1)

        conv_out = conv_module(a_c, g_c, conv_w[l], conv_b[l], conv_ln_g[l], conv_ln_b[l])

        q = partial_rope(q.reshape(B, S, NSA_HEADS, HD), cos, sin).reshape(B, S, G, NQ, HD)
        kc = partial_rope(kc.reshape(B, S, G, HD), cos, sin)
        ks_ = partial_rope(ks_.reshape(B, S, G, HD), cos, sin)
        kw = partial_rope(kw.reshape(B, S, G, HD), cos, sin)
        vc = vc.reshape(B, S, G, HD)
        vs_ = vs_.reshape(B, S, G, HD)
        vw = vw.reshape(B, S, G, HD)
        br_gates = jax.nn.sigmoid(gl).reshape(B, S, G, NQ, 3)
        nsa_out = nsa_mixer(q, kc, vc, ks_, vs_, kw, vw, br_gates,
                            cmp_pe_k[l], cmp_pe_v[l], cmp_k_w1[l], cmp_k_w2[l], cmp_v_w1[l], cmp_v_w2[l])

        mixed = jnp.concatenate([rmsnorm(conv_out, out_norm_conv[l]),
                                 rmsnorm(nsa_out, out_norm_nsa[l])], axis=-1)
        x = x + gt1[:, None, :] * (mixed @ w_out[l])

        h2 = rmsnorm(x, norm2_g[l]) * (1.0 + sc2[:, None, :]) + sh2[:, None, :]
        x = x + gt2[:, None, :] * moe(h2, w_router[l], b_router[l], w_gate[l], b_gate[l],
                                      w_up[l], b_up[l], w_down[l], b_down[l])
    return rmsnorm(x, final_norm_g)
```

```cpp
#include <hip/hip_runtime.h>
#include <hip/hip_cooperative_groups.h>
#include <cstdio>
#include <cstdint>
namespace cg = cooperative_groups;

#define LAS __attribute__((address_space(3)))
typedef unsigned short bf16_t;
typedef short bf16x8 __attribute__((ext_vector_type(8)));
typedef float f32x4 __attribute__((ext_vector_type(4)));
typedef float f32x2 __attribute__((ext_vector_type(2)));
typedef unsigned u32x4 __attribute__((ext_vector_type(4)));
typedef unsigned u32x2 __attribute__((ext_vector_type(2)));

constexpr int T_TOK = 32768, DM = 1024, NB = 16, SEQ = 2048;
constexpr int IN_COLS = 2328, IN_PAD = 2560;
constexpr int NCMP = 127;
constexpr int NEXP = 32, TOPK = 4, DFF = 1024;
constexpr int CHUNK_TOK = 16384, CHUNK_ROWS = 65536, MAXTILES = 288;
constexpr float NORM_EPS = 1e-5f;
constexpr int NTHR = 512;
constexpr size_t LDS_BYTES = 140 * 1024;

constexpr size_t MiB = 1024 * 1024;
constexpr size_t WS_BOOK = 0;
constexpr size_t WS_WGU  = 16 * MiB;
constexpr size_t WS_D1   = WS_WGU + 128 * MiB;
constexpr size_t WS_E    = WS_D1 + 64 * MiB;
constexpr size_t WS_H2   = WS_E;
constexpr size_t WS_ACT  = WS_E + 64 * MiB;
constexpr size_t WS_YBUF = WS_E + 192 * MiB;
constexpr size_t WS_TOTAL = WS_E + 320 * MiB;
constexpr size_t WS_H    = WS_E;
constexpr size_t WS_MIX  = WS_E;
constexpr size_t WS_U    = WS_E + 64 * MiB;
constexpr size_t WS_Q    = WS_E + 96 * MiB;
constexpr size_t WS_KV   = WS_E + 128 * MiB;
constexpr size_t WS_GATES= WS_E + 176 * MiB;
constexpr size_t WS_OC   = WS_E + 180 * MiB;
constexpr size_t WS_OW   = WS_E + 212 * MiB;
constexpr size_t WS_OS   = WS_E + 244 * MiB;
constexpr size_t BK_MOD    = 0;
constexpr size_t BK_ROPE   = 512 * 1024;
constexpr size_t BK_CB1    = BK_ROPE + 128 * 1024;
constexpr size_t BK_HIST   = BK_CB1 + 1024;
constexpr size_t BK_NT     = BK_HIST + 512;
constexpr size_t BK_TILES  = BK_NT + 256;
constexpr size_t BK_TOPI   = 1 * MiB;
constexpr size_t BK_TOPG   = BK_TOPI + 512 * 1024;
constexpr size_t BK_SLOTOF = BK_TOPG + 512 * 1024;
constexpr size_t BK_ROWTOK = BK_SLOTOF + 512 * 1024;
constexpr size_t BK_SEL    = BK_ROWTOK + 512 * 1024;
constexpr size_t BK_KCMP   = BK_SEL + 256 * 1024;
constexpr size_t BK_VCMP   = BK_KCMP + 512 * 1024;
constexpr size_t BK_END    = BK_VCMP + 512 * 1024;
static_assert(BK_END <= 16 * MiB, "book");
constexpr size_t DO_WIN  = 0;
constexpr size_t DO_WOUT = 5 * MiB;
constexpr size_t DO_CK1  = 7 * MiB;
constexpr size_t DO_CV1  = DO_CK1 + 512 * 1024;
constexpr size_t DO_CK2  = DO_CV1 + 512 * 1024;
constexpr size_t DO_CV2  = DO_CK2 + 16 * 1024;
constexpr size_t DO_WD   = 64 * MiB;

struct Params {
  const float *x, *c, *norm1_g, *norm2_g, *w_ada, *b_ada, *w_in, *conv_w, *conv_b, *conv_ln_g, *conv_ln_b,
      *cmp_pe_k, *cmp_pe_v, *cmp_k_w1, *cmp_k_w2, *cmp_v_w1, *cmp_v_w2, *out_norm_conv, *out_norm_nsa, *w_out,
      *w_router, *b_router, *w_gate, *b_gate, *w_up, *b_up, *w_down, *b_down, *final_norm_g;
  float* out;
  unsigned char* ws;
  int ph0, ph1;
};

__device__ __forceinline__ bf16_t f2bf(float f) { unsigned u = __float_as_uint(f); u += 0x7FFFu + ((u >> 16) & 1u); return (bf16_t)(u >> 16); }
__device__ __forceinline__ float bf2f(bf16_t b) { return __uint_as_float(((unsigned)b) << 16); }
__device__ __forceinline__ unsigned pack2(float lo, float hi) { return (unsigned)f2bf(lo) | ((unsigned)f2bf(hi) << 16); }
__device__ __forceinline__ float wave_sum(float v) {
#pragma unroll
  for (int o = 32; o > 0; o >>= 1) v += __shfl_xor(v, o);
  return v;
}
__device__ __forceinline__ float sigmoidf_(float v) { return 1.0f / (1.0f + __expf(-v)); }
__device__ __forceinline__ int ld_i32(const int* p) { return __hip_atomic_load(p, __ATOMIC_RELAXED, __HIP_MEMORY_SCOPE_AGENT); }

__device__ __forceinline__ int my_tid() { int t = threadIdx.x; asm volatile("" : "+v"(t)); return t; }
__device__ __forceinline__ float block_sum(float v, LAS float* red) {
  v = wave_sum(v);
  const int tq = my_tid(); const int wid = tq >> 6, lane = tq & 63;
  __syncthreads();
  if (lane == 0) red[wid] = v;
  __syncthreads();
  float s = 0.f;
#pragma unroll
  for (int i = 0; i < 8; ++i) s += red[i];
  return s;
}

__device__ __forceinline__ void conv_tile(const float* __restrict__ src, int ldn, int nvalid, int k0, int n0,
                                          bf16_t* dst, int ldk, int drow0, LAS float* tile) {
  const int tid = my_tid();
#pragma unroll
  for (int r = 0; r < 8; ++r) {
    const int k = r * 8 + (tid >> 6), n = tid & 63;
    tile[k * 65 + n] = (n0 + n < nvalid) ? src[(size_t)(k0 + k) * ldn + n0 + n] : 0.f;
  }
  __syncthreads();
  {
    const int n = tid >> 3, ks = tid & 7;
    u32x4 w;
    w.x = pack2(tile[(ks * 8 + 0) * 65 + n], tile[(ks * 8 + 1) * 65 + n]);
    w.y = pack2(tile[(ks * 8 + 2) * 65 + n], tile[(ks * 8 + 3) * 65 + n]);
    w.z = pack2(tile[(ks * 8 + 4) * 65 + n], tile[(ks * 8 + 5) * 65 + n]);
    w.w = pack2(tile[(ks * 8 + 6) * 65 + n], tile[(ks * 8 + 7) * 65 + n]);
    *(u32x4*)(dst + (size_t)(drow0 + n) * ldk + k0 + ks * 8) = w;
  }
  __syncthreads();
}

__device__ __forceinline__ void sincos_acc(float angf, float& c, float& s) {
  const double TWO_PI = 6.283185307179586476925286766559;
  double a = (double)angf;
  double k = __builtin_rint(a / TWO_PI);
  double r = a - k * TWO_PI;
  double r2 = r * r;
  double ts = r, tc = 1.0, ss = r, cs = 1.0;
#pragma unroll 1
  for (int n = 1; n <= 14; ++n) {
    tc = -tc * r2 / (double)((2 * n - 1) * (2 * n));
    ts = -ts * r2 / (double)((2 * n) * (2 * n + 1));
    cs += tc; ss += ts;
  }
  c = (float)cs; s = (float)ss;
}

__device__ __forceinline__ void phase0(const Params& p, LAS unsigned char* smem) {
  const int tid = my_tid();
  unsigned char* ws = p.ws;
  unsigned char* dout = (unsigned char*)p.out;
  LAS float* fl = (LAS float*)smem;
  constexpr int I_MOD = 96, I_ROPE = 8, I_CB1 = 2, I_WIN = 640, I_WOUT = 256, I_C1 = 128, I_C2 = 4, I_GU = 16384, I_WD = 8192;
  constexpr int O_ROPE = I_MOD, O_CB1 = O_ROPE + I_ROPE, O_WIN = O_CB1 + I_CB1, O_WOUT = O_WIN + I_WIN, O_C1 = O_WOUT + I_WOUT,
                O_C2 = O_C1 + I_C1, O_GU = O_C2 + I_C2, O_WD = O_GU + I_GU, O_END = O_WD + I_WD;
  if (blockIdx.x == 0 && tid < 130) {
    ((int*)(ws + WS_BOOK + BK_HIST))[tid] = 0;
  }
  for (int it = blockIdx.x; it < O_END; it += gridDim.x) {
    if (it < O_ROPE) {
      const int n0 = it * 64;
      LAS float* cact = fl;
      LAS float* red = fl + 16384;
      for (int i = tid; i < 16384; i += NTHR) { const float v = p.c[i]; cact[i] = v / (1.0f + __expf(-v)); }
      __syncthreads();
      const int nl = tid & 63, kp = tid >> 6;
      float acc[16];
#pragma unroll
      for (int b = 0; b < 16; ++b) acc[b] = 0.f;
      for (int k = kp * 128; k < kp * 128 + 128; ++k) {
        const float w = p.w_ada[(size_t)k * 6144 + n0 + nl];
#pragma unroll
        for (int b = 0; b < 16; ++b) acc[b] += cact[b * 1024 + k] * w;
      }
#pragma unroll
      for (int b = 0; b < 16; ++b) red[(kp * 16 + b) * 64 + nl] = acc[b];
      __syncthreads();
      float* MOD = (float*)(ws + WS_BOOK + BK_MOD);
      for (int o = tid; o < 1024; o += NTHR) {
        const int b = o >> 6, n2 = o & 63;
        float s = p.b_ada[n0 + n2];
#pragma unroll
        for (int k2 = 0; k2 < 8; ++k2) s += red[(k2 * 16 + b) * 64 + n2];
        MOD[b * 6144 + n0 + n2] = s;
      }
      __syncthreads();
    } else if (it < O_CB1) {
      const int j = it - O_ROPE;
      float* ROPE = (float*)(ws + WS_BOOK + BK_ROPE);
      const float invf[8] = {1.0f, 0.1939227432012558f, 0.03760603070259094f, 0.007292664609849453f, 0.0014142135623842478f,
                             0.00027424818836152554f, 5.318296098266728e-05f, 1.0313386155758053e-05f};
      for (int e = tid; e < 2048; e += NTHR) {
        const int s = j * 256 + (e >> 3), i = e & 7;
        float fr = 1.0f;
#pragma unroll
        for (int q = 0; q < 8; ++q) fr = (i == q) ? invf[q] : fr;
        const float ang = (float)s * fr;
        float cc, sn; sincos_acc(ang, cc, sn);
        ROPE[s * 16 + i] = cc; ROPE[s * 16 + 8 + i] = sn;
      }
    } else if (it < O_WIN) {
      const int kv = it - O_CB1;
      const float* pe = kv ? p.cmp_pe_v : p.cmp_pe_k;
      const float* w1 = kv ? p.cmp_v_w1 : p.cmp_k_w1;
      const int n = tid & 127, part = tid >> 7;
      float s = 0.f;
      for (int k = part * 512; k < part * 512 + 512; ++k) s += pe[k] * w1[(size_t)k * 128 + n];
      fl[part * 128 + n] = s;
      __syncthreads();
      if (tid < 128) ((float*)(ws + WS_BOOK + BK_CB1))[kv * 128 + tid] = fl[tid] + fl[128 + tid] + fl[256 + tid] + fl[384 + tid];
      __syncthreads();
    } else if (it < O_WOUT) {
      const int j = it - O_WIN, kt = j / 40, ntl = j % 40, n0 = ntl * 64;
      int drow0;
      if (n0 < 512) drow0 = (n0 >> 7) * 256 + (n0 & 127);
      else if (n0 < 1024) { const int cc = n0 - 512; drow0 = (cc >> 7) * 256 + 128 + (cc & 127); }
      else drow0 = n0;
      conv_tile(p.w_in, IN_COLS, IN_COLS, kt * 64, n0, (bf16_t*)(dout + DO_WIN), 1024, drow0, fl);
    } else if (it < O_C1) {
      const int j = it - O_WOUT, kt = j >> 4, ntl = j & 15;
      conv_tile(p.w_out, 1024, 1024, kt * 64, ntl * 64, (bf16_t*)(dout + DO_WOUT), 1024, ntl * 64, fl);
    } else if (it < O_C2) {
      const int j = it - O_C1, kv = j >> 6, jj = j & 63, kt = jj >> 1, ntl = jj & 1;
      conv_tile(kv ? p.cmp_v_w1 : p.cmp_k_w1, 128, 128, kt * 64, ntl * 64, (bf16_t*)(dout + (kv ? DO_CV1 : DO_CK1)), 2048, ntl * 64, fl);
    } else if (it < O_GU) {
      const int j = it - O_C2, kv = j >> 1, kt = j & 1;
      conv_tile(kv ? p.cmp_v_w2 : p.cmp_k_w2, 64, 64, kt * 64, 0, (bf16_t*)(dout + (kv ? DO_CV2 : DO_CK2)), 128, 0, fl);
    } else if (it < O_WD) {
      const int j = it - O_GU, e = j >> 9, r = j & 511, gu = r >> 8, kt = (r >> 4) & 15, ntl = r & 15, n0 = ntl * 64;
      const float* src = (gu ? p.w_up : p.w_gate) + (size_t)e * 1024 * 1024;
      const int drow0 = (n0 >> 7) * 256 + gu * 128 + (n0 & 127);
      conv_tile(src, 1024, 1024, kt * 64, n0, (bf16_t*)(ws + WS_WGU) + (size_t)e * 2048 * 1024, 1024, drow0, fl);
    } else {
      const int j = it - O_WD, e = j >> 8, r = j & 255, kt = r >> 4, ntl = r & 15;
      conv_tile(p.w_down + (size_t)e * 1024 * 1024, 1024, 1024, kt * 64, ntl * 64, (bf16_t*)(dout + DO_WD) + (size_t)e * 1024 * 1024, 1024, ntl * 64, fl);
    }
  }
}

__device__ __forceinline__ void phase1(const Params& p) {
  const int tid = my_tid(), wid = tid >> 6, lane = tid & 63;
  const float* MOD = (const float*)(p.ws + WS_BOOK + BK_MOD);
  bf16_t* H = (bf16_t*)(p.ws + WS_H);
  for (int it = blockIdx.x; it < T_TOK / 128; it += gridDim.x) {
    const int t0 = it * 128, b = t0 / SEQ;
    f32x4 sc[4], sh[4];
#pragma unroll
    for (int j = 0; j < 4; ++j) {
      const int d = j * 256 + lane * 4;
      const f32x4 g = *(const f32x4*)(p.norm1_g + d);
      const f32x4 s1 = *(const f32x4*)(MOD + b * 6144 + 1024 + d);
      sh[j] = *(const f32x4*)(MOD + b * 6144 + d);
      sc[j] = g * (s1 + 1.0f);
    }
    for (int tt = wid; tt < 128; tt += 8) {
      const int t = t0 + tt;
      f32x4 v[4]; float ss = 0.f;
#pragma unroll
      for (int j = 0; j < 4; ++j) { v[j] = *(const f32x4*)(p.x + (size_t)t * DM + j * 256 + lane * 4); ss += v[j][0] * v[j][0] + v[j][1] * v[j][1] + v[j][2] * v[j][2] + v[j][3] * v[j][3]; }
      ss = wave_sum(ss);
      const float rstd = rsqrtf(ss * (1.0f / DM) + NORM_EPS);
#pragma unroll
      for (int j = 0; j < 4; ++j) {
        const f32x4 o = v[j] * rstd * sc[j] + sh[j];
        u32x2 w; w.x = pack2(o[0], o[1]); w.y = pack2(o[2], o[3]);
        *(u32x2*)(H + (size_t)t * DM + j * 256 + lane * 4) = w;
      }
    }
  }
}

namespace gm {
constexpr int BM = 256, BK = 64, HALF = 128, HTB = HALF * BK * 2, STAGE_BYTES = 8 * HTB, KDIM = 1024, NT = KDIM / BK;
__device__ __forceinline__ int lds_byte(int r, int c) { const int st = (r >> 4) * 2 + (c >> 5), rr = r & 15, cc = c & 31, ob = rr * 64 + cc * 2; return st * 1024 + (ob ^ (((ob >> 9) & 1) << 5)); }
__device__ __forceinline__ void stage_rc(int b, int& R, int& C) { const int st = b / 1024, sb = b % 1024, swz = sb ^ (((sb >> 9) & 1) << 5); R = (st >> 1) * 16 + swz / 64; C = (st & 1) * 32 + (swz % 64) / 2; }
__device__ __forceinline__ int perm32(int rho) { const int n = rho >> 4, i = rho & 15; return 8 * (i >> 2) + 4 * n + (i & 3); }

struct Unit {
  const char* A;
  const char* B;
  unsigned ao[2][2];
  int pm, pn, e, row0, nrows;
};

template <class Epi, class Sched>
__device__ __forceinline__ void gemm_phase(LAS unsigned char* lds, const Sched& S, const Epi& E) {
  const int tid = my_tid(), wid = __builtin_amdgcn_readfirstlane(tid >> 6), lane = tid & 63, wr = wid >> 2, wc = wid & 3, fr = lane & 15, fq = lane >> 4;
  constexpr int K = KDIM, nt = NT;
  int RA[2], CA[2]; unsigned voffB[2];
#pragma unroll
  for (int i = 0; i < 2; ++i) { int R, C; stage_rc(tid * 16 + i * 8192, R, C); const int Rb = (R & ~31) + perm32(R & 31);
    RA[i] = R; CA[i] = C; voffB[i] = (unsigned)(Rb * K + C) * 2u; }
  const size_t kstep = (size_t)(BK * 2);
  const size_t hstep = (size_t)HALF * K * 2;
  const unsigned ldsw = (unsigned)wid * 1024u;
  const int aoff = lds_byte(wr * 64 + fr, fq * 8), boff = lds_byte(wc * 32 + fr, fq * 8);
#define GM_SA(b, h) (((b) * 2 + (h)) * HTB)
#define GM_SB(b, h) ((4 + (b) * 2 + (h)) * HTB)
#define GM_STAGE(bufoff, gbase, voff) do { _Pragma("unroll") for (int _i = 0; _i < 2; ++_i) \
    __builtin_amdgcn_global_load_lds((const unsigned*)((const char*)(gbase) + (voff)[_i]), (LAS unsigned*)(lds + (bufoff) + ldsw + _i * 8192), 16, 0, 0); } while (0)
#define GM_LDA(dst, b, h) do { _Pragma("unroll") for (int m = 0; m < 4; ++m) _Pragma("unroll") for (int k = 0; k < 2; ++k) dst[m][k] = *(const LAS bf16x8*)(lds + GM_SA(b, h) + aoff + m * 2048 + k * 1024); } while (0)
#define GM_LDB(dst, b, h) do { _Pragma("unroll") for (int n = 0; n < 2; ++n) _Pragma("unroll") for (int k = 0; k < 2; ++k) dst[n][k] = *(const LAS bf16x8*)(lds + GM_SB(b, h) + boff + n * 2048 + k * 1024); } while (0)
#define GM_MMA(ai, bj, At, Bt) do { __builtin_amdgcn_s_setprio(1); _Pragma("unroll") for (int m = 0; m < 4; ++m) _Pragma("unroll") for (int n = 0; n < 2; ++n) _Pragma("unroll") for (int k = 0; k < 2; ++k) \
    acc[ai][bj][m][n] = __builtin_amdgcn_mfma_f32_16x16x32_bf16(Bt[n][k], At[m][k], acc[ai][bj][m][n], 0, 0, 0); __builtin_amdgcn_s_setprio(0); } while (0)
#define GM_WAIT_V(n) asm volatile("s_waitcnt vmcnt(" #n ")" ::: "memory")
#define GM_WAIT_L(n) asm volatile("s_waitcnt lgkmcnt(" #n ")" ::: "memory")
#define GM_BAR __builtin_amdgcn_s_barrier()
#define GM_SCHED __builtin_amdgcn_sched_barrier(0)
  Unit cur, nxt; int ui = 0;
  if (!S.next(0, cur, RA, CA)) return;
  f32x4 acc[2][2][4][2];
#pragma unroll
  for (int a = 0; a < 2; ++a)
#pragma unroll
    for (int b = 0; b < 2; ++b)
#pragma unroll
      for (int m = 0; m < 4; ++m)
#pragma unroll
        for (int n = 0; n < 2; ++n) acc[a][b][m][n] = (f32x4){0.f, 0.f, 0.f, 0.f};
  bf16x8 At[4][2], B0[2][2], B1[2][2];
  const char* cA = cur.A; const char* cB = cur.B;
  unsigned cao0[2] = {cur.ao[0][0], cur.ao[0][1]}, cao1[2] = {cur.ao[1][0], cur.ao[1][1]};
  GM_STAGE(GM_SB(0, 0), cB, voffB); GM_STAGE(GM_SA(0, 0), cA, cao0); GM_STAGE(GM_SB(0, 1), cB + hstep, voffB); GM_STAGE(GM_SA(0, 1), cA, cao1);
  if (wr == 1) GM_BAR;
  GM_WAIT_V(4); GM_BAR;
  GM_STAGE(GM_SB(1, 0), cB + kstep, voffB); GM_STAGE(GM_SA(1, 0), cA + kstep, cao0); GM_STAGE(GM_SB(1, 1), cB + hstep + kstep, voffB);
  GM_WAIT_V(6); GM_BAR;
  for (;;) {
    const bool has_next = S.next(ui + 1, nxt, RA, CA);
    const char* nA = has_next ? nxt.A : cA; const char* nB = has_next ? nxt.B : cB;
    unsigned nao0[2], nao1[2];
    nao0[0] = has_next ? nxt.ao[0][0] : cao0[0]; nao0[1] = has_next ? nxt.ao[0][1] : cao0[1];
    nao1[0] = has_next ? nxt.ao[1][0] : cao1[0]; nao1[1] = has_next ? nxt.ao[1][1] : cao1[1];
    for (int t = 0; t < nt; t += 2) {
      const bool last = (t == nt - 2);
      const char* a1 = cA + (size_t)(t + 1) * kstep;
      const char* a2 = last ? nA : cA + (size_t)(t + 2) * kstep; const char* b2 = last ? nB : cB + (size_t)(t + 2) * kstep;
      const char* a3 = a2 + kstep; const char* b3 = b2 + kstep;
      unsigned x0[2], x1[2];
      x0[0] = last ? nao0[0] : cao0[0]; x0[1] = last ? nao0[1] : cao0[1];
      x1[0] = last ? nao1[0] : cao1[0]; x1[1] = last ? nao1[1] : cao1[1];
      GM_LDB(B0, 0, 0); GM_SCHED; GM_LDA(At, 0, 0); GM_STAGE(GM_SA(1, 1), a1, cao1);
      GM_WAIT_L(8); GM_BAR; GM_WAIT_L(0); GM_MMA(0, 0, At, B0); GM_BAR; GM_SCHED;
      GM_LDB(B1, 0, 1); GM_STAGE(GM_SB(0, 0), b2, voffB);
      GM_BAR; GM_WAIT_L(0); GM_MMA(0, 1, At, B1); GM_BAR;
      GM_LDA(At, 0, 1); GM_STAGE(GM_SA(0, 0), a2, x0);
      GM_BAR; GM_WAIT_L(0); GM_MMA(1, 0, At, B0); GM_BAR; GM_SCHED;
      GM_STAGE(GM_SB(0, 1), b2 + hstep, voffB);
      GM_WAIT_V(6); GM_BAR; GM_MMA(1, 1, At, B1); GM_BAR;
      GM_LDB(B0, 1, 0); GM_SCHED; GM_LDA(At, 1, 0); GM_STAGE(GM_SA(0, 1), a2, x1);
      GM_WAIT_L(8); GM_BAR; GM_WAIT_L(0); GM_MMA(0, 0, At, B0); GM_BAR; GM_SCHED;
      GM_LDB(B1, 1, 1); GM_STAGE(GM_SB(1, 0), b3, voffB);
      GM_BAR; GM_WAIT_L(0); GM_MMA(0, 1, At, B1); GM_BAR;
      GM_LDA(At, 1, 1); GM_STAGE(GM_SA(1, 0), a3, x0);
      GM_BAR; GM_WAIT_L(0); GM_MMA(1, 0, At, B0); GM_BAR; GM_SCHED;
      GM_STAGE(GM_SB(1, 1), b3 + hstep, voffB);
      GM_WAIT_V(6); GM_BAR; GM_MMA(1, 1, At, B1); GM_BAR;
    }
    E(acc, cur, wr, wc, fr, fq);
    if (!has_next) break;
#pragma unroll
    for (int a = 0; a < 2; ++a)
#pragma unroll
      for (int b = 0; b < 2; ++b)
#pragma unroll
        for (int m = 0; m < 4; ++m)
#pragma unroll
          for (int n = 0; n < 2; ++n) acc[a][b][m][n] = (f32x4){0.f, 0.f, 0.f, 0.f};
    cur = nxt; cA = nA; cB = nB; cao0[0] = nao0[0]; cao0[1] = nao0[1]; cao1[0] = nao1[0]; cao1[1] = nao1[1]; ++ui;
  }
  GM_WAIT_V(0);
  if (wr == 0) GM_BAR;
  GM_BAR;
#undef GM_SA
#undef GM_SB
#undef GM_STAGE
#undef GM_LDA
#undef GM_LDB
#undef GM_MMA
#undef GM_WAIT_V
#undef GM_WAIT_L
#undef GM_BAR
#undef GM_SCHED
}

__device__ __forceinline__ int unit_index(int i) {
  const int G = gridDim.x, c = blockIdx.x;
  return i * G + (c & 7) * (G >> 3) + (c >> 3);
}
}

__device__ __forceinline__ unsigned cvt_pk_bf16(float lo, float hi) { unsigned r; asm volatile("v_cvt_pk_bf16_f32 %0, %1, %2" : "=v"(r) : "v"(lo), "v"(hi)); return r; }
__device__ __forceinline__ u32x4 pack8(const f32x4& a, const f32x4& b) { u32x4 w; w.x = cvt_pk_bf16(a[0], a[1]); w.y = cvt_pk_bf16(a[2], a[3]); w.z = cvt_pk_bf16(b[0], b[1]); w.w = cvt_pk_bf16(b[2], b[3]); return w; }

struct DenseSched {
  const char* A; const char* Bt; int nN, nunits;
  __device__ __forceinline__ bool next(int i, gm::Unit& u, const int (&RA)[2], const int (&CA)[2]) const {
    const int L = gm::unit_index(i); if (L >= nunits) return false;
    u.pm = L / nN; u.pn = L - u.pm * nN; u.e = 0; u.row0 = u.pm * 256; u.nrows = 256;
    u.A = A + (size_t)u.pm * (256 * 1024 * 2); u.B = Bt + (size_t)u.pn * (256 * 1024 * 2);
#pragma unroll
    for (int h = 0; h < 2; ++h)
#pragma unroll
      for (int j = 0; j < 2; ++j) u.ao[h][j] = (unsigned)((h * 128 + RA[j]) * 1024 + CA[j]) * 2u;
    return true;
  }
};
struct GuSched {
  const char* H2; const char* W; const int* tiles; const int* rowtok; int ntiles;
  __device__ __forceinline__ bool next(int i, gm::Unit& u, const int (&RA)[2], const int (&CA)[2]) const {
    const int L = gm::unit_index(i); if (L >= ntiles * 8) return false;
    const int ti = L >> 3; u.pn = L & 7; u.pm = ti;
    u.e = __builtin_amdgcn_readfirstlane(ld_i32(tiles + ti * 4 + 0));
    u.row0 = __builtin_amdgcn_readfirstlane(ld_i32(tiles + ti * 4 + 1));
    u.nrows = __builtin_amdgcn_readfirstlane(ld_i32(tiles + ti * 4 + 2));
    u.A = H2; u.B = W + (size_t)u.e * (2048 * 1024 * 2) + (size_t)u.pn * (256 * 1024 * 2);
#pragma unroll
    for (int h = 0; h < 2; ++h)
#pragma unroll
      for (int j = 0; j < 2; ++j) { const int rl = h * 128 + RA[j]; const int tok = rowtok[u.row0 + (rl < u.nrows ? rl : 0)];
        u.ao[h][j] = (unsigned)(tok * 1024 + CA[j]) * 2u; }
    return true;
  }
};
struct DownSched {
  const char* ACT; const char* W; const int* tiles; int ntiles;
  __device__ __forceinline__ bool next(int i, gm::Unit& u, const int (&RA)[2], const int (&CA)[2]) const {
    const int L = gm::unit_index(i); if (L >= ntiles * 4) return false;
    const int ti = L >> 2; u.pn = L & 3; u.pm = ti;
    u.e = __builtin_amdgcn_readfirstlane(ld_i32(tiles + ti * 4 + 0));
    u.row0 = __builtin_amdgcn_readfirstlane(ld_i32(tiles + ti * 4 + 1));
    u.nrows = __builtin_amdgcn_readfirstlane(ld_i32(tiles + ti * 4 + 2));
    u.A = ACT + (size_t)u.row0 * 2048; u.B = W + (size_t)u.e * (1024 * 1024 * 2) + (size_t)u.pn * (256 * 1024 * 2);
#pragma unroll
    for (int h = 0; h < 2; ++h)
#pragma unroll
      for (int j = 0; j < 2; ++j) { const int rl = h * 128 + RA[j]; u.ao[h][j] = (unsigned)((rl < u.nrows ? rl : u.nrows - 1) * 1024 + CA[j]) * 2u; }
    return true;
  }
};

struct EpiProj {
  bf16_t *U, *Q, *KV; float* GATES; const float* ROPE;
  __device__ __forceinline__ void operator()(const f32x4 (&acc)[2][2][4][2], const gm::Unit& u, int wr, int wc, int fr, int fq) const {
    const int pn = u.pn;
#pragma unroll
    for (int ai = 0; ai < 2; ++ai)
#pragma unroll
      for (int m = 0; m < 4; ++m) {
        const int row = u.pm * 256 + ai * 128 + wr * 64 + m * 16 + fr;
        const int s = row & 2047, b = row >> 11;
        if (pn < 4) {
          f32x4 o[2];
#pragma unroll
          for (int n = 0; n < 2; ++n)
#pragma unroll
            for (int j = 0; j < 4; ++j) o[n][j] = acc[ai][0][m][n][j] * sigmoidf_(acc[ai][1][m][n][j]);
          *(u32x4*)(U + (size_t)row * 512 + pn * 128 + wc * 32 + 8 * fq) = pack8(o[0], o[1]);
        } else if (pn < 9) {
          const bool isq = pn < 6;
#pragma unroll
          for (int bj = 0; bj < 2; ++bj) {
            f32x4 v[2] = {acc[ai][bj][m][0], acc[ai][bj][m][1]};
            const bool dorope = (isq || bj == 0) && ((wc & 1) == 0);
            if (dorope) {
              const f32x4 c0 = *(const f32x4*)(ROPE + s * 16), c1 = *(const f32x4*)(ROPE + s * 16 + 4);
              const f32x4 s0 = *(const f32x4*)(ROPE + s * 16 + 8), s1 = *(const f32x4*)(ROPE + s * 16 + 12);
              const f32x4 cs[2] = {c0, c1}, sn[2] = {s0, s1};
              const float sgn = (fq == 0) ? -1.0f : 1.0f;
#pragma unroll
              for (int n = 0; n < 2; ++n)
#pragma unroll
                for (int j = 0; j < 4; ++j) {
                  const float other = __shfl_xor(v[n][j], 16);
                  const float r = v[n][j] * cs[n][j] + sgn * other * sn[n][j];
                  v[n][j] = (fq < 2) ? r : v[n][j];
                }
            }
            if (isq) {
              v[0] = v[0] * 0.125f; v[1] = v[1] * 0.125f;
              *(u32x4*)(Q + (size_t)row * 512 + (pn - 4) * 256 + bj * 128 + wc * 32 + 8 * fq) = pack8(v[0], v[1]);
            } else {
              const int idx = (pn - 6) * 2 + bj, g = wc >> 1, hd0 = (wc & 1) * 32 + 8 * fq;
              *(u32x4*)(KV + (size_t)idx * (16 * 2 * 2048 * 64) + ((size_t)(b * 2 + g) * 2048 + s) * 64 + hd0) = pack8(v[0], v[1]);
            }
          }
        } else {
          if (wc == 0 && fq < 3) {
#pragma unroll
            for (int n = 0; n < 2; ++n) {
              f32x4 o;
#pragma unroll
              for (int j = 0; j < 4; ++j) o[j] = sigmoidf_(acc[ai][0][m][n][j]);
              *(f32x4*)(GATES + (size_t)row * 24 + 8 * fq + 4 * n) = o;
            }
          }
        }
      }
  }
};
struct EpiOut {
  bf16_t* D1; const float* MOD;
  __device__ __forceinline__ void operator()(const f32x4 (&acc)[2][2][4][2], const gm::Unit& u, int wr, int wc, int fr, int fq) const {
#pragma unroll
    for (int bj = 0; bj < 2; ++bj) {
      const int col0 = u.pn * 256 + bj * 128 + wc * 32 + 8 * fq;
      const int b = (u.pm * 256) >> 11;
      const f32x4 g0 = *(const f32x4*)(MOD + b * 6144 + 2048 + col0), g1 = *(const f32x4*)(MOD + b * 6144 + 2048 + col0 + 4);
#pragma unroll
      for (int ai = 0; ai < 2; ++ai)
#pragma unroll
        for (int m = 0; m < 4; ++m) {
          const int row = u.pm * 256 + ai * 128 + wr * 64 + m * 16 + fr;
          *(u32x4*)(D1 + (size_t)row * 1024 + col0) = pack8(acc[ai][bj][m][0] * g0, acc[ai][bj][m][1] * g1);
        }
    }
  }
};
struct EpiGU {
  bf16_t* ACT; const float* bg; const float* bu;
  __device__ __forceinline__ void operator()(const f32x4 (&acc)[2][2][4][2], const gm::Unit& u, int wr, int wc, int fr, int fq) const {
    const int f0 = u.pn * 128 + wc * 32 + 8 * fq;
    const f32x4 bg0 = *(const f32x4*)(bg + u.e * 1024 + f0), bg1 = *(const f32x4*)(bg + u.e * 1024 + f0 + 4);
    const f32x4 bu0 = *(const f32x4*)(bu + u.e * 1024 + f0), bu1 = *(const f32x4*)(bu + u.e * 1024 + f0 + 4);
#pragma unroll
    for (int ai = 0; ai < 2; ++ai)
#pragma unroll
      for (int m = 0; m < 4; ++m) {
        const int rl = ai * 128 + wr * 64 + m * 16 + fr;
        f32x4 o[2];
#pragma unroll
        for (int n = 0; n < 2; ++n)
#pragma unroll
          for (int j = 0; j < 4; ++j) {
            float g = acc[ai][0][m][n][j] + (n ? bg1[j] : bg0[j]);
            float uu = acc[ai][1][m][n][j] + (n ? bu1[j] : bu0[j]);
            g = fminf(g, 7.0f); uu = fminf(fmaxf(uu, -7.0f), 7.0f);
            o[n][j] = g * sigmoidf_(1.702f * g) * (uu + 1.0f);
          }
        if (rl < u.nrows) *(u32x4*)(ACT + (size_t)(u.row0 + rl) * 1024 + f0) = pack8(o[0], o[1]);
      }
  }
};
struct EpiDown {
  bf16_t* Y; const float* bd;
  __device__ __forceinline__ void operator()(const f32x4 (&acc)[2][2][4][2], const gm::Unit& u, int wr, int wc, int fr, int fq) const {
#pragma unroll
    for (int bj = 0; bj < 2; ++bj) {
      const int col0 = u.pn * 256 + bj * 128 + wc * 32 + 8 * fq;
      const f32x4 b0 = *(const f32x4*)(bd + u.e * 1024 + col0), b1 = *(const f32x4*)(bd + u.e * 1024 + col0 + 4);
#pragma unroll
      for (int ai = 0; ai < 2; ++ai)
#pragma unroll
        for (int m = 0; m < 4; ++m) {
          const int rl = ai * 128 + wr * 64 + m * 16 + fr;
          if (rl < u.nrows) *(u32x4*)(Y + (size_t)(u.row0 + rl) * 1024 + col0) = pack8(acc[ai][bj][m][0] + b0, acc[ai][bj][m][1] + b1);
        }
    }
  }
};

__device__ __forceinline__ void phase3_naive(const Params& p, LAS unsigned char* smem) {
  const int tid = my_tid();
  LAS float* fl = (LAS float*)smem;
  LAS float* red = fl;
  unsigned char* ws = p.ws; unsigned char* dout = (unsigned char*)p.out;
  const bf16_t* U = (const bf16_t*)(ws + WS_U);
  bf16_t* MIX = (bf16_t*)(ws + WS_MIX);
  constexpr int I_CONV = T_TOK / 16;
  constexpr int I_CMP = 2 * 1016;
  for (int it = blockIdx.x; it < I_CONV + I_CMP + 1; it += gridDim.x) {
    if (it < I_CONV) {
      const int c = tid;
      float w[31];
#pragma unroll
      for (int k = 0; k < 31; ++k) w[k] = p.conv_w[k * 512 + c];
      const float cb = p.conv_b[c], lg = p.conv_ln_g[c], lb = p.conv_ln_b[c], og = p.out_norm_conv[c];
      for (int tt = 0; tt < 16; ++tt) {
        const int t = it * 16 + tt, s = t & 2047;
        float y = cb;
#pragma unroll
        for (int k = 0; k < 31; ++k) { const int sp = s - 30 + k; if (sp >= 0) y += w[k] * bf2f(U[(size_t)(t - 30 + k) * 512 + c]); }
        const float mean = block_sum(y, red) * (1.0f / 512.0f);
        const float d = y - mean;
        const float var = block_sum(d * d, red) * (1.0f / 512.0f);
        float v = d * rsqrtf(var + NORM_EPS) * lg + lb;
        v = v * sigmoidf_(v);
        const float ms = block_sum(v * v, red) * (1.0f / 512.0f);
        MIX[(size_t)t * 1024 + c] = f2bf(v * rsqrtf(ms + NORM_EPS) * og);
      }
    } else if (it < I_CONV + I_CMP) {
      const int j = it - I_CONV, kv = j / 1016, r0 = (j % 1016) * 4;
      const bf16_t* X = (const bf16_t*)(ws + WS_KV) + (size_t)kv * (16 * 2 * 2048 * 64);
      const bf16_t* W1T = (const bf16_t*)(dout + (kv ? DO_CV1 : DO_CK1));
      const bf16_t* W2T = (const bf16_t*)(dout + (kv ? DO_CV2 : DO_CK2));
      const float* b1 = (const float*)(ws + WS_BOOK + BK_CB1) + kv * 128;
      bf16_t* OUT = (bf16_t*)(ws + WS_BOOK + (kv ? BK_VCMP : BK_KCMP));
      LAS float* hid = fl + 64;
      {
        const int rl = tid >> 7, n = tid & 127, r = r0 + rl;
        const int g = r & 1, bc = r >> 1, cidx = bc % 127, b = bc / 127;
        const bf16_t* a = X + ((size_t)(b * 2 + g) * 2048 + 16 * cidx) * 64;
        const bf16_t* wrow = W1T + (size_t)n * 2048;
        float acc = 0.f;
        for (int k = 0; k < 2048; k += 8) {
          const bf16x8 av = *(const bf16x8*)(a + k), wv = *(const bf16x8*)(wrow + k);
#pragma unroll
          for (int q = 0; q < 8; ++q) acc += bf2f((bf16_t)av[q]) * bf2f((bf16_t)wv[q]);
        }
        acc += b1[n];
        hid[rl * 128 + n] = acc * sigmoidf_(acc);
      }
      __syncthreads();
      if (tid < 256) {
        const int rl = tid >> 6, d = tid & 63, r = r0 + rl;
        const int g = r & 1, bc = r >> 1, cidx = bc % 127, b = bc / 127;
        float acc = 0.f;
        for (int n = 0; n < 128; ++n) acc += hid[rl * 128 + n] * bf2f(W2T[d * 128 + n]);
        OUT[((size_t)(b * 2 + g) * 128 + cidx) * 64 + d] = f2bf(acc);
      }
      __syncthreads();
    } else {
      bf16_t* KC = (bf16_t*)(ws + WS_BOOK + BK_KCMP); bf16_t* VC = (bf16_t*)(ws + WS_BOOK + BK_VCMP);
      for (int i = tid; i < 32 * 64; i += NTHR) { const int bg = i >> 6, d = i & 63; KC[((size_t)bg * 128 + 127) * 64 + d] = 0; VC[((size_t)bg * 128 + 127) * 64 + d] = 0; }
    }
  }
}

__device__ __forceinline__ void phase4_naive(const Params& p, LAS unsigned char* smem) {
  const int tid = my_tid();
  unsigned char* ws = p.ws;
  LAS float* imp = (LAS float*)smem;
  const bf16_t* Q = (const bf16_t*)(ws + WS_Q);
  const bf16_t* KC = (const bf16_t*)(ws + WS_BOOK + BK_KCMP);
  const bf16_t* VC = (const bf16_t*)(ws + WS_BOOK + BK_VCMP);
  const float* GATES = (const float*)(ws + WS_GATES);
  bf16_t* OC = (bf16_t*)(ws + WS_OC);
  unsigned* SEL = (unsigned*)(ws + WS_BOOK + BK_SEL);
  for (int it = blockIdx.x; it < 65536 / NTHR; it += gridDim.x) {
    const int gi = it * NTHR + tid;
    const int t = gi & 2047, g = (gi >> 11) & 1, b = gi >> 12;
    const int tok = b * 2048 + t;
    const int ncv = (t >= 31) ? ((t - 31) >> 4) + 1 : 0;
    const bf16_t* kc = KC + (size_t)(b * 2 + g) * 128 * 64;
    const bf16_t* vc = VC + (size_t)(b * 2 + g) * 128 * 64;
#pragma unroll
    for (int j = 0; j < 32; ++j) imp[j * NTHR + tid] = 0.f;
    for (int n = 0; n < 4; ++n) {
      const int head = g * 4 + n;
      bf16x8 qp[8];
#pragma unroll
      for (int d8 = 0; d8 < 8; ++d8) qp[d8] = *(const bf16x8*)(Q + (size_t)tok * 512 + head * 64 + d8 * 8);
      float o[64];
#pragma unroll
      for (int d = 0; d < 64; ++d) o[d] = 0.f;
      if (ncv > 0) {
        float m = -1e30f;
#pragma unroll 1
        for (int c = 0; c < ncv; ++c) {
          float s = 0.f;
#pragma unroll
          for (int d8 = 0; d8 < 8; ++d8) { const bf16x8 v = *(const bf16x8*)(kc + c * 64 + d8 * 8);
#pragma unroll
            for (int e = 0; e < 8; ++e) s += bf2f((bf16_t)qp[d8][e]) * bf2f((bf16_t)v[e]); }
          m = fmaxf(m, s);
        }
        float l = 0.f;
#pragma unroll 1
        for (int c = 0; c < ncv; ++c) {
          float s = 0.f;
#pragma unroll
          for (int d8 = 0; d8 < 8; ++d8) { const bf16x8 v = *(const bf16x8*)(kc + c * 64 + d8 * 8);
#pragma unroll
            for (int e = 0; e < 8; ++e) s += bf2f((bf16_t)qp[d8][e]) * bf2f((bf16_t)v[e]); }
          l += __expf(s - m);
        }
        const float il = 1.0f / l;
#pragma unroll 1
        for (int c = 0; c < ncv; ++c) {
          float s = 0.f;
#pragma unroll
          for (int d8 = 0; d8 < 8; ++d8) { const bf16x8 v = *(const bf16x8*)(kc + c * 64 + d8 * 8);
#pragma unroll
            for (int e = 0; e < 8; ++e) s += bf2f((bf16_t)qp[d8][e]) * bf2f((bf16_t)v[e]); }
          const float pr = __expf(s - m) * il;
#pragma unroll
          for (int d8 = 0; d8 < 8; ++d8) { const bf16x8 v = *(const bf16x8*)(vc + c * 64 + d8 * 8);
#pragma unroll
            for (int e = 0; e < 8; ++e) o[d8 * 8 + e] += pr * bf2f((bf16_t)v[e]); }
          imp[(c >> 2) * NTHR + tid] += pr;
          if ((c & 3) == 3 && ((c + 1) >> 2) < 32) imp[((c + 1) >> 2) * NTHR + tid] += pr;
        }
      }
      const float g0 = GATES[(size_t)tok * 24 + head * 3 + 0];
#pragma unroll
      for (int d8 = 0; d8 < 8; ++d8) {
        u32x4 w; w.x = pack2(g0 * o[d8 * 8 + 0], g0 * o[d8 * 8 + 1]); w.y = pack2(g0 * o[d8 * 8 + 2], g0 * o[d8 * 8 + 3]);
        w.z = pack2(g0 * o[d8 * 8 + 4], g0 * o[d8 * 8 + 5]); w.w = pack2(g0 * o[d8 * 8 + 6], g0 * o[d8 * 8 + 7]);
        *(u32x4*)(OC + (size_t)tok * 512 + head * 64 + d8 * 8) = w;
      }
    }
    const int cur = t >> 6, nvalid = cur + 1;
    unsigned mask;
    if (nvalid <= 16) mask = (1u << nvalid) - 1u;
    else {
      mask = 0u;
      for (int j = 0; j <= cur; ++j) {
        const bool fj = (j == 0) || (j == cur) || (j == cur - 1);
        const float sj = fj ? 1e9f : imp[j * NTHR + tid];
        int rank = 0;
        for (int i = 0; i <= cur; ++i) {
          const bool fi = (i == 0) || (i == cur) || (i == cur - 1);
          const float si = fi ? 1e9f : imp[i * NTHR + tid];
          rank += (si > sj || (si == sj && i < j)) ? 1 : 0;
        }
        if (rank < 16) mask |= (1u << j);
      }
    }
    SEL[gi] = mask;
  }
}

template <bool SELECTED>
__device__ __forceinline__ void phase56_naive(const Params& p) {
  const int tid = my_tid();
  unsigned char* ws = p.ws;
  const bf16_t* Q = (const bf16_t*)(ws + WS_Q);
  const bf16_t* KB = (const bf16_t*)(ws + WS_KV) + (size_t)(SELECTED ? 2 : 4) * (16 * 2 * 2048 * 64);
  const bf16_t* VB = (const bf16_t*)(ws + WS_KV) + (size_t)(SELECTED ? 3 : 5) * (16 * 2 * 2048 * 64);
  const float* GATES = (const float*)(ws + WS_GATES);
  const unsigned* SEL = (const unsigned*)(ws + WS_BOOK + BK_SEL);
  bf16_t* O = (bf16_t*)(ws + (SELECTED ? WS_OS : WS_OW));
  for (int it = blockIdx.x; it < (T_TOK * 8) / NTHR; it += gridDim.x) {
    const int gi = it * NTHR + tid;
    const int t = gi & 2047, head = (gi >> 11) & 7, b = gi >> 14, g = head >> 2;
    const int tok = b * 2048 + t;
    const bf16_t* kb = KB + (size_t)(b * 2 + g) * 2048 * 64;
    const bf16_t* vb = VB + (size_t)(b * 2 + g) * 2048 * 64;
    bf16x8 qp[8]; float o[64];
#pragma unroll
    for (int d8 = 0; d8 < 8; ++d8) { qp[d8] = *(const bf16x8*)(Q + (size_t)tok * 512 + head * 64 + d8 * 8);
#pragma unroll
      for (int e = 0; e < 8; ++e) o[d8 * 8 + e] = 0.f; }
    float m = -1e30f, l = 0.f;
    const unsigned mask = SELECTED ? SEL[(b * 2 + g) * 2048 + t] : 0u;
    const int k_lo = SELECTED ? 0 : (t - 511 > 0 ? t - 511 : 0);
#pragma unroll 1
    for (int key = k_lo; key <= t; ++key) {
      if (SELECTED && !((mask >> (key >> 6)) & 1u)) { key |= 63; continue; }
      float s = 0.f;
#pragma unroll
      for (int d8 = 0; d8 < 8; ++d8) { const bf16x8 v = *(const bf16x8*)(kb + (size_t)key * 64 + d8 * 8);
#pragma unroll
        for (int e = 0; e < 8; ++e) s += bf2f((bf16_t)qp[d8][e]) * bf2f((bf16_t)v[e]); }
      const float mn = fmaxf(m, s), a = __expf(m - mn), pr = __expf(s - mn);
      l = l * a + pr; m = mn;
#pragma unroll
      for (int d8 = 0; d8 < 8; ++d8) { const bf16x8 v = *(const bf16x8*)(vb + (size_t)key * 64 + d8 * 8);
#pragma unroll
        for (int e = 0; e < 8; ++e) o[d8 * 8 + e] = o[d8 * 8 + e] * a + pr * bf2f((bf16_t)v[e]); }
    }
    const float gt = GATES[(size_t)tok * 24 + head * 3 + (SELECTED ? 1 : 2)] / l;
#pragma unroll
    for (int d8 = 0; d8 < 8; ++d8) {
      u32x4 w; w.x = pack2(gt * o[d8 * 8 + 0], gt * o[d8 * 8 + 1]); w.y = pack2(gt * o[d8 * 8 + 2], gt * o[d8 * 8 + 3]);
      w.z = pack2(gt * o[d8 * 8 + 4], gt * o[d8 * 8 + 5]); w.w = pack2(gt * o[d8 * 8 + 6], gt * o[d8 * 8 + 7]);
      *(u32x4*)(O + (size_t)tok * 512 + head * 64 + d8 * 8) = w;
    }
  }
}

__device__ __forceinline__ void phase6b(const Params& p) {
  const int tid = my_tid(), wid = tid >> 6, lane = tid & 63;
  unsigned char* ws = p.ws;
  const bf16_t* OC = (const bf16_t*)(ws + WS_OC); const bf16_t* OW = (const bf16_t*)(ws + WS_OW); const bf16_t* OS = (const bf16_t*)(ws + WS_OS);
  bf16_t* MIX = (bf16_t*)(ws + WS_MIX);
  const f32x4 g0 = *(const f32x4*)(p.out_norm_nsa + lane * 8), g1 = *(const f32x4*)(p.out_norm_nsa + lane * 8 + 4);
  for (int t = blockIdx.x * 8 + wid; t < T_TOK; t += gridDim.x * 8) {
    const bf16x8 a = *(const bf16x8*)(OC + (size_t)t * 512 + lane * 8), b = *(const bf16x8*)(OW + (size_t)t * 512 + lane * 8), c = *(const bf16x8*)(OS + (size_t)t * 512 + lane * 8);
    float v[8]; float ss = 0.f;
#pragma unroll
    for (int e = 0; e < 8; ++e) { v[e] = bf2f((bf16_t)a[e]) + bf2f((bf16_t)b[e]) + bf2f((bf16_t)c[e]); ss += v[e] * v[e]; }
    ss = wave_sum(ss);
    const float rstd = rsqrtf(ss * (1.0f / 512.0f) + NORM_EPS);
    u32x4 w; w.x = pack2(v[0] * rstd * g0[0], v[1] * rstd * g0[1]); w.y = pack2(v[2] * rstd * g0[2], v[3] * rstd * g0[3]);
    w.z = pack2(v[4] * rstd * g1[0], v[5] * rstd * g1[1]); w.w = pack2(v[6] * rstd * g1[2], v[7] * rstd * g1[3]);
    *(u32x4*)(MIX + (size_t)t * 1024 + 512 + lane * 8) = w;
  }
}

__device__ __forceinline__ void phase8_naive(const Params& p) {
  const int tid = my_tid(), wid = tid >> 6, lane = tid & 63;
  unsigned char* ws = p.ws;
  const float* MOD = (const float*)(ws + WS_BOOK + BK_MOD);
  const bf16_t* D1 = (const bf16_t*)(ws + WS_D1);
  bf16_t* H2 = (bf16_t*)(ws + WS_H2);
  int* TOPI = (int*)(ws + WS_BOOK + BK_TOPI); float* TOPG = (float*)(ws + WS_BOOK + BK_TOPG);
  int* HIST = (int*)(ws + WS_BOOK + BK_HIST);
  for (int it = blockIdx.x; it < T_TOK / 128; it += gridDim.x) {
    const int t0 = it * 128, b = t0 / SEQ;
    f32x4 sc[4], sh[4];
#pragma unroll
    for (int j = 0; j < 4; ++j) {
      const int d = j * 256 + lane * 4;
      const f32x4 g = *(const f32x4*)(p.norm2_g + d);
      const f32x4 s2 = *(const f32x4*)(MOD + b * 6144 + 4096 + d);
      sh[j] = *(const f32x4*)(MOD + b * 6144 + 3072 + d);
      sc[j] = g * (s2 + 1.0f);
    }
    for (int tt = wid; tt < 128; tt += 8) {
      const int t = t0 + tt;
      f32x4 v[4]; float ss = 0.f;
#pragma unroll
      for (int j = 0; j < 4; ++j) {
        v[j] = *(const f32x4*)(p.x + (size_t)t * DM + j * 256 + lane * 4);
        const u32x2 dd = *(const u32x2*)(D1 + (size_t)t * DM + j * 256 + lane * 4);
        v[j][0] += __uint_as_float(dd.x << 16); v[j][1] += __uint_as_float(dd.x & 0xffff0000u);
        v[j][2] += __uint_as_float(dd.y << 16); v[j][3] += __uint_as_float(dd.y & 0xffff0000u);
        ss += v[j][0] * v[j][0] + v[j][1] * v[j][1] + v[j][2] * v[j][2] + v[j][3] * v[j][3];
      }
      ss = wave_sum(ss);
      const float rstd = rsqrtf(ss * (1.0f / DM) + NORM_EPS);
#pragma unroll
      for (int j = 0; j < 4; ++j) {
        v[j] = v[j] * rstd * sc[j] + sh[j];
        u32x2 w; w.x = pack2(v[j][0], v[j][1]); w.y = pack2(v[j][2], v[j][3]);
        *(u32x2*)(H2 + (size_t)t * DM + j * 256 + lane * 4) = w;
      }
      float mylg = -3.0e38f;
#pragma unroll 4
      for (int e = 0; e < 32; ++e) {
        float s = 0.f;
#pragma unroll
        for (int j = 0; j < 4; ++j)
#pragma unroll
          for (int q = 0; q < 4; ++q) s += v[j][q] * p.w_router[(size_t)(j * 256 + lane * 4 + q) * 32 + e];
        s = wave_sum(s) + p.b_router[e];
        mylg = (lane == e) ? s : mylg;
      }
      int idx[4]; float val[4];
#pragma unroll
      for (int k = 0; k < 4; ++k) {
        float bv = mylg; int bi = lane;
#pragma unroll
        for (int o = 32; o > 0; o >>= 1) {
          const float ov = __shfl_xor(bv, o); const int oi = __shfl_xor(bi, o);
          const bool take = (ov > bv) || (ov == bv && oi < bi);
          bv = take ? ov : bv; bi = take ? oi : bi;
        }
        idx[k] = bi; val[k] = bv;
        mylg = (lane == bi) ? -3.0e38f : mylg;
      }
      const float e0 = 1.0f, e1 = __expf(val[1] - val[0]), e2 = __expf(val[2] - val[0]), e3 = __expf(val[3] - val[0]);
      const float inv = 1.0f / (e0 + e1 + e2 + e3);
      if (lane == 0) {
        *(int4*)(TOPI + (size_t)t * 4) = make_int4(idx[0], idx[1], idx[2], idx[3]);
        *(f32x4*)(TOPG + (size_t)t * 4) = (f32x4){e0 * inv, e1 * inv, e2 * inv, e3 * inv};
        const int ch = t / CHUNK_TOK;
        atomicAdd(HIST + ch * 32 + idx[0], 1); atomicAdd(HIST + ch * 32 + idx[1], 1);
        atomicAdd(HIST + ch * 32 + idx[2], 1); atomicAdd(HIST + ch * 32 + idx[3], 1);
      }
    }
  }
}

__device__ __forceinline__ void phase9(const Params& p, LAS unsigned char* smem) {
  const int tid = my_tid();
  unsigned char* ws = p.ws;
  LAS int* base = (LAS int*)smem;
  int* HIST = (int*)(ws + WS_BOOK + BK_HIST);
  int* FILL = HIST + 64;
  int* NTL = (int*)(ws + WS_BOOK + BK_NT);
  int* TILES = (int*)(ws + WS_BOOK + BK_TILES);
  const int* TOPI = (const int*)(ws + WS_BOOK + BK_TOPI);
  int* SLOTOF = (int*)(ws + WS_BOOK + BK_SLOTOF);
  int* ROWTOK = (int*)(ws + WS_BOOK + BK_ROWTOK);
  if (tid < 2) {
    int run = 0, nt = 0;
    for (int e = 0; e < 32; ++e) {
      const int cnt = ld_i32(HIST + tid * 32 + e);
      base[tid * 32 + e] = run;
      if (blockIdx.x == 0) {
        for (int r = 0; r < cnt; r += 256) { int* tl = TILES + (size_t)(tid * MAXTILES + nt) * 4; tl[0] = e; tl[1] = run + r; tl[2] = (cnt - r < 256) ? cnt - r : 256; tl[3] = 0; ++nt; }
      }
      run += cnt;
    }
    if (blockIdx.x == 0) NTL[tid] = nt;
  }
  __syncthreads();
  for (int a = blockIdx.x * NTHR + tid; a < T_TOK * 4; a += gridDim.x * NTHR) {
    const int t = a >> 2, ch = t / CHUNK_TOK;
    const int e = TOPI[a];
    const int slot = base[ch * 32 + e] + atomicAdd(FILL + ch * 32 + e, 1);
    ROWTOK[ch * CHUNK_ROWS + slot] = t;
    SLOTOF[a] = slot;
  }
}

__device__ __forceinline__ void phase12(const Params& p, int ch) {
  const int tid = my_tid(), wid = tid >> 6, lane = tid & 63;
  unsigned char* ws = p.ws;
  const float* MOD = (const float*)(ws + WS_BOOK + BK_MOD);
  const bf16_t* D1 = (const bf16_t*)(ws + WS_D1);
  const bf16_t* Y = (const bf16_t*)(ws + WS_YBUF);
  const int* SLOTOF = (const int*)(ws + WS_BOOK + BK_SLOTOF);
  const float* TOPG = (const float*)(ws + WS_BOOK + BK_TOPG);
  for (int it = blockIdx.x; it < CHUNK_TOK / 128; it += gridDim.x) {
    const int t0 = ch * CHUNK_TOK + it * 128, b = t0 / SEQ;
    f32x4 gt[4], fg[4];
#pragma unroll
    for (int j = 0; j < 4; ++j) { const int d = j * 256 + lane * 4; gt[j] = *(const f32x4*)(MOD + b * 6144 + 5120 + d); fg[j] = *(const f32x4*)(p.final_norm_g + d); }
    for (int tt = wid; tt < 128; tt += 8) {
      const int t = t0 + tt;
      const int4 sl = *(const int4*)(SLOTOF + (size_t)t * 4);
      const f32x4 gg = *(const f32x4*)(TOPG + (size_t)t * 4);
      const int sls[4] = {sl.x, sl.y, sl.z, sl.w};
      f32x4 v[4]; float ss = 0.f;
#pragma unroll
      for (int j = 0; j < 4; ++j) {
        const int d = j * 256 + lane * 4;
        f32x4 y = (f32x4){0.f, 0.f, 0.f, 0.f};
#pragma unroll
        for (int k = 0; k < 4; ++k) {
          const u32x2 yy = *(const u32x2*)(Y + (size_t)sls[k] * 1024 + d);
          y[0] += gg[k] * __uint_as_float(yy.x << 16); y[1] += gg[k] * __uint_as_float(yy.x & 0xffff0000u);
          y[2] += gg[k] * __uint_as_float(yy.y << 16); y[3] += gg[k] * __uint_as_float(yy.y & 0xffff0000u);
        }
        v[j] = *(const f32x4*)(p.x + (size_t)t * DM + d);
        const u32x2 dd = *(const u32x2*)(D1 + (size_t)t * DM + d);
        v[j][0] += __uint_as_float(dd.x << 16); v[j][1] += __uint_as_float(dd.x & 0xffff0000u);
        v[j][2] += __uint_as_float(dd.y << 16); v[j][3] += __uint_as_float(dd.y & 0xffff0000u);
        v[j] = v[j] + gt[j] * y;
        ss += v[j][0] * v[j][0] + v[j][1] * v[j][1] + v[j][2] * v[j][2] + v[j][3] * v[j][3];
      }
      ss = wave_sum(ss);
      const float rstd = rsqrtf(ss * (1.0f / DM) + NORM_EPS);
#pragma unroll
      for (int j = 0; j < 4; ++j) *(f32x4*)(p.out + (size_t)t * DM + j * 256 + lane * 4) = v[j] * rstd * fg[j];
    }
  }
}

__global__ void __launch_bounds__(NTHR) mega(Params p) {
  extern __shared__ __attribute__((aligned(16))) unsigned char smem_raw[];
  LAS unsigned char* smem = (LAS unsigned char*)smem_raw;
  cg::grid_group grid = cg::this_grid();
  unsigned char* ws = p.ws; unsigned char* dout = (unsigned char*)p.out;
  phase0(p, smem);
  grid.sync();
  phase1(p);
  grid.sync();
  {
    DenseSched S{(const char*)(ws + WS_H), (const char*)(dout + DO_WIN), 10, 1280};
    EpiProj E{(bf16_t*)(ws + WS_U), (bf16_t*)(ws + WS_Q), (bf16_t*)(ws + WS_KV), (float*)(ws + WS_GATES), (const float*)(ws + WS_BOOK + BK_ROPE)};
    gm::gemm_phase(smem, S, E);
  }
  grid.sync();
  phase3_naive(p, smem);
  phase56_naive<false>(p);
  grid.sync();
  phase4_naive(p, smem);
  grid.sync();
  phase56_naive<true>(p);
  grid.sync();
  phase6b(p);
  grid.sync();
  {
    DenseSched S{(const char*)(ws + WS_MIX), (const char*)(dout + DO_WOUT), 4, 512};
    EpiOut E{(bf16_t*)(ws + WS_D1), (const float*)(ws + WS_BOOK + BK_MOD)};
    gm::gemm_phase(smem, S, E);
  }
  grid.sync();
  phase8_naive(p);
  grid.sync();
  phase9(p, smem);
  grid.sync();
  for (int ch = 0; ch < 2; ++ch) {
    const int* tiles = (const int*)(ws + WS_BOOK + BK_TILES) + (size_t)ch * MAXTILES * 4;
    const int ntiles = __builtin_amdgcn_readfirstlane(ld_i32((const int*)(ws + WS_BOOK + BK_NT) + ch));
    {
      GuSched S{(const char*)(ws + WS_H2), (const char*)(ws + WS_WGU), tiles, (const int*)(ws + WS_BOOK + BK_ROWTOK) + ch * CHUNK_ROWS, ntiles};
      EpiGU E{(bf16_t*)(ws + WS_ACT), p.b_gate, p.b_up};
      gm::gemm_phase(smem, S, E);
    }
    grid.sync();
    {
      DownSched S{(const char*)(ws + WS_ACT), (const char*)(dout + DO_WD), tiles, ntiles};
      EpiDown E{(bf16_t*)(ws + WS_YBUF), p.b_down};
      gm::gemm_phase(smem, S, E);
    }
    grid.sync();
    phase12(p, ch);
  }
}

extern "C" void kernel_launch(void* const* d_in, const int* in_sizes, int n_in,
                              void* d_out, int out_size, void* d_ws, size_t ws_size,
                              hipStream_t stream) {
  static int grid_blocks = 0;
  if (!grid_blocks) {
    int dev = 0, cus = 0, per_cu = 0;
    (void)hipGetDevice(&dev);
    (void)hipDeviceGetAttribute(&cus, hipDeviceAttributeMultiprocessorCount, dev);
    (void)hipFuncSetAttribute((const void*)mega, hipFuncAttributeMaxDynamicSharedMemorySize, (int)LDS_BYTES);
    (void)hipOccupancyMaxActiveBlocksPerMultiprocessor(&per_cu, mega, NTHR, LDS_BYTES);
    if (per_cu > 1) per_cu = 1;
    grid_blocks = cus * per_cu;
    if (grid_blocks > 256) grid_blocks = 256;
    grid_blocks &= ~7;
  }
  Params p{};
  const float** pp = (const float**)&p;
  for (int i = 0; i < 29; ++i) pp[i] = (const float*)d_in[i];
  p.out = (float*)d_out; p.ws = (unsigned char*)d_ws; p.ph0 = 0; p.ph1 = 0;
  if (ws_size < WS_TOTAL) { fprintf(stderr, "workspace too small: %zu < %zu\n", ws_size, (size_t)WS_TOTAL); return; }
  void* args[] = {&p};
  hipError_t e = hipLaunchCooperativeKernel((void*)mega, dim3(grid_blocks), dim3(NTHR), args, LDS_BYTES, stream);
  if (e != hipSuccess) fprintf(stderr, "cooperative launch failed: %s (grid %d)\n", hipGetErrorString(e), grid_blocks);
}
```

```cpp
#include <hip/hip_runtime.h>
#include <hip/hip_cooperative_groups.h>
#include <cstdio>
#include <cstdint>
namespace cg = cooperative_groups;

#define LAS __attribute__((address_space(3)))
typedef unsigned short bf16_t;
typedef short bf16x8 __attribute__((ext_vector_type(8)));
typedef float f32x4 __attribute__((ext_vector_type(4)));
typedef float f32x2 __attribute__((ext_vector_type(2)));
typedef unsigned u32x4 __attribute__((ext_vector_type(4)));
typedef unsigned u32x2 __attribute__((ext_vector_type(2)));

constexpr int T_TOK = 32768, DM = 1024, NB = 16, SEQ = 2048;
constexpr int IN_COLS = 2328, IN_PAD = 2560;
constexpr int NCMP = 127;
constexpr int NEXP = 32, TOPK = 4, DFF = 1024;
constexpr int CHUNK_TOK = 16384, CHUNK_ROWS = 65536, MAXTILES = 288;
constexpr float NORM_EPS = 1e-5f;
constexpr int NTHR = 512;
constexpr size_t LDS_BYTES = 140 * 1024;

constexpr size_t MiB = 1024 * 1024;
constexpr size_t WS_BOOK = 0;
constexpr size_t WS_WGU  = 16 * MiB;
constexpr size_t WS_D1   = WS_WGU + 128 * MiB;
constexpr size_t WS_E    = WS_D1 + 64 * MiB;
constexpr size_t WS_H2   = WS_E;
constexpr size_t WS_ACT  = WS_E + 64 * MiB;
constexpr size_t WS_YBUF = WS_E + 192 * MiB;
constexpr size_t WS_TOTAL = WS_E + 320 * MiB;
constexpr size_t WS_H    = WS_E;
constexpr size_t WS_MIX  = WS_E;
constexpr size_t WS_U    = WS_E + 64 * MiB;
constexpr size_t WS_Q    = WS_E + 96 * MiB;
constexpr size_t WS_KV   = WS_E + 128 * MiB;
constexpr size_t WS_GATES= WS_E + 176 * MiB;
constexpr size_t WS_OC   = WS_E + 180 * MiB;
constexpr size_t WS_OW   = WS_E + 212 * MiB;
constexpr size_t WS_OS   = WS_E + 244 * MiB;
constexpr size_t BK_MOD    = 0;
constexpr size_t BK_ROPE   = 512 * 1024;
constexpr size_t BK_CB1    = BK_ROPE + 128 * 1024;
constexpr size_t BK_HIST   = BK_CB1 + 1024;
constexpr size_t BK_NT     = BK_HIST + 512;
constexpr size_t BK_TILES  = BK_NT + 256;
constexpr size_t BK_TOPI   = 1 * MiB;
constexpr size_t BK_TOPG   = BK_TOPI + 512 * 1024;
constexpr size_t BK_SLOTOF = BK_TOPG + 512 * 1024;
constexpr size_t BK_ROWTOK = BK_SLOTOF + 512 * 1024;
constexpr size_t BK_SEL    = BK_ROWTOK + 512 * 1024;
constexpr size_t BK_KCMP   = BK_SEL + 256 * 1024;
constexpr size_t BK_VCMP   = BK_KCMP + 512 * 1024;
constexpr size_t BK_ITEMCNT= BK_VCMP + 512 * 1024;
constexpr size_t BK_WRT    = BK_ITEMCNT + 32 * 1024;
constexpr size_t BK_END    = BK_WRT + 128 * 1024;
static_assert(BK_END <= 16 * MiB, "book");
constexpr size_t DO_WIN  = 0;
constexpr size_t DO_WOUT = 5 * MiB;
constexpr size_t DO_CK1  = 7 * MiB;
constexpr size_t DO_CV1  = DO_CK1 + 512 * 1024;
constexpr size_t DO_CK2  = DO_CV1 + 512 * 1024;
constexpr size_t DO_CV2  = DO_CK2 + 16 * 1024;
constexpr size_t DO_WD   = 64 * MiB;

struct Params {
  const float *x, *c, *norm1_g, *norm2_g, *w_ada, *b_ada, *w_in, *conv_w, *conv_b, *conv_ln_g, *conv_ln_b,
      *cmp_pe_k, *cmp_pe_v, *cmp_k_w1, *cmp_k_w2, *cmp_v_w1, *cmp_v_w2, *out_norm_conv, *out_norm_nsa, *w_out,
      *w_router, *b_router, *w_gate, *b_gate, *w_up, *b_up, *w_down, *b_down, *final_norm_g;
  float* out;
  unsigned char* ws;
  int ph0, ph1;
};

__device__ __forceinline__ bf16_t f2bf(float f) { unsigned u = __float_as_uint(f); u += 0x7FFFu + ((u >> 16) & 1u); return (bf16_t)(u >> 16); }
__device__ __forceinline__ float bf2f(bf16_t b) { return __uint_as_float(((unsigned)b) << 16); }
__device__ __forceinline__ unsigned pack2(float lo, float hi) { return (unsigned)f2bf(lo) | ((unsigned)f2bf(hi) << 16); }
__device__ __forceinline__ float wave_sum(float v) {
#pragma unroll
  for (int o = 32; o > 0; o >>= 1) v += __shfl_xor(v, o);
  return v;
}
__device__ __forceinline__ float sigmoidf_(float v) { return 1.0f / (1.0f + __expf(-v)); }
__device__ __forceinline__ int ld_i32(const int* p) { return __hip_atomic_load(p, __ATOMIC_RELAXED, __HIP_MEMORY_SCOPE_AGENT); }

__device__ __forceinline__ int my_tid() { int t = threadIdx.x; asm volatile("" : "+v"(t)); return t; }
__device__ __forceinline__ int lds_inc(LAS int* p) { return __hip_atomic_fetch_add(p, 1, __ATOMIC_RELAXED, __HIP_MEMORY_SCOPE_WORKGROUP); }
__device__ __forceinline__ float block_sum(float v, LAS float* red) {
  v = wave_sum(v);
  const int tq = my_tid(); const int wid = tq >> 6, lane = tq & 63;
  __syncthreads();
  if (lane == 0) red[wid] = v;
  __syncthreads();
  float s = 0.f;
#pragma unroll
  for (int i = 0; i < 8; ++i) s += red[i];
  return s;
}

__device__ __forceinline__ void conv_tile(const float* __restrict__ src, int ldn, int nvalid, int k0, int n0,
                                          bf16_t* dst, int ldk, int drow0, LAS float* tile) {
  const int tid = my_tid();
#pragma unroll
  for (int r = 0; r < 8; ++r) {
    const int k = r * 8 + (tid >> 6), n = tid & 63;
    tile[k * 65 + n] = (n0 + n < nvalid) ? src[(size_t)(k0 + k) * ldn + n0 + n] : 0.f;
  }
  __syncthreads();
  {
    const int n = tid >> 3, ks = tid & 7;
    u32x4 w;
    w.x = pack2(tile[(ks * 8 + 0) * 65 + n], tile[(ks * 8 + 1) * 65 + n]);
    w.y = pack2(tile[(ks * 8 + 2) * 65 + n], tile[(ks * 8 + 3) * 65 + n]);
    w.z = pack2(tile[(ks * 8 + 4) * 65 + n], tile[(ks * 8 + 5) * 65 + n]);
    w.w = pack2(tile[(ks * 8 + 6) * 65 + n], tile[(ks * 8 + 7) * 65 + n]);
    *(u32x4*)(dst + (size_t)(drow0 + n) * ldk + k0 + ks * 8) = w;
  }
  __syncthreads();
}

__device__ __forceinline__ void sincos_acc(float angf, float& c, float& s) {
  const double TWO_PI = 6.283185307179586476925286766559;
  double a = (double)angf;
  double k = __builtin_rint(a / TWO_PI);
  double r = a - k * TWO_PI;
  double r2 = r * r;
  double ts = r, tc = 1.0, ss = r, cs = 1.0;
#pragma unroll 1
  for (int n = 1; n <= 14; ++n) {
    tc = -tc * r2 / (double)((2 * n - 1) * (2 * n));
    ts = -ts * r2 / (double)((2 * n) * (2 * n + 1));
    cs += tc; ss += ts;
  }
  c = (float)cs; s = (float)ss;
}

__device__ __forceinline__ void phase0(const Params& p, LAS unsigned char* smem) {
  const int tid = my_tid();
  unsigned char* ws = p.ws;
  unsigned char* dout = (unsigned char*)p.out;
  LAS float* fl = (LAS float*)smem;
  constexpr int I_MOD = 96, I_ROPE = 8 + 4, I_CB1 = 2, I_WIN = 640, I_WOUT = 256, I_C1 = 128, I_C2 = 4, I_GU = 16384, I_WD = 8192;
  constexpr int O_ROPE = I_MOD, O_CB1 = O_ROPE + I_ROPE, O_WIN = O_CB1 + I_CB1, O_WOUT = O_WIN + I_WIN, O_C1 = O_WOUT + I_WOUT,
                O_C2 = O_C1 + I_C1, O_GU = O_C2 + I_C2, O_WD = O_GU + I_GU, O_END = O_WD + I_WD;
  if (blockIdx.x == 0 && tid < 130) {
    ((int*)(ws + WS_BOOK + BK_HIST))[tid] = 0;
  }
  for (int it = blockIdx.x; it < O_END; it += gridDim.x) {
    if (it < O_ROPE) {
      const int n0 = it * 64;
      LAS float* cact = fl;
      LAS float* red = fl + 16384;
      for (int i = tid; i < 16384; i += NTHR) { const float v = p.c[i]; cact[i] = v / (1.0f + __expf(-v)); }
      __syncthreads();
      const int nl = tid & 63, kp = tid >> 6;
      float acc[16];
#pragma unroll
      for (int b = 0; b < 16; ++b) acc[b] = 0.f;
      for (int k = kp * 128; k < kp * 128 + 128; ++k) {
        const float w = p.w_ada[(size_t)k * 6144 + n0 + nl];
#pragma unroll
        for (int b = 0; b < 16; ++b) acc[b] += cact[b * 1024 + k] * w;
      }
#pragma unroll
      for (int b = 0; b < 16; ++b) red[(kp * 16 + b) * 64 + nl] = acc[b];
      __syncthreads();
      float* MOD = (float*)(ws + WS_BOOK + BK_MOD);
      for (int o = tid; o < 1024; o += NTHR) {
        const int b = o >> 6, n2 = o & 63;
        float s = p.b_ada[n0 + n2];
#pragma unroll
        for (int k2 = 0; k2 < 8; ++k2) s += red[(k2 * 16 + b) * 64 + n2];
        MOD[b * 6144 + n0 + n2] = s;
      }
      __syncthreads();
    } else if (it < O_CB1) {
      const int j = it - O_ROPE;
      if (j >= 8) {
        float* WRT = (float*)(ws + WS_BOOK + BK_WRT);
        for (int i = tid; i < 8192; i += NTHR) { const int idx = (j - 8) * 8192 + i, d = idx >> 5, e = idx & 31; WRT[e * 1024 + d] = p.w_router[idx]; }
        continue;
      }
      float* ROPE = (float*)(ws + WS_BOOK + BK_ROPE);
      const float invf[8] = {1.0f, 0.1939227432012558f, 0.03760603070259094f, 0.007292664609849453f, 0.0014142135623842478f,
                             0.00027424818836152554f, 5.318296098266728e-05f, 1.0313386155758053e-05f};
      for (int e = tid; e < 2048; e += NTHR) {
        const int s = j * 256 + (e >> 3), i = e & 7;
        float fr = 1.0f;
#pragma unroll
        for (int q = 0; q < 8; ++q) fr = (i == q) ? invf[q] : fr;
        const float ang = (float)s * fr;
        float cc, sn; sincos_acc(ang, cc, sn);
        ROPE[s * 16 + i] = cc; ROPE[s * 16 + 8 + i] = sn;
      }
    } else if (it < O_WIN) {
      const int kv = it - O_CB1;
      const float* pe = kv ? p.cmp_pe_v : p.cmp_pe_k;
      const float* w1 = kv ? p.cmp_v_w1 : p.cmp_k_w1;
      const int n = tid & 127, part = tid >> 7;
      float s = 0.f;
      for (int k = part * 512; k < part * 512 + 512; ++k) s += pe[k] * w1[(size_t)k * 128 + n];
      fl[part * 128 + n] = s;
      __syncthreads();
      if (tid < 128) ((float*)(ws + WS_BOOK + BK_CB1))[kv * 128 + tid] = fl[tid] + fl[128 + tid] + fl[256 + tid] + fl[384 + tid];
      __syncthreads();
    } else if (it < O_WOUT) {
      const int j = it - O_WIN, kt = j / 40, ntl = j % 40, n0 = ntl * 64;
      int drow0;
      if (n0 < 512) drow0 = (n0 >> 7) * 256 + (n0 & 127);
      else if (n0 < 1024) { const int cc = n0 - 512; drow0 = (cc >> 7) * 256 + 128 + (cc & 127); }
      else drow0 = n0;
      conv_tile(p.w_in, IN_COLS, IN_COLS, kt * 64, n0, (bf16_t*)(dout + DO_WIN), 1024, drow0, fl);
    } else if (it < O_C1) {
      const int j = it - O_WOUT, kt = j >> 4, ntl = j & 15;
      conv_tile(p.w_out, 1024, 1024, kt * 64, ntl * 64, (bf16_t*)(dout + DO_WOUT), 1024, ntl * 64, fl);
    } else if (it < O_C2) {
      const int j = it - O_C1, kv = j >> 6, jj = j & 63, kt = jj >> 1, ntl = jj & 1;
      conv_tile(kv ? p.cmp_v_w1 : p.cmp_k_w1, 128, 128, kt * 64, ntl * 64, (bf16_t*)(dout + (kv ? DO_CV1 : DO_CK1)), 2048, ntl * 64, fl);
    } else if (it < O_GU) {
      const int j = it - O_C2, kv = j >> 1, kt = j & 1;
      conv_tile(kv ? p.cmp_v_w2 : p.cmp_k_w2, 64, 64, kt * 64, 0, (bf16_t*)(dout + (kv ? DO_CV2 : DO_CK2)), 128, 0, fl);
    } else if (it < O_WD) {
      const int j = it - O_GU, e = j >> 9, r = j & 511, gu = r >> 8, kt = (r >> 4) & 15, ntl = r & 15, n0 = ntl * 64;
      const float* src = (gu ? p.w_up : p.w_gate) + (size_t)e * 1024 * 1024;
      const int drow0 = (n0 >> 7) * 256 + gu * 128 + (n0 & 127);
      conv_tile(src, 1024, 1024, kt * 64, n0, (bf16_t*)(ws + WS_WGU) + (size_t)e * 2048 * 1024, 1024, drow0, fl);
    } else {
      const int j = it - O_WD, e = j >> 8, r = j & 255, kt = r >> 4, ntl = r & 15;
      conv_tile(p.w_down + (size_t)e * 1024 * 1024, 1024, 1024, kt * 64, ntl * 64, (bf16_t*)(dout + DO_WD) + (size_t)e * 1024 * 1024, 1024, ntl * 64, fl);
    }
  }
}

__device__ __forceinline__ void phase1(const Params& p) {
  const int tid = my_tid(), wid = tid >> 6, lane = tid & 63;
  const float* MOD = (const float*)(p.ws + WS_BOOK + BK_MOD);
  bf16_t* H = (bf16_t*)(p.ws + WS_H);
  for (int it = blockIdx.x; it < T_TOK / 128; it += gridDim.x) {
    const int t0 = it * 128, b = t0 / SEQ;
    f32x4 sc[4], sh[4];
#pragma unroll
    for (int j = 0; j < 4; ++j) {
      const int d = j * 256 + lane * 4;
      const f32x4 g = *(const f32x4*)(p.norm1_g + d);
      const f32x4 s1 = *(const f32x4*)(MOD + b * 6144 + 1024 + d);
      sh[j] = *(const f32x4*)(MOD + b * 6144 + d);
      sc[j] = g * (s1 + 1.0f);
    }
    for (int tt = wid; tt < 128; tt += 8) {
      const int t = t0 + tt;
      f32x4 v[4]; float ss = 0.f;
#pragma unroll
      for (int j = 0; j < 4; ++j) { v[j] = *(const f32x4*)(p.x + (size_t)t * DM + j * 256 + lane * 4); ss += v[j][0] * v[j][0] + v[j][1] * v[j][1] + v[j][2] * v[j][2] + v[j][3] * v[j][3]; }
      ss = wave_sum(ss);
      const float rstd = rsqrtf(ss * (1.0f / DM) + NORM_EPS);
#pragma unroll
      for (int j = 0; j < 4; ++j) {
        const f32x4 o = v[j] * rstd * sc[j] + sh[j];
        u32x2 w; w.x = pack2(o[0], o[1]); w.y = pack2(o[2], o[3]);
        *(u32x2*)(H + (size_t)t * DM + j * 256 + lane * 4) = w;
      }
    }
  }
}

namespace gm {
constexpr int BM = 256, BK = 64, HALF = 128, HTB = HALF * BK * 2, STAGE_BYTES = 8 * HTB, KDIM = 1024, NT = KDIM / BK;
__device__ __forceinline__ int lds_byte(int r, int c) { const int st = (r >> 4) * 2 + (c >> 5), rr = r & 15, cc = c & 31, ob = rr * 64 + cc * 2; return st * 1024 + (ob ^ (((ob >> 9) & 1) << 5)); }
__device__ __forceinline__ void stage_rc(int b, int& R, int& C) { const int st = b / 1024, sb = b % 1024, swz = sb ^ (((sb >> 9) & 1) << 5); R = (st >> 1) * 16 + swz / 64; C = (st & 1) * 32 + (swz % 64) / 2; }
__device__ __forceinline__ int perm32(int rho) { const int n = rho >> 4, i = rho & 15; return 8 * (i >> 2) + 4 * n + (i & 3); }

struct Unit {
  const char* A;
  const char* B;
  unsigned ao[2][2];
  int pm, pn, e, row0, nrows;
};

template <class Epi, class Sched>
__device__ __forceinline__ void gemm_phase(LAS unsigned char* lds, const Sched& S, const Epi& E) {
  const int tid = my_tid(), wid = __builtin_amdgcn_readfirstlane(tid >> 6), lane = tid & 63, wr = wid >> 2, wc = wid & 3, fr = lane & 15, fq = lane >> 4;
  constexpr int K = KDIM, nt = NT;
  int RA[2], CA[2]; unsigned voffB[2];
#pragma unroll
  for (int i = 0; i < 2; ++i) { int R, C; stage_rc(tid * 16 + i * 8192, R, C); const int Rb = (R & ~31) + perm32(R & 31);
    RA[i] = R; CA[i] = C; voffB[i] = (unsigned)(Rb * K + C) * 2u; }
  const size_t kstep = (size_t)(BK * 2);
  const size_t hstep = (size_t)HALF * K * 2;
  const unsigned ldsw = (unsigned)wid * 1024u;
  const int aoff = lds_byte(wr * 64 + fr, fq * 8), boff = lds_byte(wc * 32 + fr, fq * 8);
#define GM_SA(b, h) (((b) * 2 + (h)) * HTB)
#define GM_SB(b, h) ((4 + (b) * 2 + (h)) * HTB)
#define GM_STAGE(bufoff, gbase, voff) do { _Pragma("unroll") for (int _i = 0; _i < 2; ++_i) \
    __builtin_amdgcn_global_load_lds((const unsigned*)((const char*)(gbase) + (voff)[_i]), (LAS unsigned*)(lds + (bufoff) + ldsw + _i * 8192), 16, 0, 0); } while (0)
#define GM_LDA(dst, b, h) do { _Pragma("unroll") for (int m = 0; m < 4; ++m) _Pragma("unroll") for (int k = 0; k < 2; ++k) dst[m][k] = *(const LAS bf16x8*)(lds + GM_SA(b, h) + aoff + m * 2048 + k * 1024); } while (0)
#define GM_LDB(dst, b, h) do { _Pragma("unroll") for (int n = 0; n < 2; ++n) _Pragma("unroll") for (int k = 0; k < 2; ++k) dst[n][k] = *(const LAS bf16x8*)(lds + GM_SB(b, h) + boff + n * 2048 + k * 1024); } while (0)
#define GM_MMA(ai, bj, At, Bt) do { __builtin_amdgcn_s_setprio(1); _Pragma("unroll") for (int m = 0; m < 4; ++m) _Pragma("unroll") for (int n = 0; n < 2; ++n) _Pragma("unroll") for (int k = 0; k < 2; ++k) \
    acc[ai][bj][m][n] = __builtin_amdgcn_mfma_f32_16x16x32_bf16(Bt[n][k], At[m][k], acc[ai][bj][m][n], 0, 0, 0); __builtin_amdgcn_s_setprio(0); } while (0)
#define GM_WAIT_V(n) asm volatile("s_waitcnt vmcnt(" #n ")" ::: "memory")
#define GM_WAIT_L(n) asm volatile("s_waitcnt lgkmcnt(" #n ")" ::: "memory")
#define GM_BAR __builtin_amdgcn_s_barrier()
#define GM_SCHED __builtin_amdgcn_sched_barrier(0)
  Unit cur, nxt; int ui = 0;
  if (!S.next(0, cur, RA, CA)) return;
  f32x4 acc[2][2][4][2];
#pragma unroll
  for (int a = 0; a < 2; ++a)
#pragma unroll
    for (int b = 0; b < 2; ++b)
#pragma unroll
      for (int m = 0; m < 4; ++m)
#pragma unroll
        for (int n = 0; n < 2; ++n) acc[a][b][m][n] = (f32x4){0.f, 0.f, 0.f, 0.f};
  bf16x8 At[4][2], B0[2][2], B1[2][2];
  const char* cA = cur.A; const char* cB = cur.B;
  unsigned cao0[2] = {cur.ao[0][0], cur.ao[0][1]}, cao1[2] = {cur.ao[1][0], cur.ao[1][1]};
  GM_STAGE(GM_SB(0, 0), cB, voffB); GM_STAGE(GM_SA(0, 0), cA, cao0); GM_STAGE(GM_SB(0, 1), cB + hstep, voffB); GM_STAGE(GM_SA(0, 1), cA, cao1);
  if (wr == 1) GM_BAR;
  GM_WAIT_V(4); GM_BAR;
  GM_STAGE(GM_SB(1, 0), cB + kstep, voffB); GM_STAGE(GM_SA(1, 0), cA + kstep, cao0); GM_STAGE(GM_SB(1, 1), cB + hstep + kstep, voffB);
  GM_WAIT_V(6); GM_BAR;
  for (;;) {
    const bool has_next = S.next(ui + 1, nxt, RA, CA);
    const char* nA = has_next ? nxt.A : cA; const char* nB = has_next ? nxt.B : cB;
    unsigned nao0[2], nao1[2];
    nao0[0] = has_next ? nxt.ao[0][0] : cao0[0]; nao0[1] = has_next ? nxt.ao[0][1] : cao0[1];
    nao1[0] = has_next ? nxt.ao[1][0] : cao1[0]; nao1[1] = has_next ? nxt.ao[1][1] : cao1[1];
    for (int t = 0; t < nt; t += 2) {
      const bool last = (t == nt - 2);
      const char* a1 = cA + (size_t)(t + 1) * kstep;
      const char* a2 = last ? nA : cA + (size_t)(t + 2) * kstep; const char* b2 = last ? nB : cB + (size_t)(t + 2) * kstep;
      const char* a3 = a2 + kstep; const char* b3 = b2 + kstep;
      unsigned x0[2], x1[2];
      x0[0] = last ? nao0[0] : cao0[0]; x0[1] = last ? nao0[1] : cao0[1];
      x1[0] = last ? nao1[0] : cao1[0]; x1[1] = last ? nao1[1] : cao1[1];
      GM_LDB(B0, 0, 0); GM_SCHED; GM_LDA(At, 0, 0); GM_STAGE(GM_SA(1, 1), a1, cao1);
      GM_WAIT_L(8); GM_BAR; GM_WAIT_L(0); GM_MMA(0, 0, At, B0); GM_BAR; GM_SCHED;
      GM_LDB(B1, 0, 1); GM_STAGE(GM_SB(0, 0), b2, voffB);
      GM_BAR; GM_WAIT_L(0); GM_MMA(0, 1, At, B1); GM_BAR;
      GM_LDA(At, 0, 1); GM_STAGE(GM_SA(0, 0), a2, x0);
      GM_BAR; GM_WAIT_L(0); GM_MMA(1, 0, At, B0); GM_BAR; GM_SCHED;
      GM_STAGE(GM_SB(0, 1), b2 + hstep, voffB);
      GM_WAIT_V(6); GM_BAR; GM_MMA(1, 1, At, B1); GM_BAR;
      GM_LDB(B0, 1, 0); GM_SCHED; GM_LDA(At, 1, 0); GM_STAGE(GM_SA(0, 1), a2, x1);
      GM_WAIT_L(8); GM_BAR; GM_WAIT_L(0); GM_MMA(0, 0, At, B0); GM_BAR; GM_SCHED;
      GM_LDB(B1, 1, 1); GM_STAGE(GM_SB(1, 0), b3, voffB);
      GM_BAR; GM_WAIT_L(0); GM_MMA(0, 1, At, B1); GM_BAR;
      GM_LDA(At, 1, 1); GM_STAGE(GM_SA(1, 0), a3, x0);
      GM_BAR; GM_WAIT_L(0); GM_MMA(1, 0, At, B0); GM_BAR; GM_SCHED;
      GM_STAGE(GM_SB(1, 1), b3 + hstep, voffB);
      GM_WAIT_V(6); GM_BAR; GM_MMA(1, 1, At, B1); GM_BAR;
    }
    E(acc, cur, wr, wc, fr, fq);
    if (!has_next) break;
#pragma unroll
    for (int a = 0; a < 2; ++a)
#pragma unroll
      for (int b = 0; b < 2; ++b)
#pragma unroll
        for (int m = 0; m < 4; ++m)
#pragma unroll
          for (int n = 0; n < 2; ++n) acc[a][b][m][n] = (f32x4){0.f, 0.f, 0.f, 0.f};
    cur = nxt; cA = nA; cB = nB; cao0[0] = nao0[0]; cao0[1] = nao0[1]; cao1[0] = nao1[0]; cao1[1] = nao1[1]; ++ui;
  }
  GM_WAIT_V(0);
  if (wr == 0) GM_BAR;
  GM_BAR;
#undef GM_SA
#undef GM_SB
#undef GM_STAGE
#undef GM_LDA
#undef GM_LDB
#undef GM_MMA
#undef GM_WAIT_V
#undef GM_WAIT_L
#undef GM_BAR
#undef GM_SCHED
}

__device__ __forceinline__ int unit_index(int i) {
  const int G = gridDim.x, c = blockIdx.x;
  return i * G + (c & 7) * (G >> 3) + (c >> 3);
}
}

__device__ __forceinline__ unsigned cvt_pk_bf16(float lo, float hi) { unsigned r; asm volatile("v_cvt_pk_bf16_f32 %0, %1, %2" : "=v"(r) : "v"(lo), "v"(hi)); return r; }
__device__ __forceinline__ u32x4 pack8(const f32x4& a, const f32x4& b) { u32x4 w; w.x = cvt_pk_bf16(a[0], a[1]); w.y = cvt_pk_bf16(a[2], a[3]); w.z = cvt_pk_bf16(b[0], b[1]); w.w = cvt_pk_bf16(b[2], b[3]); return w; }

struct DenseSched {
  const char* A; const char* Bt; int nN, nunits;
  __device__ __forceinline__ bool next(int i, gm::Unit& u, const int (&RA)[2], const int (&CA)[2]) const {
    const int L = gm::unit_index(i); if (L >= nunits) return false;
    u.pm = L / nN; u.pn = L - u.pm * nN; u.e = 0; u.row0 = u.pm * 256; u.nrows = 256;
    u.A = A + (size_t)u.pm * (256 * 1024 * 2); u.B = Bt + (size_t)u.pn * (256 * 1024 * 2);
#pragma unroll
    for (int h = 0; h < 2; ++h)
#pragma unroll
      for (int j = 0; j < 2; ++j) u.ao[h][j] = (unsigned)((h * 128 + RA[j]) * 1024 + CA[j]) * 2u;
    return true;
  }
};
struct GuSched {
  const char* H2; const char* W; const int* tiles; const int* rowtok; int ntiles;
  __device__ __forceinline__ bool next(int i, gm::Unit& u, const int (&RA)[2], const int (&CA)[2]) const {
    const int L = gm::unit_index(i); if (L >= ntiles * 8) return false;
    const int ti = L >> 3; u.pn = L & 7; u.pm = ti;
    u.e = __builtin_amdgcn_readfirstlane(ld_i32(tiles + ti * 4 + 0));
    u.row0 = __builtin_amdgcn_readfirstlane(ld_i32(tiles + ti * 4 + 1));
    u.nrows = __builtin_amdgcn_readfirstlane(ld_i32(tiles + ti * 4 + 2));
    u.A = H2; u.B = W + (size_t)u.e * (2048 * 1024 * 2) + (size_t)u.pn * (256 * 1024 * 2);
#pragma unroll
    for (int h = 0; h < 2; ++h)
#pragma unroll
      for (int j = 0; j < 2; ++j) { const int rl = h * 128 + RA[j]; const int tok = rowtok[u.row0 + (rl < u.nrows ? rl : 0)];
        u.ao[h][j] = (unsigned)(tok * 1024 + CA[j]) * 2u; }
    return true;
  }
};
struct DownSched {
  const char* ACT; const char* W; const int* tiles; int ntiles;
  __device__ __forceinline__ bool next(int i, gm::Unit& u, const int (&RA)[2], const int (&CA)[2]) const {
    const int L = gm::unit_index(i); if (L >= ntiles * 4) return false;
    const int ti = L >> 2; u.pn = L & 3; u.pm = ti;
    u.e = __builtin_amdgcn_readfirstlane(ld_i32(tiles + ti * 4 + 0));
    u.row0 = __builtin_amdgcn_readfirstlane(ld_i32(tiles + ti * 4 + 1));
    u.nrows = __builtin_amdgcn_readfirstlane(ld_i32(tiles + ti * 4 + 2));
    u.A = ACT + (size_t)u.row0 * 2048; u.B = W + (size_t)u.e * (1024 * 1024 * 2) + (size_t)u.pn * (256 * 1024 * 2);
#pragma unroll
    for (int h = 0; h < 2; ++h)
#pragma unroll
      for (int j = 0; j < 2; ++j) { const int rl = h * 128 + RA[j]; u.ao[h][j] = (unsigned)((rl < u.nrows ? rl : u.nrows - 1) * 1024 + CA[j]) * 2u; }
    return true;
  }
};

struct EpiProj {
  bf16_t *U, *Q, *KV; float* GATES; const float* ROPE;
  __device__ __forceinline__ void operator()(const f32x4 (&acc)[2][2][4][2], const gm::Unit& u, int wr, int wc, int fr, int fq) const {
    const int pn = u.pn;
#pragma unroll
    for (int ai = 0; ai < 2; ++ai)
#pragma unroll
      for (int m = 0; m < 4; ++m) {
        const int row = u.pm * 256 + ai * 128 + wr * 64 + m * 16 + fr;
        const int s = row & 2047, b = row >> 11;
        if (pn < 4) {
          f32x4 o[2];
#pragma unroll
          for (int n = 0; n < 2; ++n)
#pragma unroll
            for (int j = 0; j < 4; ++j) o[n][j] = acc[ai][0][m][n][j] * sigmoidf_(acc[ai][1][m][n][j]);
          *(u32x4*)(U + (size_t)row * 512 + pn * 128 + wc * 32 + 8 * fq) = pack8(o[0], o[1]);
        } else if (pn < 9) {
          const bool isq = pn < 6;
#pragma unroll
          for (int bj = 0; bj < 2; ++bj) {
            f32x4 v[2] = {acc[ai][bj][m][0], acc[ai][bj][m][1]};
            const bool dorope = (isq || bj == 0) && ((wc & 1) == 0);
            if (dorope) {
              const f32x4 c0 = *(const f32x4*)(ROPE + s * 16), c1 = *(const f32x4*)(ROPE + s * 16 + 4);
              const f32x4 s0 = *(const f32x4*)(ROPE + s * 16 + 8), s1 = *(const f32x4*)(ROPE + s * 16 + 12);
              const f32x4 cs[2] = {c0, c1}, sn[2] = {s0, s1};
              const float sgn = (fq == 0) ? -1.0f : 1.0f;
#pragma unroll
              for (int n = 0; n < 2; ++n)
#pragma unroll
                for (int j = 0; j < 4; ++j) {
                  const float other = __shfl_xor(v[n][j], 16);
                  const float r = v[n][j] * cs[n][j] + sgn * other * sn[n][j];
                  v[n][j] = (fq < 2) ? r : v[n][j];
                }
            }
            if (isq) {
              v[0] = v[0] * 0.125f; v[1] = v[1] * 0.125f;
              *(u32x4*)(Q + (size_t)row * 512 + (pn - 4) * 256 + bj * 128 + wc * 32 + 8 * fq) = pack8(v[0], v[1]);
            } else {
              const int idx = (pn - 6) * 2 + bj, g = wc >> 1, hd0 = (wc & 1) * 32 + 8 * fq;
              *(u32x4*)(KV + (size_t)idx * (16 * 2 * 2048 * 64) + ((size_t)(b * 2 + g) * 2048 + s) * 64 + hd0) = pack8(v[0], v[1]);
            }
          }
        } else {
          if (wc == 0 && fq < 3) {
#pragma unroll
            for (int n = 0; n < 2; ++n) {
              f32x4 o;
#pragma unroll
              for (int j = 0; j < 4; ++j) o[j] = sigmoidf_(acc[ai][0][m][n][j]);
              *(f32x4*)(GATES + (size_t)row * 24 + 8 * fq + 4 * n) = o;
            }
          }
        }
      }
  }
};
struct EpiOut {
  bf16_t* D1; const float* MOD;
  __device__ __forceinline__ void operator()(const f32x4 (&acc)[2][2][4][2], const gm::Unit& u, int wr, int wc, int fr, int fq) const {
#pragma unroll
    for (int bj = 0; bj < 2; ++bj) {
      const int col0 = u.pn * 256 + bj * 128 + wc * 32 + 8 * fq;
      const int b = (u.pm * 256) >> 11;
      const f32x4 g0 = *(const f32x4*)(MOD + b * 6144 + 2048 + col0), g1 = *(const f32x4*)(MOD + b * 6144 + 2048 + col0 + 4);
#pragma unroll
      for (int ai = 0; ai < 2; ++ai)
#pragma unroll
        for (int m = 0; m < 4; ++m) {
          const int row = u.pm * 256 + ai * 128 + wr * 64 + m * 16 + fr;
          *(u32x4*)(D1 + (size_t)row * 1024 + col0) = pack8(acc[ai][bj][m][0] * g0, acc[ai][bj][m][1] * g1);
        }
    }
  }
};
struct EpiGU {
  bf16_t* ACT; const float* bg; const float* bu;
  __device__ __forceinline__ void operator()(const f32x4 (&acc)[2][2][4][2], const gm::Unit& u, int wr, int wc, int fr, int fq) const {
    const int f0 = u.pn * 128 + wc * 32 + 8 * fq;
    const f32x4 bg0 = *(const f32x4*)(bg + u.e * 1024 + f0), bg1 = *(const f32x4*)(bg + u.e * 1024 + f0 + 4);
    const f32x4 bu0 = *(const f32x4*)(bu + u.e * 1024 + f0), bu1 = *(const f32x4*)(bu + u.e * 1024 + f0 + 4);
#pragma unroll
    for (int ai = 0; ai < 2; ++ai)
#pragma unroll
      for (int m = 0; m < 4; ++m) {
        const int rl = ai * 128 + wr * 64 + m * 16 + fr;
        f32x4 o[2];
#pragma unroll
        for (int n = 0; n < 2; ++n)
#pragma unroll
          for (int j = 0; j < 4; ++j) {
            float g = acc[ai][0][m][n][j] + (n ? bg1[j] : bg0[j]);
            float uu = acc[ai][1][m][n][j] + (n ? bu1[j] : bu0[j]);
            g = fminf(g, 7.0f); uu = fminf(fmaxf(uu, -7.0f), 7.0f);
            o[n][j] = g * sigmoidf_(1.702f * g) * (uu + 1.0f);
          }
        if (rl < u.nrows) *(u32x4*)(ACT + (size_t)(u.row0 + rl) * 1024 + f0) = pack8(o[0], o[1]);
      }
  }
};
struct EpiDown {
  bf16_t* Y; const float* bd;
  __device__ __forceinline__ void operator()(const f32x4 (&acc)[2][2][4][2], const gm::Unit& u, int wr, int wc, int fr, int fq) const {
#pragma unroll
    for (int bj = 0; bj < 2; ++bj) {
      const int col0 = u.pn * 256 + bj * 128 + wc * 32 + 8 * fq;
      const f32x4 b0 = *(const f32x4*)(bd + u.e * 1024 + col0), b1 = *(const f32x4*)(bd + u.e * 1024 + col0 + 4);
#pragma unroll
      for (int ai = 0; ai < 2; ++ai)
#pragma unroll
        for (int m = 0; m < 4; ++m) {
          const int rl = ai * 128 + wr * 64 + m * 16 + fr;
          if (rl < u.nrows) *(u32x4*)(Y + (size_t)(u.row0 + rl) * 1024 + col0) = pack8(acc[ai][bj][m][0] + b0, acc[ai][bj][m][1] + b1);
        }
    }
  }
};

__device__ __forceinline__ void phase3_naive(const Params& p, LAS unsigned char* smem) {
  const int tid = my_tid();
  LAS float* fl = (LAS float*)smem;
  LAS float* red = fl;
  unsigned char* ws = p.ws; unsigned char* dout = (unsigned char*)p.out;
  const bf16_t* U = (const bf16_t*)(ws + WS_U);
  bf16_t* MIX = (bf16_t*)(ws + WS_MIX);
  constexpr int I_CONV = T_TOK / 16;
  constexpr int I_CMP = 2 * 1016;
  for (int it = blockIdx.x; it < I_CONV + I_CMP + 1; it += gridDim.x) {
    if (it < I_CONV) {
      const int c = tid;
      float w[31];
#pragma unroll
      for (int k = 0; k < 31; ++k) w[k] = p.conv_w[k * 512 + c];
      const float cb = p.conv_b[c], lg = p.conv_ln_g[c], lb = p.conv_ln_b[c], og = p.out_norm_conv[c];
      for (int tt = 0; tt < 16; ++tt) {
        const int t = it * 16 + tt, s = t & 2047;
        float y = cb;
#pragma unroll
        for (int k = 0; k < 31; ++k) { const int sp = s - 30 + k; if (sp >= 0) y += w[k] * bf2f(U[(size_t)(t - 30 + k) * 512 + c]); }
        const float mean = block_sum(y, red) * (1.0f / 512.0f);
        const float d = y - mean;
        const float var = block_sum(d * d, red) * (1.0f / 512.0f);
        float v = d * rsqrtf(var + NORM_EPS) * lg + lb;
        v = v * sigmoidf_(v);
        const float ms = block_sum(v * v, red) * (1.0f / 512.0f);
        MIX[(size_t)t * 1024 + c] = f2bf(v * rsqrtf(ms + NORM_EPS) * og);
      }
    } else if (it < I_CONV + I_CMP) {
      const int j = it - I_CONV, kv = j / 1016, r0 = (j % 1016) * 4;
      const bf16_t* X = (const bf16_t*)(ws + WS_KV) + (size_t)kv * (16 * 2 * 2048 * 64);
      const bf16_t* W1T = (const bf16_t*)(dout + (kv ? DO_CV1 : DO_CK1));
      const bf16_t* W2T = (const bf16_t*)(dout + (kv ? DO_CV2 : DO_CK2));
      const float* b1 = (const float*)(ws + WS_BOOK + BK_CB1) + kv * 128;
      bf16_t* OUT = (bf16_t*)(ws + WS_BOOK + (kv ? BK_VCMP : BK_KCMP));
      LAS float* hid = fl + 64;
      {
        const int rl = tid >> 7, n = tid & 127, r = r0 + rl;
        const int g = r & 1, bc = r >> 1, cidx = bc % 127, b = bc / 127;
        const bf16_t* a = X + ((size_t)(b * 2 + g) * 2048 + 16 * cidx) * 64;
        const bf16_t* wrow = W1T + (size_t)n * 2048;
        float acc = 0.f;
        for (int k = 0; k < 2048; k += 8) {
          const bf16x8 av = *(const bf16x8*)(a + k), wv = *(const bf16x8*)(wrow + k);
#pragma unroll
          for (int q = 0; q < 8; ++q) acc += bf2f((bf16_t)av[q]) * bf2f((bf16_t)wv[q]);
        }
        acc += b1[n];
        hid[rl * 128 + n] = acc * sigmoidf_(acc);
      }
      __syncthreads();
      if (tid < 256) {
        const int rl = tid >> 6, d = tid & 63, r = r0 + rl;
        const int g = r & 1, bc = r >> 1, cidx = bc % 127, b = bc / 127;
        float acc = 0.f;
        for (int n = 0; n < 128; ++n) acc += hid[rl * 128 + n] * bf2f(W2T[d * 128 + n]);
        OUT[((size_t)(b * 2 + g) * 128 + cidx) * 64 + d] = f2bf(acc);
      }
      __syncthreads();
    } else {
      bf16_t* KC = (bf16_t*)(ws + WS_BOOK + BK_KCMP); bf16_t* VC = (bf16_t*)(ws + WS_BOOK + BK_VCMP);
      for (int i = tid; i < 32 * 64; i += NTHR) { const int bg = i >> 6, d = i & 63; KC[((size_t)bg * 128 + 127) * 64 + d] = 0; VC[((size_t)bg * 128 + 127) * 64 + d] = 0; }
    }
  }
}

__device__ __forceinline__ void phase3(const Params& p, LAS unsigned char* smem) {
  const int tid = my_tid(), wid = __builtin_amdgcn_readfirstlane(tid >> 6), lane = tid & 63;
  unsigned char* ws = p.ws; unsigned char* dout = (unsigned char*)p.out;
  for (int it = blockIdx.x; it < 128; it += gridDim.x) {
    const int kv = it >> 6, bg = (it >> 1) & 31, mh = it & 1;
    const bf16_t* X = (const bf16_t*)(ws + WS_KV) + (size_t)kv * (16 * 2 * 2048 * 64) + (size_t)bg * 2048 * 64;
    const bf16_t* W1T = (const bf16_t*)(dout + (kv ? DO_CV1 : DO_CK1));
    const bf16_t* W2T = (const bf16_t*)(dout + (kv ? DO_CV2 : DO_CK2));
    const float* b1 = (const float*)(ws + WS_BOOK + BK_CB1) + kv * 128;
    bf16_t* OUT = (bf16_t*)(ws + WS_BOOK + (kv ? BK_VCMP : BK_KCMP)) + (size_t)bg * 128 * 64;
    const int fr = lane & 15, fq = lane >> 4;
    f32x4 acc[4];
#pragma unroll
    for (int mt = 0; mt < 4; ++mt) acc[mt] = (f32x4){0.f, 0.f, 0.f, 0.f};
    const bf16_t* arow = X + (size_t)(64 * mh + fr) * 1024 + 8 * fq;
    const bf16_t* brow = W1T + (size_t)(16 * wid + fr) * 2048 + 8 * fq;
#pragma unroll 2
    for (int s = 0; s < 64; ++s) {
      const bf16x8 bf = *(const bf16x8*)(brow + 32 * s);
#pragma unroll
      for (int mt = 0; mt < 4; ++mt) {
        const bf16x8 af = *(const bf16x8*)(arow + (size_t)mt * 16 * 1024 + 32 * s);
        acc[mt] = __builtin_amdgcn_mfma_f32_16x16x32_bf16(af, bf, acc[mt], 0, 0, 0);
      }
    }
    LAS bf16_t* hid = (LAS bf16_t*)smem;
    __syncthreads();
    {
      const float bb = b1[16 * wid + fr];
#pragma unroll
      for (int mt = 0; mt < 4; ++mt)
#pragma unroll
        for (int j = 0; j < 4; ++j) { const float v = acc[mt][j] + bb; hid[(16 * mt + 4 * fq + j) * 136 + 16 * wid + fr] = f2bf(v * sigmoidf_(v)); }
    }
    __syncthreads();
    {
      const int mt = wid >> 1;
#pragma unroll
      for (int q = 0; q < 2; ++q) {
        const int nt = 2 * (wid & 1) + q;
        f32x4 o = (f32x4){0.f, 0.f, 0.f, 0.f};
#pragma unroll
        for (int s = 0; s < 4; ++s) {
          const bf16x8 af = *(const LAS bf16x8*)(hid + (16 * mt + fr) * 136 + 32 * s + 8 * fq);
          const bf16x8 bf = *(const bf16x8*)(W2T + (size_t)(16 * nt + fr) * 128 + 32 * s + 8 * fq);
          o = __builtin_amdgcn_mfma_f32_16x16x32_bf16(af, bf, o, 0, 0, 0);
        }
#pragma unroll
        for (int j = 0; j < 4; ++j) { const int c = 64 * mh + 16 * mt + 4 * fq + j; if (c < 127) OUT[(size_t)c * 64 + 16 * nt + fr] = f2bf(o[j]); }
      }
    }
    if (mh == 1 && tid < 64) OUT[(size_t)127 * 64 + tid] = 0;
  }
  __syncthreads();
  {
    const bf16_t* U = (const bf16_t*)(ws + WS_U);
    bf16_t* MIX = (bf16_t*)(ws + WS_MIX);
    LAS float* ybuf = (LAS float*)smem;
    const int c = tid;
    float w[31];
#pragma unroll
    for (int k = 0; k < 31; ++k) w[k] = p.conv_w[k * 512 + c];
    const float cb = p.conv_b[c];
    f32x4 lg[2], lb[2], og[2];
#pragma unroll
    for (int q = 0; q < 2; ++q) { lg[q] = *(const f32x4*)(p.conv_ln_g + lane * 8 + 4 * q); lb[q] = *(const f32x4*)(p.conv_ln_b + lane * 8 + 4 * q); og[q] = *(const f32x4*)(p.out_norm_conv + lane * 8 + 4 * q); }
    for (int it = blockIdx.x; it < T_TOK / 32; it += gridDim.x) {
      const int t0 = it * 32, s0 = t0 & 2047;
      float u[62];
#pragma unroll
      for (int i = 0; i < 62; ++i) u[i] = (s0 - 30 + i >= 0) ? bf2f(U[(size_t)(t0 - 30 + i) * 512 + c]) : 0.f;
      __syncthreads();
#pragma unroll
      for (int i = 0; i < 32; ++i) {
        float y = cb;
#pragma unroll
        for (int k = 0; k < 31; ++k) y += w[k] * u[i + k];
        ybuf[i * 512 + c] = y;
      }
      __syncthreads();
#pragma unroll
      for (int q4 = 0; q4 < 4; ++q4) {
        const int i = wid * 4 + q4, t = t0 + i;
        const f32x4 y0 = *(const LAS f32x4*)(ybuf + i * 512 + lane * 8), y1 = *(const LAS f32x4*)(ybuf + i * 512 + lane * 8 + 4);
        const float mean = wave_sum((y0[0] + y0[1]) + (y0[2] + y0[3]) + (y1[0] + y1[1]) + (y1[2] + y1[3])) * (1.0f / 512.0f);
        const f32x4 d0 = y0 - mean, d1 = y1 - mean;
        const float var = wave_sum(d0[0] * d0[0] + d0[1] * d0[1] + d0[2] * d0[2] + d0[3] * d0[3] + d1[0] * d1[0] + d1[1] * d1[1] + d1[2] * d1[2] + d1[3] * d1[3]) * (1.0f / 512.0f);
        const float rs = rsqrtf(var + NORM_EPS);
        f32x4 v0 = d0 * rs * lg[0] + lb[0], v1 = d1 * rs * lg[1] + lb[1];
#pragma unroll
        for (int e = 0; e < 4; ++e) { v0[e] = v0[e] * sigmoidf_(v0[e]); v1[e] = v1[e] * sigmoidf_(v1[e]); }
        const float ms = wave_sum(v0[0] * v0[0] + v0[1] * v0[1] + v0[2] * v0[2] + v0[3] * v0[3] + v1[0] * v1[0] + v1[1] * v1[1] + v1[2] * v1[2] + v1[3] * v1[3]) * (1.0f / 512.0f);
        const float r2 = rsqrtf(ms + NORM_EPS);
        v0 = v0 * r2 * og[0]; v1 = v1 * r2 * og[1];
        *(u32x4*)(MIX + (size_t)t * 1024 + lane * 8) = pack8(v0, v1);
      }
    }
  }
}

__device__ __forceinline__ void phase4_naive(const Params& p, LAS unsigned char* smem) {
  const int tid = my_tid();
  unsigned char* ws = p.ws;
  LAS float* imp = (LAS float*)smem;
  const bf16_t* Q = (const bf16_t*)(ws + WS_Q);
  const bf16_t* KC = (const bf16_t*)(ws + WS_BOOK + BK_KCMP);
  const bf16_t* VC = (const bf16_t*)(ws + WS_BOOK + BK_VCMP);
  const float* GATES = (const float*)(ws + WS_GATES);
  bf16_t* OC = (bf16_t*)(ws + WS_OC);
  unsigned* SEL = (unsigned*)(ws + WS_BOOK + BK_SEL);
  for (int it = blockIdx.x; it < 65536 / NTHR; it += gridDim.x) {
    const int gi = it * NTHR + tid;
    const int t = gi & 2047, g = (gi >> 11) & 1, b = gi >> 12;
    const int tok = b * 2048 + t;
    const int ncv = (t >= 31) ? ((t - 31) >> 4) + 1 : 0;
    const bf16_t* kc = KC + (size_t)(b * 2 + g) * 128 * 64;
    const bf16_t* vc = VC + (size_t)(b * 2 + g) * 128 * 64;
#pragma unroll
    for (int j = 0; j < 32; ++j) imp[j * NTHR + tid] = 0.f;
    for (int n = 0; n < 4; ++n) {
      const int head = g * 4 + n;
      bf16x8 qp[8];
#pragma unroll
      for (int d8 = 0; d8 < 8; ++d8) qp[d8] = *(const bf16x8*)(Q + (size_t)tok * 512 + head * 64 + d8 * 8);
      float o[64];
#pragma unroll
      for (int d = 0; d < 64; ++d) o[d] = 0.f;
      if (ncv > 0) {
        float m = -1e30f;
#pragma unroll 1
        for (int c = 0; c < ncv; ++c) {
          float s = 0.f;
#pragma unroll
          for (int d8 = 0; d8 < 8; ++d8) { const bf16x8 v = *(const bf16x8*)(kc + c * 64 + d8 * 8);
#pragma unroll
            for (int e = 0; e < 8; ++e) s += bf2f((bf16_t)qp[d8][e]) * bf2f((bf16_t)v[e]); }
          m = fmaxf(m, s);
        }
        float l = 0.f;
#pragma unroll 1
        for (int c = 0; c < ncv; ++c) {
          float s = 0.f;
#pragma unroll
          for (int d8 = 0; d8 < 8; ++d8) { const bf16x8 v = *(const bf16x8*)(kc + c * 64 + d8 * 8);
#pragma unroll
            for (int e = 0; e < 8; ++e) s += bf2f((bf16_t)qp[d8][e]) * bf2f((bf16_t)v[e]); }
          l += __expf(s - m);
        }
        const float il = 1.0f / l;
#pragma unroll 1
        for (int c = 0; c < ncv; ++c) {
          float s = 0.f;
#pragma unroll
          for (int d8 = 0; d8 < 8; ++d8) { const bf16x8 v = *(const bf16x8*)(kc + c * 64 + d8 * 8);
#pragma unroll
            for (int e = 0; e < 8; ++e) s += bf2f((bf16_t)qp[d8][e]) * bf2f((bf16_t)v[e]); }
          const float pr = __expf(s - m) * il;
#pragma unroll
          for (int d8 = 0; d8 < 8; ++d8) { const bf16x8 v = *(const bf16x8*)(vc + c * 64 + d8 * 8);
#pragma unroll
            for (int e = 0; e < 8; ++e) o[d8 * 8 + e] += pr * bf2f((bf16_t)v[e]); }
          imp[(c >> 2) * NTHR + tid] += pr;
          if ((c & 3) == 3 && ((c + 1) >> 2) < 32) imp[((c + 1) >> 2) * NTHR + tid] += pr;
        }
      }
      const float g0 = GATES[(size_t)tok * 24 + head * 3 + 0];
#pragma unroll
      for (int d8 = 0; d8 < 8; ++d8) {
        u32x4 w; w.x = pack2(g0 * o[d8 * 8 + 0], g0 * o[d8 * 8 + 1]); w.y = pack2(g0 * o[d8 * 8 + 2], g0 * o[d8 * 8 + 3]);
        w.z = pack2(g0 * o[d8 * 8 + 4], g0 * o[d8 * 8 + 5]); w.w = pack2(g0 * o[d8 * 8 + 6], g0 * o[d8 * 8 + 7]);
        *(u32x4*)(OC + (size_t)tok * 512 + head * 64 + d8 * 8) = w;
      }
    }
    const int cur = t >> 6, nvalid = cur + 1;
    unsigned mask;
    if (nvalid <= 16) mask = (1u << nvalid) - 1u;
    else {
      mask = 0u;
      for (int j = 0; j <= cur; ++j) {
        const bool fj = (j == 0) || (j == cur) || (j == cur - 1);
        const float sj = fj ? 1e9f : imp[j * NTHR + tid];
        int rank = 0;
        for (int i = 0; i <= cur; ++i) {
          const bool fi = (i == 0) || (i == cur) || (i == cur - 1);
          const float si = fi ? 1e9f : imp[i * NTHR + tid];
          rank += (si > sj || (si == sj && i < j)) ? 1 : 0;
        }
        if (rank < 16) mask |= (1u << j);
      }
    }
    SEL[gi] = mask;
  }
}

template <bool SELECTED>
__device__ __forceinline__ void phase56_naive(const Params& p) {
  const int tid = my_tid();
  unsigned char* ws = p.ws;
  const bf16_t* Q = (const bf16_t*)(ws + WS_Q);
  const bf16_t* KB = (const bf16_t*)(ws + WS_KV) + (size_t)(SELECTED ? 2 : 4) * (16 * 2 * 2048 * 64);
  const bf16_t* VB = (const bf16_t*)(ws + WS_KV) + (size_t)(SELECTED ? 3 : 5) * (16 * 2 * 2048 * 64);
  const float* GATES = (const float*)(ws + WS_GATES);
  const unsigned* SEL = (const unsigned*)(ws + WS_BOOK + BK_SEL);
  bf16_t* O = (bf16_t*)(ws + (SELECTED ? WS_OS : WS_OW));
  for (int it = blockIdx.x; it < (T_TOK * 8) / NTHR; it += gridDim.x) {
    const int gi = it * NTHR + tid;
    const int t = gi & 2047, head = (gi >> 11) & 7, b = gi >> 14, g = head >> 2;
    const int tok = b * 2048 + t;
    const bf16_t* kb = KB + (size_t)(b * 2 + g) * 2048 * 64;
    const bf16_t* vb = VB + (size_t)(b * 2 + g) * 2048 * 64;
    bf16x8 qp[8]; float o[64];
#pragma unroll
    for (int d8 = 0; d8 < 8; ++d8) { qp[d8] = *(const bf16x8*)(Q + (size_t)tok * 512 + head * 64 + d8 * 8);
#pragma unroll
      for (int e = 0; e < 8; ++e) o[d8 * 8 + e] = 0.f; }
    float m = -1e30f, l = 0.f;
    const unsigned mask = SELECTED ? SEL[(b * 2 + g) * 2048 + t] : 0u;
    const int k_lo = SELECTED ? 0 : (t - 511 > 0 ? t - 511 : 0);
#pragma unroll 1
    for (int key = k_lo; key <= t; ++key) {
      if (SELECTED && !((mask >> (key >> 6)) & 1u)) { key |= 63; continue; }
      float s = 0.f;
#pragma unroll
      for (int d8 = 0; d8 < 8; ++d8) { const bf16x8 v = *(const bf16x8*)(kb + (size_t)key * 64 + d8 * 8);
#pragma unroll
        for (int e = 0; e < 8; ++e) s += bf2f((bf16_t)qp[d8][e]) * bf2f((bf16_t)v[e]); }
      const float mn = fmaxf(m, s), a = __expf(m - mn), pr = __expf(s - mn);
      l = l * a + pr; m = mn;
#pragma unroll
      for (int d8 = 0; d8 < 8; ++d8) { const bf16x8 v = *(const bf16x8*)(vb + (size_t)key * 64 + d8 * 8);
#pragma unroll
        for (int e = 0; e < 8; ++e) o[d8 * 8 + e] = o[d8 * 8 + e] * a + pr * bf2f((bf16_t)v[e]); }
    }
    const float gt = GATES[(size_t)tok * 24 + head * 3 + (SELECTED ? 1 : 2)] / l;
#pragma unroll
    for (int d8 = 0; d8 < 8; ++d8) {
      u32x4 w; w.x = pack2(gt * o[d8 * 8 + 0], gt * o[d8 * 8 + 1]); w.y = pack2(gt * o[d8 * 8 + 2], gt * o[d8 * 8 + 3]);
      w.z = pack2(gt * o[d8 * 8 + 4], gt * o[d8 * 8 + 5]); w.w = pack2(gt * o[d8 * 8 + 6], gt * o[d8 * 8 + 7]);
      *(u32x4*)(O + (size_t)tok * 512 + head * 64 + d8 * 8) = w;
    }
  }
}

typedef float f32x16 __attribute__((ext_vector_type(16)));
typedef short s16x4 __attribute__((ext_vector_type(4)));
typedef __attribute__((address_space(3))) s16x4 lds_s16x4;
constexpr int AT_KSTR = 144, AT_VSTR = 192, AT_VOFF = 64 * AT_KSTR, AT_TILE = 64 * AT_KSTR + 64 * AT_VSTR;

__device__ __forceinline__ bf16x8 cat4(s16x4 a, s16x4 b) { bf16x8 r; r[0] = a[0]; r[1] = a[1]; r[2] = a[2]; r[3] = a[3]; r[4] = b[0]; r[5] = b[1]; r[6] = b[2]; r[7] = b[3]; return r; }

template <class MaskF>
__device__ __forceinline__ void attn_tile(LAS unsigned char* buf, const bf16x8 (&qf)[4], f32x16 (&O)[2], float& m, float& l, int lane, bool need_mask, const MaskF& kmask) {
  const int h = lane >> 5, l31 = lane & 31;
  f32x16 s[2];
#pragma unroll
  for (int kb = 0; kb < 2; ++kb)
#pragma unroll
    for (int r = 0; r < 16; ++r) s[kb][r] = 0.f;
#pragma unroll
  for (int ks = 0; ks < 4; ++ks) {
#pragma unroll
    for (int kb = 0; kb < 2; ++kb) {
      const bf16x8 a = *(const LAS bf16x8*)(buf + (kb * 32 + l31) * AT_KSTR + (2 * ks + h) * 16);
      s[kb] = __builtin_amdgcn_mfma_f32_32x32x16_bf16(a, qf[ks], s[kb], 0, 0, 0);
    }
  }
  if (need_mask) {
#pragma unroll
    for (int kb = 0; kb < 2; ++kb)
#pragma unroll
      for (int r = 0; r < 16; ++r) s[kb][r] = kmask(kb, r) ? s[kb][r] : -1e30f;
  }
  float mx = s[0][0];
#pragma unroll
  for (int kb = 0; kb < 2; ++kb)
#pragma unroll
    for (int r = 0; r < 16; ++r) mx = fmaxf(mx, s[kb][r]);
  mx = fmaxf(mx, __shfl_xor(mx, 32));
  const float mn = fmaxf(m, mx);
  const float alpha = __expf(m - mn);
  m = mn;
  float ls = 0.f;
#pragma unroll
  for (int kb = 0; kb < 2; ++kb)
#pragma unroll
    for (int r = 0; r < 16; ++r) { s[kb][r] = __expf(s[kb][r] - mn); ls += s[kb][r]; }
  l = l * alpha + ls;
#pragma unroll
  for (int dt = 0; dt < 2; ++dt)
#pragma unroll
    for (int r = 0; r < 16; ++r) O[dt][r] *= alpha;
  bf16x8 pb[2][2];
#pragma unroll
  for (int kb = 0; kb < 2; ++kb)
#pragma unroll
    for (int sx = 0; sx < 2; ++sx) {
      u32x4 w; w.x = cvt_pk_bf16(s[kb][8 * sx + 0], s[kb][8 * sx + 1]); w.y = cvt_pk_bf16(s[kb][8 * sx + 2], s[kb][8 * sx + 3]);
      w.z = cvt_pk_bf16(s[kb][8 * sx + 4], s[kb][8 * sx + 5]); w.w = cvt_pk_bf16(s[kb][8 * sx + 6], s[kb][8 * sx + 7]);
      pb[kb][sx] = __builtin_bit_cast(bf16x8, w);
    }
  const int blk = (lane >> 4) & 1, q = (lane & 15) >> 2, pp = lane & 3;
  LAS unsigned char* vbase = buf + AT_VOFF + (4 * h + q) * AT_VSTR + (16 * blk + 4 * pp) * 2;
#pragma unroll
  for (int dt = 0; dt < 2; ++dt)
#pragma unroll
    for (int kb = 0; kb < 2; ++kb)
#pragma unroll
      for (int sx = 0; sx < 2; ++sx) {
        const s16x4 va = __builtin_amdgcn_ds_read_tr16_b64_v4i16((lds_s16x4*)(vbase + (32 * kb + 16 * sx) * AT_VSTR + dt * 64));
        const s16x4 vb = __builtin_amdgcn_ds_read_tr16_b64_v4i16((lds_s16x4*)(vbase + (32 * kb + 16 * sx + 8) * AT_VSTR + dt * 64));
        O[dt] = __builtin_amdgcn_mfma_f32_32x32x16_bf16(cat4(va, vb), pb[kb][sx], O[dt], 0, 0, 0);
      }
}

template <bool SELECTED>
__device__ __forceinline__ void phase_attn(const Params& p, LAS unsigned char* smem) {
  const int tid = my_tid(), wid = __builtin_amdgcn_readfirstlane(tid >> 6), lane = tid & 63, h = lane >> 5, l31 = lane & 31;
  const int n = wid & 3, th = wid >> 2;
  unsigned char* ws = p.ws;
  const bf16_t* Q = (const bf16_t*)(ws + WS_Q);
  const bf16_t* KB = (const bf16_t*)(ws + WS_KV) + (size_t)(SELECTED ? 2 : 4) * (16 * 2 * 2048 * 64);
  const bf16_t* VB = (const bf16_t*)(ws + WS_KV) + (size_t)(SELECTED ? 3 : 5) * (16 * 2 * 2048 * 64);
  const float* GATES = (const float*)(ws + WS_GATES);
  const unsigned* SEL = (const unsigned*)(ws + WS_BOOK + BK_SEL);
  bf16_t* OUT = (bf16_t*)(ws + (SELECTED ? WS_OS : WS_OW));
  const int G = gridDim.x;
  for (int it = blockIdx.x; it < 1024; it += G) {
    const int rnd = it / G, pos = it - rnd * G;
    const int si = rnd * G + ((rnd & 1) ? (G - 1 - pos) : pos);
    const int cur = 31 - (si >> 5), bg = si & 31, b = bg >> 1, g = bg & 1;
    const int t = cur * 64 + th * 32 + l31, tok = b * 2048 + t, head = g * 4 + n;
    bf16x8 qf[4];
#pragma unroll
    for (int ks = 0; ks < 4; ++ks) qf[ks] = *(const bf16x8*)(Q + (size_t)tok * 512 + head * 64 + 16 * ks + 8 * h);
    unsigned mysel = 0u, tiles;
    if (SELECTED) {
      mysel = SEL[bg * 2048 + t];
      unsigned any = SEL[bg * 2048 + cur * 64 + lane];
#pragma unroll
      for (int o = 32; o > 0; o >>= 1) any |= __shfl_xor(any, o);
      tiles = __builtin_amdgcn_readfirstlane(any);
    } else {
      const int jmin = cur - 8 > 0 ? cur - 8 : 0;
      tiles = ((cur == 31) ? 0xffffffffu : ((1u << (cur + 1)) - 1u)) & ~((1u << jmin) - 1u);
    }
    const char* kg = (const char*)(KB + (size_t)bg * 2048 * 64);
    const char* vg = (const char*)(VB + (size_t)bg * 2048 * 64);
    f32x16 O[2];
#pragma unroll
    for (int dt = 0; dt < 2; ++dt)
#pragma unroll
      for (int r = 0; r < 16; ++r) O[dt][r] = 0.f;
    float m = -1e30f, l = 0.f;
    int j = cur;
    tiles &= ~(1u << j);
    u32x4 kreg = *(const u32x4*)(kg + (size_t)j * 8192 + tid * 16), vreg = *(const u32x4*)(vg + (size_t)j * 8192 + tid * 16);
    const int kwo = (tid >> 3) * AT_KSTR + (tid & 7) * 16, vwo = AT_VOFF + (tid >> 3) * AT_VSTR + (tid & 7) * 16;
    *(LAS u32x4*)(smem + kwo) = kreg; *(LAS u32x4*)(smem + vwo) = vreg;
    __syncthreads();
    int cb = 0;
    for (;;) {
      const bool has_next = tiles != 0u;
      const int jn = has_next ? 31 - __builtin_clz(tiles) : 0;
      if (has_next) { tiles &= ~(1u << jn); kreg = *(const u32x4*)(kg + (size_t)jn * 8192 + tid * 16); vreg = *(const u32x4*)(vg + (size_t)jn * 8192 + tid * 16); }
      LAS unsigned char* buf = smem + cb * AT_TILE;
      if (SELECTED) {
        const bool selj = (mysel >> j) & 1u;
        const int kbase = j * 64 + 4 * h;
        attn_tile(buf, qf, O, m, l, lane, true, [&](int kb, int r) { return selj && (kbase + 32 * kb + (r & 3) + 8 * (r >> 2) <= t); });
      } else {
        const int kbase = j * 64 + 4 * h;
        const bool nm = (j == cur) || (j <= cur - 8);
        attn_tile(buf, qf, O, m, l, lane, nm, [&](int kb, int r) { const int key = kbase + 32 * kb + (r & 3) + 8 * (r >> 2); return key <= t && key > t - 512; });
      }
      if (has_next) { *(LAS u32x4*)(smem + (cb ^ 1) * AT_TILE + kwo) = kreg; *(LAS u32x4*)(smem + (cb ^ 1) * AT_TILE + vwo) = vreg; }
      __syncthreads();
      if (!has_next) break;
      cb ^= 1; j = jn;
    }
    const float lt = l + __shfl_xor(l, 32);
    const float sc = GATES[(size_t)tok * 24 + head * 3 + (SELECTED ? 1 : 2)] / lt;
#pragma unroll
    for (int dt = 0; dt < 2; ++dt)
#pragma unroll
      for (int r4 = 0; r4 < 4; ++r4) {
        u32x2 w; w.x = cvt_pk_bf16(O[dt][4 * r4 + 0] * sc, O[dt][4 * r4 + 1] * sc); w.y = cvt_pk_bf16(O[dt][4 * r4 + 2] * sc, O[dt][4 * r4 + 3] * sc);
        *(u32x2*)(OUT + (size_t)tok * 512 + head * 64 + 32 * dt + 8 * r4 + 4 * h) = w;
      }
  }
}

__device__ __forceinline__ void phase4_mfma(const Params& p, LAS unsigned char* smem) {
  const int tid = my_tid(), wid = __builtin_amdgcn_readfirstlane(tid >> 6), lane = tid & 63, h = lane >> 5, l31 = lane & 31;
  unsigned char* ws = p.ws;
  const bf16_t* Q = (const bf16_t*)(ws + WS_Q);
  const float* GATES = (const float*)(ws + WS_GATES);
  bf16_t* OC = (bf16_t*)(ws + WS_OC);
  unsigned* SEL = (unsigned*)(ws + WS_BOOK + BK_SEL);
  constexpr int VOFF = 128 * AT_KSTR;
  for (int it = blockIdx.x; it < 256; it += gridDim.x) {
    const int bg = it >> 3, tt = it & 7, b = bg >> 1, g = bg & 1;
    const char* kg = (const char*)(ws + WS_BOOK + BK_KCMP) + (size_t)bg * 16384;
    const char* vg = (const char*)(ws + WS_BOOK + BK_VCMP) + (size_t)bg * 16384;
    __syncthreads();
#pragma unroll
    for (int i = 0; i < 2; ++i) {
      const int e = tid + i * NTHR, key = e >> 3, ch = e & 7;
      *(LAS u32x4*)(smem + key * AT_KSTR + ch * 16) = *(const u32x4*)(kg + e * 16);
      *(LAS u32x4*)(smem + VOFF + key * AT_VSTR + ch * 16) = *(const u32x4*)(vg + e * 16);
    }
    __syncthreads();
    const int tw0 = tt * 256 + wid * 32, t = tw0 + l31, tok = b * 2048 + t;
    const int ncv = (t >= 31) ? ((t - 31) >> 4) + 1 : 0;
    const int tmax = tw0 + 31;
    const int ncvmax = (tmax >= 31) ? ((tmax - 31) >> 4) + 1 : 0;
    const int nkb = (ncvmax + 31) >> 5;
    float mainv[16], edgev[16];
#pragma unroll
    for (int a = 0; a < 16; ++a) { mainv[a] = 0.f; edgev[a] = 0.f; }
    for (int n = 0; n < 4; ++n) {
      const int head = g * 4 + n;
      bf16x8 qf[4];
#pragma unroll
      for (int ks = 0; ks < 4; ++ks) qf[ks] = *(const bf16x8*)(Q + (size_t)tok * 512 + head * 64 + 16 * ks + 8 * h);
      f32x16 s[4];
#pragma unroll
      for (int kb = 0; kb < 4; ++kb)
#pragma unroll
        for (int r = 0; r < 16; ++r) s[kb][r] = 0.f;
#pragma unroll
      for (int kb = 0; kb < 4; ++kb)
        if (kb < nkb) {
#pragma unroll
          for (int ks = 0; ks < 4; ++ks) {
            const bf16x8 a = *(const LAS bf16x8*)(smem + (kb * 32 + l31) * AT_KSTR + (2 * ks + h) * 16);
            s[kb] = __builtin_amdgcn_mfma_f32_32x32x16_bf16(a, qf[ks], s[kb], 0, 0, 0);
          }
        }
      float mx = -1e30f;
#pragma unroll
      for (int kb = 0; kb < 4; ++kb)
#pragma unroll
        for (int r = 0; r < 16; ++r) {
          const int c = 32 * kb + (r & 3) + 8 * (r >> 2) + 4 * h;
          s[kb][r] = (c < ncv) ? s[kb][r] : -1e30f;
          mx = fmaxf(mx, s[kb][r]);
        }
      mx = fmaxf(mx, __shfl_xor(mx, 32));
      float ls = 0.f;
#pragma unroll
      for (int kb = 0; kb < 4; ++kb)
#pragma unroll
        for (int r = 0; r < 16; ++r) {
          const int c = 32 * kb + (r & 3) + 8 * (r >> 2) + 4 * h;
          s[kb][r] = (c < ncv) ? __expf(s[kb][r] - mx) : 0.f;
          ls += s[kb][r];
        }
      ls += __shfl_xor(ls, 32);
      const float inv = (ls > 0.f) ? 1.0f / ls : 0.f;
#pragma unroll
      for (int kb = 0; kb < 4; ++kb)
#pragma unroll
        for (int i = 0; i < 4; ++i) {
          const float p0 = s[kb][4 * i] * inv, p1 = s[kb][4 * i + 1] * inv, p2 = s[kb][4 * i + 2] * inv, p3 = s[kb][4 * i + 3] * inv;
          s[kb][4 * i] = p0; s[kb][4 * i + 1] = p1; s[kb][4 * i + 2] = p2; s[kb][4 * i + 3] = p3;
          mainv[kb * 4 + i] += (p0 + p1) + (p2 + p3);
          edgev[kb * 4 + i] += p3;
        }
      f32x16 O[2];
#pragma unroll
      for (int dt = 0; dt < 2; ++dt)
#pragma unroll
        for (int r = 0; r < 16; ++r) O[dt][r] = 0.f;
      const int blk = (lane >> 4) & 1, q = (lane & 15) >> 2, pp = lane & 3;
      LAS unsigned char* vbase = smem + VOFF + (4 * h + q) * AT_VSTR + (16 * blk + 4 * pp) * 2;
#pragma unroll
      for (int kb = 0; kb < 4; ++kb)
        if (kb < nkb) {
#pragma unroll
          for (int sx = 0; sx < 2; ++sx) {
            u32x4 w; w.x = cvt_pk_bf16(s[kb][8 * sx + 0], s[kb][8 * sx + 1]); w.y = cvt_pk_bf16(s[kb][8 * sx + 2], s[kb][8 * sx + 3]);
            w.z = cvt_pk_bf16(s[kb][8 * sx + 4], s[kb][8 * sx + 5]); w.w = cvt_pk_bf16(s[kb][8 * sx + 6], s[kb][8 * sx + 7]);
            const bf16x8 pb = __builtin_bit_cast(bf16x8, w);
#pragma unroll
            for (int dt = 0; dt < 2; ++dt) {
              const s16x4 va = __builtin_amdgcn_ds_read_tr16_b64_v4i16((lds_s16x4*)(vbase + (32 * kb + 16 * sx) * AT_VSTR + dt * 64));
              const s16x4 vb = __builtin_amdgcn_ds_read_tr16_b64_v4i16((lds_s16x4*)(vbase + (32 * kb + 16 * sx + 8) * AT_VSTR + dt * 64));
              O[dt] = __builtin_amdgcn_mfma_f32_32x32x16_bf16(cat4(va, vb), pb, O[dt], 0, 0, 0);
            }
          }
        }
      const float g0 = GATES[(size_t)tok * 24 + head * 3 + 0];
#pragma unroll
      for (int dt = 0; dt < 2; ++dt)
#pragma unroll
        for (int r4 = 0; r4 < 4; ++r4) {
          u32x2 w; w.x = cvt_pk_bf16(O[dt][4 * r4 + 0] * g0, O[dt][4 * r4 + 1] * g0); w.y = cvt_pk_bf16(O[dt][4 * r4 + 2] * g0, O[dt][4 * r4 + 3] * g0);
          *(u32x2*)(OC + (size_t)tok * 512 + head * 64 + 32 * dt + 8 * r4 + 4 * h) = w;
        }
    }
    const int cur = t >> 6;
    float so[16], oo[16];
    {
      float ex[16];
#pragma unroll
      for (int a = 0; a < 16; ++a) ex[a] = __shfl_xor(edgev[a], 32);
#pragma unroll
      for (int a = 0; a < 16; ++a) {
        const float add = h ? ex[a] : (a > 0 ? ex[a > 0 ? a - 1 : 0] : 0.f);
        const float imp = mainv[a] + add;
        const int j = 2 * a + h;
        const bool forced = (j == 0) || (j == cur) || (j == cur - 1);
        so[a] = (j <= cur) ? (forced ? 1e9f : imp) : -3.0e38f;
      }
#pragma unroll
      for (int a = 0; a < 16; ++a) oo[a] = __shfl_xor(so[a], 32);
    }
    unsigned bits = 0u;
    const bool all = (cur + 1) <= 16;
#pragma unroll
    for (int a = 0; a < 16; ++a) {
      const int j = 2 * a + h;
      int rank = 0;
#pragma unroll
      for (int bb = 0; bb < 16; ++bb) {
        rank += ((so[bb] > so[a]) || (so[bb] == so[a] && bb < a)) ? 1 : 0;
        const int jo = 2 * bb + 1 - h;
        rank += ((oo[bb] > so[a]) || (oo[bb] == so[a] && jo < j)) ? 1 : 0;
      }
      const bool selj = (j <= cur) && (all || rank < 16);
      bits |= selj ? (1u << j) : 0u;
    }
    bits |= __shfl_xor(bits, 32);
    if (h == 0) SEL[bg * 2048 + t] = bits;
  }
}

__device__ __forceinline__ void phase6b(const Params& p) {
  const int tid = my_tid(), wid = tid >> 6, lane = tid & 63;
  unsigned char* ws = p.ws;
  const bf16_t* OC = (const bf16_t*)(ws + WS_OC); const bf16_t* OW = (const bf16_t*)(ws + WS_OW); const bf16_t* OS = (const bf16_t*)(ws + WS_OS);
  bf16_t* MIX = (bf16_t*)(ws + WS_MIX);
  const f32x4 g0 = *(const f32x4*)(p.out_norm_nsa + lane * 8), g1 = *(const f32x4*)(p.out_norm_nsa + lane * 8 + 4);
  for (int t = blockIdx.x * 8 + wid; t < T_TOK; t += gridDim.x * 8) {
    const bf16x8 a = *(const bf16x8*)(OC + (size_t)t * 512 + lane * 8), b = *(const bf16x8*)(OW + (size_t)t * 512 + lane * 8), c = *(const bf16x8*)(OS + (size_t)t * 512 + lane * 8);
    float v[8]; float ss = 0.f;
#pragma unroll
    for (int e = 0; e < 8; ++e) { v[e] = bf2f((bf16_t)a[e]) + bf2f((bf16_t)b[e]) + bf2f((bf16_t)c[e]); ss += v[e] * v[e]; }
    ss = wave_sum(ss);
    const float rstd = rsqrtf(ss * (1.0f / 512.0f) + NORM_EPS);
    u32x4 w; w.x = pack2(v[0] * rstd * g0[0], v[1] * rstd * g0[1]); w.y = pack2(v[2] * rstd * g0[2], v[3] * rstd * g0[3]);
    w.z = pack2(v[4] * rstd * g1[0], v[5] * rstd * g1[1]); w.w = pack2(v[6] * rstd * g1[2], v[7] * rstd * g1[3]);
    *(u32x4*)(MIX + (size_t)t * 1024 + 512 + lane * 8) = w;
  }
}

__device__ __forceinline__ void phase8_naive(const Params& p) {
  const int tid = my_tid(), wid = tid >> 6, lane = tid & 63;
  unsigned char* ws = p.ws;
  const float* MOD = (const float*)(ws + WS_BOOK + BK_MOD);
  const bf16_t* D1 = (const bf16_t*)(ws + WS_D1);
  bf16_t* H2 = (bf16_t*)(ws + WS_H2);
  int* TOPI = (int*)(ws + WS_BOOK + BK_TOPI); float* TOPG = (float*)(ws + WS_BOOK + BK_TOPG);
  int* HIST = (int*)(ws + WS_BOOK + BK_HIST);
  for (int it = blockIdx.x; it < T_TOK / 128; it += gridDim.x) {
    const int t0 = it * 128, b = t0 / SEQ;
    f32x4 sc[4], sh[4];
#pragma unroll
    for (int j = 0; j < 4; ++j) {
      const int d = j * 256 + lane * 4;
      const f32x4 g = *(const f32x4*)(p.norm2_g + d);
      const f32x4 s2 = *(const f32x4*)(MOD + b * 6144 + 4096 + d);
      sh[j] = *(const f32x4*)(MOD + b * 6144 + 3072 + d);
      sc[j] = g * (s2 + 1.0f);
    }
    for (int tt = wid; tt < 128; tt += 8) {
      const int t = t0 + tt;
      f32x4 v[4]; float ss = 0.f;
#pragma unroll
      for (int j = 0; j < 4; ++j) {
        v[j] = *(const f32x4*)(p.x + (size_t)t * DM + j * 256 + lane * 4);
        const u32x2 dd = *(const u32x2*)(D1 + (size_t)t * DM + j * 256 + lane * 4);
        v[j][0] += __uint_as_float(dd.x << 16); v[j][1] += __uint_as_float(dd.x & 0xffff0000u);
        v[j][2] += __uint_as_float(dd.y << 16); v[j][3] += __uint_as_float(dd.y & 0xffff0000u);
        ss += v[j][0] * v[j][0] + v[j][1] * v[j][1] + v[j][2] * v[j][2] + v[j][3] * v[j][3];
      }
      ss = wave_sum(ss);
      const float rstd = rsqrtf(ss * (1.0f / DM) + NORM_EPS);
#pragma unroll
      for (int j = 0; j < 4; ++j) {
        v[j] = v[j] * rstd * sc[j] + sh[j];
        u32x2 w; w.x = pack2(v[j][0], v[j][1]); w.y = pack2(v[j][2], v[j][3]);
        *(u32x2*)(H2 + (size_t)t * DM + j * 256 + lane * 4) = w;
      }
      float mylg = -3.0e38f;
#pragma unroll 4
      for (int e = 0; e < 32; ++e) {
        float s = 0.f;
#pragma unroll
        for (int j = 0; j < 4; ++j)
#pragma unroll
          for (int q = 0; q < 4; ++q) s += v[j][q] * p.w_router[(size_t)(j * 256 + lane * 4 + q) * 32 + e];
        s = wave_sum(s) + p.b_router[e];
        mylg = (lane == e) ? s : mylg;
      }
      int idx[4]; float val[4];
#pragma unroll
      for (int k = 0; k < 4; ++k) {
        float bv = mylg; int bi = lane;
#pragma unroll
        for (int o = 32; o > 0; o >>= 1) {
          const float ov = __shfl_xor(bv, o); const int oi = __shfl_xor(bi, o);
          const bool take = (ov > bv) || (ov == bv && oi < bi);
          bv = take ? ov : bv; bi = take ? oi : bi;
        }
        idx[k] = bi; val[k] = bv;
        mylg = (lane == bi) ? -3.0e38f : mylg;
      }
      const float e0 = 1.0f, e1 = __expf(val[1] - val[0]), e2 = __expf(val[2] - val[0]), e3 = __expf(val[3] - val[0]);
      const float inv = 1.0f / (e0 + e1 + e2 + e3);
      if (lane == 0) {
        *(int4*)(TOPI + (size_t)t * 4) = make_int4(idx[0], idx[1], idx[2], idx[3]);
        *(f32x4*)(TOPG + (size_t)t * 4) = (f32x4){e0 * inv, e1 * inv, e2 * inv, e3 * inv};
        const int ch = t / CHUNK_TOK;
        atomicAdd(HIST + ch * 32 + idx[0], 1); atomicAdd(HIST + ch * 32 + idx[1], 1);
        atomicAdd(HIST + ch * 32 + idx[2], 1); atomicAdd(HIST + ch * 32 + idx[3], 1);
      }
    }
  }
}

__device__ __forceinline__ void phase9(const Params& p, LAS unsigned char* smem) {
  const int tid = my_tid();
  unsigned char* ws = p.ws;
  LAS int* base = (LAS int*)smem;
  int* HIST = (int*)(ws + WS_BOOK + BK_HIST);
  int* FILL = HIST + 64;
  int* NTL = (int*)(ws + WS_BOOK + BK_NT);
  int* TILES = (int*)(ws + WS_BOOK + BK_TILES);
  const int* TOPI = (const int*)(ws + WS_BOOK + BK_TOPI);
  int* SLOTOF = (int*)(ws + WS_BOOK + BK_SLOTOF);
  int* ROWTOK = (int*)(ws + WS_BOOK + BK_ROWTOK);
  if (tid < 2) {
    int run = 0, nt = 0;
    for (int e = 0; e < 32; ++e) {
      const int cnt = ld_i32(HIST + tid * 32 + e);
      base[tid * 32 + e] = run;
      if (blockIdx.x == 0) {
        for (int r = 0; r < cnt; r += 256) { int* tl = TILES + (size_t)(tid * MAXTILES + nt) * 4; tl[0] = e; tl[1] = run + r; tl[2] = (cnt - r < 256) ? cnt - r : 256; tl[3] = 0; ++nt; }
      }
      run += cnt;
    }
    if (blockIdx.x == 0) NTL[tid] = nt;
  }
  __syncthreads();
  for (int a = blockIdx.x * NTHR + tid; a < T_TOK * 4; a += gridDim.x * NTHR) {
    const int t = a >> 2, ch = t / CHUNK_TOK;
    const int e = TOPI[a];
    const int slot = base[ch * 32 + e] + atomicAdd(FILL + ch * 32 + e, 1);
    ROWTOK[ch * CHUNK_ROWS + slot] = t;
    SLOTOF[a] = slot;
  }
}

__device__ __forceinline__ float xreduce32(const float (&a)[32], int lane) {
  float b16[16], b8[8], b4[4], b2[2];
  const bool u5 = lane & 32, u4 = lane & 16, u3 = lane & 8, u2 = lane & 4, u1 = lane & 2;
#pragma unroll
  for (int i = 0; i < 16; ++i) { const float snd = u5 ? a[i] : a[i + 16], kp = u5 ? a[i + 16] : a[i]; b16[i] = kp + __shfl_xor(snd, 32); }
#pragma unroll
  for (int i = 0; i < 8; ++i) { const float snd = u4 ? b16[i] : b16[i + 8], kp = u4 ? b16[i + 8] : b16[i]; b8[i] = kp + __shfl_xor(snd, 16); }
#pragma unroll
  for (int i = 0; i < 4; ++i) { const float snd = u3 ? b8[i] : b8[i + 4], kp = u3 ? b8[i + 4] : b8[i]; b4[i] = kp + __shfl_xor(snd, 8); }
#pragma unroll
  for (int i = 0; i < 2; ++i) { const float snd = u2 ? b4[i] : b4[i + 2], kp = u2 ? b4[i + 2] : b4[i]; b2[i] = kp + __shfl_xor(snd, 4); }
  const float snd = u1 ? b2[0] : b2[1], kp = u1 ? b2[1] : b2[0];
  float r = kp + __shfl_xor(snd, 2);
  r += __shfl_xor(r, 1);
  return r;
}
__device__ __forceinline__ void route_top4(float mylg, int lane, int t, int* TOPI, float* TOPG, LAS int* lhist) {
  int idx[4]; float val[4];
#pragma unroll
  for (int k = 0; k < 4; ++k) {
    float bv = mylg; int bi = lane >> 1;
#pragma unroll
    for (int o = 32; o > 0; o >>= 1) {
      const float ov = __shfl_xor(bv, o); const int oi = __shfl_xor(bi, o);
      const bool take = (ov > bv) || (ov == bv && oi < bi);
      bv = take ? ov : bv; bi = take ? oi : bi;
    }
    idx[k] = bi; val[k] = bv;
    mylg = ((lane >> 1) == bi) ? -3.0e38f : mylg;
  }
  const float e1 = __expf(val[1] - val[0]), e2 = __expf(val[2] - val[0]), e3 = __expf(val[3] - val[0]);
  const float inv = 1.0f / (1.0f + e1 + e2 + e3);
  if (lane == 0) {
    *(int4*)(TOPI + (size_t)t * 4) = make_int4(idx[0], idx[1], idx[2], idx[3]);
    *(f32x4*)(TOPG + (size_t)t * 4) = (f32x4){inv, e1 * inv, e2 * inv, e3 * inv};
    lds_inc(lhist + idx[0]); lds_inc(lhist + idx[1]); lds_inc(lhist + idx[2]); lds_inc(lhist + idx[3]);
  }
}
__device__ __forceinline__ void phase8(const Params& p, LAS unsigned char* smem) {
  const int tid = my_tid(), wid = tid >> 6, lane = tid & 63;
  unsigned char* ws = p.ws;
  const float* MOD = (const float*)(ws + WS_BOOK + BK_MOD);
  const bf16_t* D1 = (const bf16_t*)(ws + WS_D1);
  bf16_t* H2 = (bf16_t*)(ws + WS_H2);
  int* TOPI = (int*)(ws + WS_BOOK + BK_TOPI); float* TOPG = (float*)(ws + WS_BOOK + BK_TOPG);
  int* ITEMCNT = (int*)(ws + WS_BOOK + BK_ITEMCNT);
  LAS float* wrt = (LAS float*)smem;
  LAS int* lhist = (LAS int*)(smem + 131072);
  {
    const float* WRT = (const float*)(ws + WS_BOOK + BK_WRT);
    for (int i = tid; i < 8192; i += NTHR) *(LAS f32x4*)(wrt + i * 4) = *(const f32x4*)(WRT + i * 4);
  }
  const float brt = p.b_router[lane >> 1];
  for (int it = blockIdx.x; it < T_TOK / 128; it += gridDim.x) {
    const int t0 = it * 128, b = t0 / SEQ;
    if (tid < 32) lhist[tid] = 0;
    __syncthreads();
    f32x4 sc[4], sh[4];
#pragma unroll
    for (int j = 0; j < 4; ++j) {
      const int d = j * 256 + lane * 4;
      const f32x4 g = *(const f32x4*)(p.norm2_g + d);
      const f32x4 s2 = *(const f32x4*)(MOD + b * 6144 + 4096 + d);
      sh[j] = *(const f32x4*)(MOD + b * 6144 + 3072 + d);
      sc[j] = g * (s2 + 1.0f);
    }
    for (int tt = wid * 2; tt < 128; tt += 16) {
      f32x4 v[2][4];
#pragma unroll
      for (int u = 0; u < 2; ++u) {
        const int t = t0 + tt + u;
        float ss = 0.f;
#pragma unroll
        for (int j = 0; j < 4; ++j) {
          v[u][j] = *(const f32x4*)(p.x + (size_t)t * DM + j * 256 + lane * 4);
          const u32x2 dd = *(const u32x2*)(D1 + (size_t)t * DM + j * 256 + lane * 4);
          v[u][j][0] += __uint_as_float(dd.x << 16); v[u][j][1] += __uint_as_float(dd.x & 0xffff0000u);
          v[u][j][2] += __uint_as_float(dd.y << 16); v[u][j][3] += __uint_as_float(dd.y & 0xffff0000u);
          ss += v[u][j][0] * v[u][j][0] + v[u][j][1] * v[u][j][1] + v[u][j][2] * v[u][j][2] + v[u][j][3] * v[u][j][3];
        }
        ss = wave_sum(ss);
        const float rstd = rsqrtf(ss * (1.0f / DM) + NORM_EPS);
#pragma unroll
        for (int j = 0; j < 4; ++j) {
          v[u][j] = v[u][j] * rstd * sc[j] + sh[j];
          u32x2 w; w.x = pack2(v[u][j][0], v[u][j][1]); w.y = pack2(v[u][j][2], v[u][j][3]);
          *(u32x2*)(H2 + (size_t)t * DM + j * 256 + lane * 4) = w;
        }
      }
      f32x2 acc[32];
#pragma unroll
      for (int e = 0; e < 32; ++e) {
        f32x2 a = (f32x2){0.f, 0.f};
#pragma unroll
        for (int j = 0; j < 4; ++j) {
          const f32x4 w = *(const LAS f32x4*)(wrt + e * 1024 + j * 256 + lane * 4);
#pragma unroll
          for (int q = 0; q < 4; ++q) a += (f32x2){v[0][j][q], v[1][j][q]} * w[q];
        }
        acc[e] = a;
      }
      float a0[32], a1[32];
#pragma unroll
      for (int e = 0; e < 32; ++e) { a0[e] = acc[e][0]; a1[e] = acc[e][1]; }
      const float l0 = xreduce32(a0, lane) + brt, l1 = xreduce32(a1, lane) + brt;
      route_top4(l0, lane, t0 + tt, TOPI, TOPG, lhist);
      route_top4(l1, lane, t0 + tt + 1, TOPI, TOPG, lhist);
    }
    __syncthreads();
    if (tid < 32) ITEMCNT[it * 32 + tid] = lhist[tid];
  }
}

__device__ __forceinline__ void phase9b(const Params& p, LAS unsigned char* smem) {
  const int tid = my_tid();
  unsigned char* ws = p.ws;
  LAS int* cnt = (LAS int*)smem;
  LAS int* ltot = cnt + 4096; LAS int* lpre = ltot + 32; LAS int* lfill = lpre + 32; LAS int* lbase = lfill + 32;
  const int* ITEMCNT = (const int*)(ws + WS_BOOK + BK_ITEMCNT);
  int* NTL = (int*)(ws + WS_BOOK + BK_NT);
  int* TILES = (int*)(ws + WS_BOOK + BK_TILES);
  const int* TOPI = (const int*)(ws + WS_BOOK + BK_TOPI);
  int* SLOTOF = (int*)(ws + WS_BOOK + BK_SLOTOF);
  int* ROWTOK = (int*)(ws + WS_BOOK + BK_ROWTOK);
  for (int it = blockIdx.x; it < T_TOK / 128; it += gridDim.x) {
    const int ch = it >> 7, li = it & 127;
    __syncthreads();
    for (int i = tid; i < 4096; i += NTHR) cnt[i] = ITEMCNT[ch * 4096 + i];
    __syncthreads();
    if (tid < 32) {
      int tot = 0, pre = 0;
      for (int i = 0; i < 128; ++i) { const int c = cnt[i * 32 + tid]; tot += c; pre += (i < li) ? c : 0; }
      ltot[tid] = tot; lpre[tid] = pre; lfill[tid] = 0;
    }
    __syncthreads();
    if (tid == 0) {
      int run = 0, nt = 0;
      for (int e = 0; e < 32; ++e) {
        const int c = ltot[e];
        lbase[e] = run;
        if (li == 0) {
          for (int r = 0; r < c; r += 256) { int* tl = TILES + (size_t)(ch * MAXTILES + nt) * 4; tl[0] = e; tl[1] = run + r; tl[2] = (c - r < 256) ? c - r : 256; tl[3] = 0; ++nt; }
        }
        run += c;
      }
      if (li == 0) NTL[ch] = nt;
    }
    __syncthreads();
    {
      const int a = it * 512 + tid, t = a >> 2;
      const int e = TOPI[a];
      const int slot = lbase[e] + lpre[e] + lds_inc(lfill + e);
      ROWTOK[ch * CHUNK_ROWS + slot] = t;
      SLOTOF[a] = slot;
    }
  }
}

__device__ __forceinline__ void phase12(const Params& p, int ch) {
  const int tid = my_tid(), wid = tid >> 6, lane = tid & 63;
  unsigned char* ws = p.ws;
  const float* MOD = (const float*)(ws + WS_BOOK + BK_MOD);
  const bf16_t* D1 = (const bf16_t*)(ws + WS_D1);
  const bf16_t* Y = (const bf16_t*)(ws + WS_YBUF);
  const int* SLOTOF = (const int*)(ws + WS_BOOK + BK_SLOTOF);
  const float* TOPG = (const float*)(ws + WS_BOOK + BK_TOPG);
  for (int it = blockIdx.x; it < CHUNK_TOK / 128; it += gridDim.x) {
    const int t0 = ch * CHUNK_TOK + it * 128, b = t0 / SEQ;
    f32x4 gt[4], fg[4];
#pragma unroll
    for (int j = 0; j < 4; ++j) { const int d = j * 256 + lane * 4; gt[j] = *(const f32x4*)(MOD + b * 6144 + 5120 + d); fg[j] = *(const f32x4*)(p.final_norm_g + d); }
    for (int tt = wid; tt < 128; tt += 8) {
      const int t = t0 + tt;
      const int4 sl = *(const int4*)(SLOTOF + (size_t)t * 4);
      const f32x4 gg = *(const f32x4*)(TOPG + (size_t)t * 4);
      const int sls[4] = {sl.x, sl.y, sl.z, sl.w};
      f32x4 v[4]; float ss = 0.f;
#pragma unroll
      for (int j = 0; j < 4; ++j) {
        const int d = j * 256 + lane * 4;
        f32x4 y = (f32x4){0.f, 0.f, 0.f, 0.f};
#pragma unroll
        for (int k = 0; k < 4; ++k) {
          const u32x2 yy = *(const u32x2*)(Y + (size_t)sls[k] * 1024 + d);
          y[0] += gg[k] * __uint_as_float(yy.x << 16); y[1] += gg[k] * __uint_as_float(yy.x & 0xffff0000u);
          y[2] += gg[k] * __uint_as_float(yy.y << 16); y[3] += gg[k] * __uint_as_float(yy.y & 0xffff0000u);
        }
        v[j] = *(const f32x4*)(p.x + (size_t)t * DM + d);
        const u32x2 dd = *(const u32x2*)(D1 + (size_t)t * DM + d);
        v[j][0] += __uint_as_float(dd.x << 16); v[j][1] += __uint_as_float(dd.x & 0xffff0000u);
        v[j][2] += __uint_as_float(dd.y << 16); v[j][3] += __uint_as_float(dd.y & 0xffff0000u);
        v[j] = v[j] + gt[j] * y;
        ss += v[j][0] * v[j][0] + v[j][1] * v[j][1] + v[j][2] * v[j][2] + v[j][3] * v[j][3];
      }
      ss = wave_sum(ss);
      const float rstd = rsqrtf(ss * (1.0f / DM) + NORM_EPS);
#pragma unroll
      for (int j = 0; j < 4; ++j) *(f32x4*)(p.out + (size_t)t * DM + j * 256 + lane * 4) = v[j] * rstd * fg[j];
    }
  }
}

__global__ void __launch_bounds__(NTHR) mega(Params p) {
  extern __shared__ __attribute__((aligned(16))) unsigned char smem_raw[];
  LAS unsigned char* smem = (LAS unsigned char*)smem_raw;
  cg::grid_group grid = cg::this_grid();
  unsigned char* ws = p.ws; unsigned char* dout = (unsigned char*)p.out;
  phase0(p, smem);
  grid.sync();
  phase1(p);
  grid.sync();
  {
    DenseSched S{(const char*)(ws + WS_H), (const char*)(dout + DO_WIN), 10, 1280};
    EpiProj E{(bf16_t*)(ws + WS_U), (bf16_t*)(ws + WS_Q), (bf16_t*)(ws + WS_KV), (float*)(ws + WS_GATES), (const float*)(ws + WS_BOOK + BK_ROPE)};
    gm::gemm_phase(smem, S, E);
  }
  grid.sync();
  phase3(p, smem);
  __syncthreads();
  phase_attn<false>(p, smem);
  grid.sync();
  phase4_mfma(p, smem);
  grid.sync();
  phase_attn<true>(p, smem);
  grid.sync();
  phase6b(p);
  grid.sync();
  {
    DenseSched S{(const char*)(ws + WS_MIX), (const char*)(dout + DO_WOUT), 4, 512};
    EpiOut E{(bf16_t*)(ws + WS_D1), (const float*)(ws + WS_BOOK + BK_MOD)};
    gm::gemm_phase(smem, S, E);
  }
  grid.sync();
  phase8(p, smem);
  grid.sync();
  phase9b(p, smem);
  grid.sync();
  for (int ch = 0; ch < 2; ++ch) {
    const int* tiles = (const int*)(ws + WS_BOOK + BK_TILES) + (size_t)ch * MAXTILES * 4;
    const int ntiles = __builtin_amdgcn_readfirstlane(ld_i32((const int*)(ws + WS_BOOK + BK_NT) + ch));
    {
      GuSched S{(const char*)(ws + WS_H2), (const char*)(ws + WS_WGU), tiles, (const int*)(ws + WS_BOOK + BK_ROWTOK) + ch * CHUNK_ROWS, ntiles};
      EpiGU E{(bf16_t*)(ws + WS_ACT), p.b_gate, p.b_up};
      gm::gemm_phase(smem, S, E);
    }
    grid.sync();
    {
      DownSched S{(const char*)(ws + WS_ACT), (const char*)(dout + DO_WD), tiles, ntiles};
      EpiDown E{(bf16_t*)(ws + WS_YBUF), p.b_down};
      gm::gemm_phase(smem, S, E);
    }
    grid.sync();
    phase12(p, ch);
  }
}

extern "C" void kernel_launch(void* const* d_in, const int* in_sizes, int n_in,
                              void* d_out, int out_size, void* d_ws, size_t ws_size,
                              hipStream_t stream) {
  static int grid_blocks = 0;
  if (!grid_blocks) {
    int dev = 0, cus = 0, per_cu = 0;
    (void)hipGetDevice(&dev);
    (void)hipDeviceGetAttribute(&cus, hipDeviceAttributeMultiprocessorCount, dev);
    (void)hipFuncSetAttribute((const void*)mega, hipFuncAttributeMaxDynamicSharedMemorySize, (int)LDS_BYTES);
    (void)hipOccupancyMaxActiveBlocksPerMultiprocessor(&per_cu, mega, NTHR, LDS_BYTES);
    if (per_cu > 1) per_cu = 1;
    grid_blocks = cus * per_cu;
    if (grid_blocks > 256) grid_blocks = 256;
    grid_blocks &= ~7;
  }
  Params p{};
  const float** pp = (const float**)&p;
  for (int i = 0; i < 29; ++i) pp[i] = (const float*)d_in[i];
  p.out = (float*)d_out; p.ws = (unsigned char*)d_ws; p.ph0 = 0; p.ph1 = 0;
  if (ws_size < WS_TOTAL) { fprintf(stderr, "workspace too small: %zu < %zu\n", ws_size, (size_t)WS_TOTAL); return; }
  void* args[] = {&p};
  hipError_t e = hipLaunchCooperativeKernel((void*)mega, dim3(grid_blocks), dim3(NTHR), args, LDS_BYTES, stream);
  if (e != hipSuccess) fprintf(stderr, "cooperative launch failed: %s (grid %d)\n", hipGetErrorString(e), grid_blocks);
}
```

```cpp
#include <hip/hip_runtime.h>
#include <hip/hip_cooperative_groups.h>
#include <cstdio>
#include <cstdint>
namespace cg = cooperative_groups;
#define PROF_ON 0
#define PROF_A 0
#define PROF_B 2
#define PROF_A1 (PROF_A + 1)
#define PROF_B1 (PROF_B + 1)
#if PROF_ON
#define PROF_BLK 0
#define PROF_SHIFT 0.0f
#define PROF_LOGBIN 0.22314355f
#define SUBSTAMP(k) do { if (blockIdx.x == PROF_BLK && threadIdx.x == 0) ((unsigned long long*)(p.ws + WS_BOOK + 15 * MiB))[k] = wall_clock64(); } while (0)
#else
#define SUBSTAMP(k) do { } while (0)
#endif
#define PROF_ITEMS 0
#define PROF_GEMM 0
#define PROF_GSEL 2

#define LAS __attribute__((address_space(3)))
typedef unsigned short bf16_t;
typedef short bf16x8 __attribute__((ext_vector_type(8)));
typedef float f32x4 __attribute__((ext_vector_type(4)));
typedef float f32x2 __attribute__((ext_vector_type(2)));
typedef unsigned u32x4 __attribute__((ext_vector_type(4)));
typedef unsigned u32x2 __attribute__((ext_vector_type(2)));

constexpr int T_TOK = 32768, DM = 1024, NB = 16, SEQ = 2048;
constexpr int IN_COLS = 2328, IN_PAD = 2560;
constexpr int NCMP = 127;
constexpr int NEXP = 32, TOPK = 4, DFF = 1024;
constexpr int CHUNK_TOK = 32768, CHUNK_ROWS = 131072, MAXTILES = 544;
constexpr float NORM_EPS = 1e-5f;
constexpr int NTHR = 512;
constexpr size_t LDS_BYTES = 140 * 1024;

constexpr size_t MiB = 1024 * 1024;
constexpr size_t WS_BOOK = 0;
constexpr size_t WS_WGU  = 16 * MiB;
constexpr size_t WS_ACT  = 80 * MiB;
constexpr size_t WS_D1   = 208 * MiB;
constexpr size_t WS_E    = 272 * MiB;
constexpr size_t WS_YBUF = WS_E;
constexpr size_t WS_TOTAL = WS_E + 256 * MiB;
constexpr size_t WS_H    = WS_E;
constexpr size_t WS_MIX  = WS_E;
constexpr size_t WS_U    = WS_E + 64 * MiB;
constexpr size_t WS_Q    = WS_E + 96 * MiB;
constexpr size_t WS_KV   = WS_E + 128 * MiB;
constexpr size_t WS_GATES= WS_E + 176 * MiB;
constexpr size_t WS_OC   = WS_E + 180 * MiB;
constexpr size_t WS_OW   = WS_E + 212 * MiB;
constexpr size_t WS_OS   = WS_ACT;
constexpr size_t BK_MOD    = 0;
constexpr size_t BK_ROPE   = 512 * 1024;
constexpr size_t BK_CB1    = BK_ROPE + 128 * 1024;
constexpr size_t BK_HIST   = BK_CB1 + 1024;
constexpr size_t BK_NT     = BK_HIST + 512;
constexpr size_t BK_TILES  = BK_NT + 256;
constexpr size_t BK_TOPI   = 1 * MiB;
constexpr size_t BK_TOPG   = BK_TOPI + 512 * 1024;
constexpr size_t BK_SLOTOF = BK_TOPG + 512 * 1024;
constexpr size_t BK_ROWTOK = BK_SLOTOF + 512 * 1024;
constexpr size_t BK_SEL    = BK_ROWTOK + 512 * 1024;
constexpr size_t BK_KCMP   = BK_SEL + 256 * 1024;
constexpr size_t BK_VCMP   = BK_KCMP + 512 * 1024;
constexpr size_t BK_ITEMCNT= BK_VCMP + 512 * 1024;
constexpr size_t BK_WRT    = BK_ITEMCNT + 32 * 1024;
constexpr size_t BK_SSQ    = BK_WRT + 128 * 1024;
constexpr size_t BK_END    = BK_SSQ + 256 * 1024;
constexpr size_t BK_ROWTOK2 = 8 * MiB;
static_assert(BK_END <= 14 * MiB, "book");
constexpr size_t BK_XBAR   = 14 * MiB;
constexpr size_t BK_CTR    = BK_XBAR + 16384;
constexpr size_t BK_ZERO_BYTES = 16384 + 256;
constexpr size_t DO_WIN  = 0;
constexpr size_t DO_WOUT = 5 * MiB;
constexpr size_t DO_CK1  = 7 * MiB;
constexpr size_t DO_CV1  = DO_CK1 + 512 * 1024;
constexpr size_t DO_CK2  = DO_CV1 + 512 * 1024;
constexpr size_t DO_CV2  = DO_CK2 + 16 * 1024;
constexpr size_t DO_H2   = 9 * MiB;
constexpr size_t DO_WD   = 64 * MiB;

struct Params {
  const float *x, *c, *norm1_g, *norm2_g, *w_ada, *b_ada, *w_in, *conv_w, *conv_b, *conv_ln_g, *conv_ln_b,
      *cmp_pe_k, *cmp_pe_v, *cmp_k_w1, *cmp_k_w2, *cmp_v_w1, *cmp_v_w2, *out_norm_conv, *out_norm_nsa, *w_out,
      *w_router, *b_router, *w_gate, *b_gate, *w_up, *b_up, *w_down, *b_down, *final_norm_g;
  float* out;
  unsigned char* ws;
  int ph0, ph1;
};

__device__ __forceinline__ bf16_t f2bf(float f) { unsigned u = __float_as_uint(f); u += 0x7FFFu + ((u >> 16) & 1u); return (bf16_t)(u >> 16); }
__device__ __forceinline__ float bf2f(bf16_t b) { return __uint_as_float(((unsigned)b) << 16); }
__device__ __forceinline__ unsigned pack2(float lo, float hi) { return (unsigned)f2bf(lo) | ((unsigned)f2bf(hi) << 16); }
__device__ __forceinline__ float clamp448(float v) { return __builtin_amdgcn_fmed3f(v, -448.0f, 448.0f); }
__device__ __forceinline__ unsigned pack4_fp8(float a, float b, float c, float d) {
  int w = 0;
  w = __builtin_amdgcn_cvt_pk_fp8_f32(clamp448(a), clamp448(b), w, false);
  w = __builtin_amdgcn_cvt_pk_fp8_f32(clamp448(c), clamp448(d), w, true);
  return (unsigned)w;
}
template <int CTRL> __device__ __forceinline__ float dpp_mov(float v) { return __int_as_float(__builtin_amdgcn_update_dpp(0, __float_as_int(v), CTRL, 0xF, 0xF, true)); }
template <int CTRL> __device__ __forceinline__ int dpp_movi(int v) { return __builtin_amdgcn_update_dpp(0, v, CTRL, 0xF, 0xF, true); }
__device__ __forceinline__ float lx1(float v) { return dpp_mov<0xB1>(v); }
__device__ __forceinline__ float lx2(float v) { return dpp_mov<0x4E>(v); }
__device__ __forceinline__ float lx4(float v) { return dpp_mov<0x1B>(dpp_mov<0x141>(v)); }
__device__ __forceinline__ float lx8(float v) { return dpp_mov<0x128>(v); }
__device__ __forceinline__ int lx1i(int v) { return dpp_movi<0xB1>(v); }
__device__ __forceinline__ int lx2i(int v) { return dpp_movi<0x4E>(v); }
__device__ __forceinline__ int lx4i(int v) { return dpp_movi<0x1B>(dpp_movi<0x141>(v)); }
__device__ __forceinline__ int lx8i(int v) { return dpp_movi<0x128>(v); }
__device__ __forceinline__ float xsum32(float a, float b) { auto r = __builtin_amdgcn_permlane32_swap(__float_as_uint(a), __float_as_uint(b), false, false); return __uint_as_float(r[0]) + __uint_as_float(r[1]); }
__device__ __forceinline__ float xsum16(float a, float b) { auto r = __builtin_amdgcn_permlane16_swap(__float_as_uint(a), __float_as_uint(b), false, false); return __uint_as_float(r[0]) + __uint_as_float(r[1]); }
__device__ __forceinline__ float xmax32(float v) { auto r = __builtin_amdgcn_permlane32_swap(__float_as_uint(v), __float_as_uint(v), false, false); return fmaxf(__uint_as_float(r[0]), __uint_as_float(r[1])); }
__device__ __forceinline__ float xother32(float v, int hi) { auto r = __builtin_amdgcn_permlane32_swap(__float_as_uint(v), __float_as_uint(v), false, false); return __uint_as_float(hi ? r[0] : r[1]); }
__device__ __forceinline__ unsigned wave_or(unsigned v) {
  v |= (unsigned)lx1i((int)v); v |= (unsigned)lx2i((int)v); v |= (unsigned)lx4i((int)v); v |= (unsigned)lx8i((int)v);
  { auto r = __builtin_amdgcn_permlane16_swap(v, v, false, false); v = r[0] | r[1]; }
  { auto r = __builtin_amdgcn_permlane32_swap(v, v, false, false); v = r[0] | r[1]; }
  return v;
}
__device__ __forceinline__ float wave_sum(float v) {
  v += lx1(v); v += lx2(v); v += lx4(v); v += lx8(v);
  v = xsum16(v, v);
  v = xsum32(v, v);
  return v;
}
__device__ __forceinline__ float sigmoidf_(float v) { return __builtin_amdgcn_rcpf(1.0f + __builtin_amdgcn_exp2f(v * -1.4426950408889634f)); }
__device__ __forceinline__ int ld_i32(const int* p) { return __hip_atomic_load(p, __ATOMIC_RELAXED, __HIP_MEMORY_SCOPE_AGENT); }

__device__ __forceinline__ int my_tid() { int t = threadIdx.x; asm volatile("" : "+v"(t)); return t; }
__device__ __forceinline__ int lds_inc(LAS int* p) { return __hip_atomic_fetch_add(p, 1, __ATOMIC_RELAXED, __HIP_MEMORY_SCOPE_WORKGROUP); }
__device__ __forceinline__ unsigned long long ld_u64(const unsigned long long* p) { return __hip_atomic_load(p, __ATOMIC_RELAXED, __HIP_MEMORY_SCOPE_AGENT); }
__device__ __forceinline__ float block_sum(float v, LAS float* red) {
  v = wave_sum(v);
  const int tq = my_tid(); const int wid = tq >> 6, lane = tq & 63;
  __syncthreads();
  if (lane == 0) red[wid] = v;
  __syncthreads();
  float s = 0.f;
#pragma unroll
  for (int i = 0; i < 8; ++i) s += red[i];
  return s;
}


#define XB_TMO      128
#define XB_XCNT(j)  (256  + 64 * (j))
#define XB_XSUB(j)  (1280 + 64 * (j))
#define XB_XGEN(j)  (2304 + 64 * (j))
#define XB_TOP      3328
#define XB_TOPGEN   3392
#define XCD_BAR_WORDS 3456
#define XB_SPIN_CAP (1u << 18)
__device__ __forceinline__ unsigned xb_ld(unsigned* p)              { return __hip_atomic_load(p, __ATOMIC_RELAXED, __HIP_MEMORY_SCOPE_AGENT); }
__device__ __forceinline__ unsigned xb_add(unsigned* p, unsigned v) { return __hip_atomic_fetch_add(p, v, __ATOMIC_RELAXED, __HIP_MEMORY_SCOPE_AGENT); }
__device__ __forceinline__ unsigned xb_xcc_id() { return (unsigned)__builtin_amdgcn_s_getreg((3 << 11) | 20) & 0xFu; }
#define XB_SPIN(cond, bar) do { unsigned _sp = 0; while (cond) { __builtin_amdgcn_s_sleep(1); \
    if ((++_sp & 255u) == 0u) { if (xb_ld(&(bar)[XB_TMO])) break; if (_sp > XB_SPIN_CAP) { atomicAdd(&(bar)[XB_TMO], 1u); break; } } } } while (0)
struct XcdBarrier { unsigned* bar; unsigned x; volatile LAS unsigned* st; };
__device__ __forceinline__ XcdBarrier xcd_barrier_post(unsigned* bar, volatile LAS unsigned* st) {
  XcdBarrier b; b.bar = bar; b.x = xb_xcc_id(); b.st = st;
  if (threadIdx.x == 0) (void)xb_add(&bar[XB_XCNT(b.x)], 1u);
  return b;
}
__device__ __forceinline__ void xcd_barrier_complete(unsigned* bar, unsigned x, unsigned& nloc, unsigned& nx) {
  const unsigned G = gridDim.x * gridDim.y * gridDim.z;
  unsigned sum, cnt, mine, sp = 0u;
  for (;;) {
    sum = 0u; cnt = 0u; mine = 0u;
#pragma unroll
    for (unsigned j = 0; j < 16; ++j) { const unsigned c = xb_ld(&bar[XB_XCNT(j)]); sum += c; cnt += (c > 0u) ? 1u : 0u; mine = (j == x) ? c : mine; }
    if (sum == G) break;
    __builtin_amdgcn_s_sleep(1);
    if ((++sp & 255u) == 0u) { if (xb_ld(&bar[XB_TMO])) break; if (sp > XB_SPIN_CAP) { atomicAdd(&bar[XB_TMO], 1u); break; } }
  }
  nloc = mine > 0u ? mine : 1u; nx = cnt > 0u ? cnt : 1u;
}
__device__ __forceinline__ void xcd_barrier(const XcdBarrier& b) {
  asm volatile("s_waitcnt vmcnt(0)" ::: "memory");
  __syncthreads();
  if (threadIdx.x == 0) {
    unsigned* bar = b.bar;
    __builtin_amdgcn_s_waitcnt(0);
    unsigned nloc = b.st[0], nx = b.st[1];
    if (nloc == 0u) { xcd_barrier_complete(bar, b.x, nloc, nx); b.st[0] = nloc; b.st[1] = nx; }
    const unsigned old = xb_add(&bar[XB_XSUB(b.x)], 1u);
    const unsigned gen = old / nloc;
    if (old + 1u == (gen + 1u) * nloc) {
      __builtin_amdgcn_fence(__ATOMIC_RELEASE, "agent");
      asm volatile("s_waitcnt vmcnt(0)" ::: "memory");
      const unsigned og = xb_add(&bar[XB_TOP], 1u);
      const unsigned tg = og / nx;
      if (og + 1u == (tg + 1u) * nx) xb_add(&bar[XB_TOPGEN], 1u);
      else XB_SPIN(xb_ld(&bar[XB_TOPGEN]) == tg, bar);
      __builtin_amdgcn_fence(__ATOMIC_ACQUIRE, "agent");
      xb_add(&bar[XB_XGEN(b.x)], 1u);
      asm volatile("s_waitcnt vmcnt(0)" ::: "memory");
    } else {
      XB_SPIN(xb_ld(&bar[XB_XGEN(b.x)]) == gen, bar);
      __builtin_amdgcn_fence(__ATOMIC_ACQUIRE, "agent");
      asm volatile("s_waitcnt vmcnt(0)" ::: "memory");
    }
  }
  __syncthreads();
}

__device__ __forceinline__ void conv_tile(const float* __restrict__ src, int ldn, int nvalid, int k0, int n0,
                                          bf16_t* dst, int ldk, int drow0, LAS float* tile, const float* kscale = nullptr) {
  const int tid = my_tid();
#pragma unroll
  for (int r = 0; r < 8; ++r) {
    const int k = r * 8 + (tid >> 6), n = tid & 63;
    const float ks = kscale ? kscale[k] : 1.0f;
    tile[k * 65 + n] = (n0 + n < nvalid) ? src[(size_t)(k0 + k) * ldn + n0 + n] * ks : 0.f;
  }
  __syncthreads();
  {
    const int n = tid >> 3, ks = tid & 7;
    u32x4 w;
    w.x = pack2(tile[(ks * 8 + 0) * 65 + n], tile[(ks * 8 + 1) * 65 + n]);
    w.y = pack2(tile[(ks * 8 + 2) * 65 + n], tile[(ks * 8 + 3) * 65 + n]);
    w.z = pack2(tile[(ks * 8 + 4) * 65 + n], tile[(ks * 8 + 5) * 65 + n]);
    w.w = pack2(tile[(ks * 8 + 6) * 65 + n], tile[(ks * 8 + 7) * 65 + n]);
    *(u32x4*)(dst + (size_t)(drow0 + n) * ldk + k0 + ks * 8) = w;
  }
  __syncthreads();
}

__device__ __forceinline__ void sincos_acc(float angf, float& c, float& s) {
  const double TWO_PI = 6.283185307179586476925286766559, INV_2PI = 0.15915494309189533576888376337251;
  const double a = (double)angf;
  const double k = __builtin_rint(a * INV_2PI);
  const float r = (float)(a - k * TWO_PI);
  const float r2 = r * r;
  float ts = r, tc = 1.0f, ss = r, cs = 1.0f;
#pragma unroll
  for (int n = 1; n <= 14; ++n) {
    tc = -tc * r2 * (1.0f / (float)((2 * n - 1) * (2 * n)));
    ts = -ts * r2 * (1.0f / (float)((2 * n) * (2 * n + 1)));
    cs += tc; ss += ts;
  }
  c = cs; s = ss;
}

__device__ __forceinline__ void phase0(const Params& p, LAS unsigned char* smem) {
  const int tid = my_tid();
  unsigned char* ws = p.ws;
  unsigned char* dout = (unsigned char*)p.out;
  LAS float* fl = (LAS float*)smem;
  constexpr int I_MOD = 96, I_ROPE = 8 + 4, I_CB1 = 2, I_WIN = 640, I_WOUT = 256, I_C1 = 128, I_C2 = 4, I_GU = 0, I_WD = 0;
  constexpr int O_ROPE = I_MOD, O_CB1 = O_ROPE + I_ROPE, O_WIN = O_CB1 + I_CB1, O_WOUT = O_WIN + I_WIN, O_C1 = O_WOUT + I_WOUT,
                O_C2 = O_C1 + I_C1, O_GU = O_C2 + I_C2, O_WD = O_GU + I_GU, O_END = O_WD + I_WD;
  if (blockIdx.x == 0 && tid < 130) {
    ((int*)(ws + WS_BOOK + BK_HIST))[tid] = 0;
  }
  for (int it = blockIdx.x; it < O_END; it += gridDim.x) {
    if (it < O_ROPE) {
      const int n0 = it * 64;
      LAS float* cact = fl;
      LAS float* red = fl + 16384;
      for (int i = tid; i < 16384; i += NTHR) { const float v = p.c[i]; cact[i] = v / (1.0f + __expf(-v)); }
      __syncthreads();
      const int nl = tid & 63, kp = tid >> 6;
      float acc[16];
#pragma unroll
      for (int b = 0; b < 16; ++b) acc[b] = 0.f;
      for (int k0 = kp * 128; k0 < kp * 128 + 128; k0 += 16) {
        float w[16];
#pragma unroll
        for (int q = 0; q < 16; ++q) w[q] = p.w_ada[(size_t)(k0 + q) * 6144 + n0 + nl];
#pragma unroll
        for (int q = 0; q < 16; ++q)
#pragma unroll
          for (int b = 0; b < 16; ++b) acc[b] += cact[b * 1024 + k0 + q] * w[q];
      }
#pragma unroll
      for (int b = 0; b < 16; ++b) red[(kp * 16 + b) * 64 + nl] = acc[b];
      __syncthreads();
      float* MOD = (float*)(ws + WS_BOOK + BK_MOD);
      for (int o = tid; o < 1024; o += NTHR) {
        const int b = o >> 6, n2 = o & 63;
        float s = p.b_ada[n0 + n2];
#pragma unroll
        for (int k2 = 0; k2 < 8; ++k2) s += red[(k2 * 16 + b) * 64 + n2];
        MOD[b * 6144 + n0 + n2] = s;
      }
      __syncthreads();
    } else if (it < O_CB1) {
      const int j = it - O_ROPE;
      if (j >= 8) {
        float* WRT = (float*)(ws + WS_BOOK + BK_WRT);
        for (int i = tid; i < 8192; i += NTHR) { const int idx = (j - 8) * 8192 + i, d = idx >> 5, e = idx & 31; WRT[e * 1024 + d] = p.w_router[idx]; }
        continue;
      }
      float* ROPE = (float*)(ws + WS_BOOK + BK_ROPE);
      const float invf[8] = {1.0f, 0.1939227432012558f, 0.03760603070259094f, 0.007292664609849453f, 0.0014142135623842478f,
                             0.00027424818836152554f, 5.318296098266728e-05f, 1.0313386155758053e-05f};
      for (int e = tid; e < 2048; e += NTHR) {
        const int s = j * 256 + (e >> 3), i = e & 7;
        float fr = 1.0f;
#pragma unroll
        for (int q = 0; q < 8; ++q) fr = (i == q) ? invf[q] : fr;
        const float ang = (float)s * fr;
        float cc, sn; sincos_acc(ang, cc, sn);
        ROPE[s * 16 + i] = cc; ROPE[s * 16 + 8 + i] = sn;
      }
    } else if (it < O_WIN) {
      const int kv = it - O_CB1;
      const float* pe = kv ? p.cmp_pe_v : p.cmp_pe_k;
      const float* w1 = kv ? p.cmp_v_w1 : p.cmp_k_w1;
      const int n4 = tid & 31, part = tid >> 5;
      f32x4 s = (f32x4){0.f, 0.f, 0.f, 0.f};
      for (int k0 = part * 128; k0 < part * 128 + 128; k0 += 16) {
        f32x4 w[16];
#pragma unroll
        for (int q = 0; q < 16; ++q) w[q] = *(const f32x4*)(w1 + (size_t)(k0 + q) * 128 + n4 * 4);
#pragma unroll
        for (int q = 0; q < 16; ++q) s += w[q] * pe[k0 + q];
      }
      *(LAS f32x4*)(fl + part * 128 + n4 * 4) = s;
      __syncthreads();
      if (tid < 128) { float r = 0.f;
#pragma unroll
        for (int q = 0; q < 16; ++q) r += fl[q * 128 + tid];
        ((float*)(ws + WS_BOOK + BK_CB1))[kv * 128 + tid] = r; }
      __syncthreads();
    } else break;
  }
  {
    struct CT { const float* src; const float* kscale; bf16_t* dst; int ldn, nvalid, k0, n0, ldk, drow0; };
    auto decode = [&](int it, CT& c) {
      c.kscale = nullptr;
      if (it < O_WOUT) {
        const int j = it - O_WIN, kt = j / 40, ntl = j % 40, n0 = ntl * 64;
        int drow0;
        if (n0 < 512) drow0 = (n0 >> 7) * 256 + (n0 & 127);
        else if (n0 < 1024) { const int cc = n0 - 512; drow0 = (cc >> 7) * 256 + 128 + (cc & 127); }
        else drow0 = n0;
        c.src = p.w_in; c.ldn = IN_COLS; c.nvalid = IN_COLS; c.k0 = kt * 64; c.n0 = n0; c.dst = (bf16_t*)(dout + DO_WIN); c.ldk = 1024; c.drow0 = drow0;
      } else if (it < O_C1) {
        const int j = it - O_WOUT, kt = j >> 4, ntl = j & 15;
        c.src = p.w_out; c.ldn = 1024; c.nvalid = 1024; c.k0 = kt * 64; c.n0 = ntl * 64; c.dst = (bf16_t*)(dout + DO_WOUT); c.ldk = 1024; c.drow0 = ntl * 64;
        c.kscale = kt >= 8 ? p.out_norm_nsa + (kt - 8) * 64 : nullptr;
      } else if (it < O_C2) {
        const int j = it - O_C1, kv = j >> 6, jj = j & 63, kt = jj >> 1, ntl = jj & 1;
        c.src = kv ? p.cmp_v_w1 : p.cmp_k_w1; c.ldn = 128; c.nvalid = 128; c.k0 = kt * 64; c.n0 = ntl * 64; c.dst = (bf16_t*)(dout + (kv ? DO_CV1 : DO_CK1)); c.ldk = 2048; c.drow0 = ntl * 64;
      } else {
        const int j = it - O_C2, kv = j >> 1, kt = j & 1;
        c.src = kv ? p.cmp_v_w2 : p.cmp_k_w2; c.ldn = 64; c.nvalid = 64; c.k0 = kt * 64; c.n0 = 0; c.dst = (bf16_t*)(dout + (kv ? DO_CV2 : DO_CK2)); c.ldk = 128; c.drow0 = 0;
      }
    };
    float rv[8];
    auto loadt = [&](const CT& c) {
#pragma unroll
      for (int r = 0; r < 8; ++r) {
        const int k = r * 8 + (tid >> 6), n = tid & 63;
        const float ks = c.kscale ? c.kscale[k] : 1.0f;
        rv[r] = (c.n0 + n < c.nvalid) ? c.src[(size_t)(c.k0 + k) * c.ldn + c.n0 + n] * ks : 0.f;
      }
    };
    int it = blockIdx.x;
    while (it < O_WIN) it += gridDim.x;
    __syncthreads();
    CT c;
    if (it < O_END) { decode(it, c); loadt(c); }
    while (it < O_END) {
#pragma unroll
      for (int r = 0; r < 8; ++r) fl[(r * 8 + (tid >> 6)) * 65 + (tid & 63)] = rv[r];
      const CT cc = c;
      const int nxt = it + (int)gridDim.x;
      if (nxt < O_END) { decode(nxt, c); loadt(c); }
      __syncthreads();
      {
        const int n = tid >> 3, ks = tid & 7;
        u32x4 w;
        w.x = pack2(fl[(ks * 8 + 0) * 65 + n], fl[(ks * 8 + 1) * 65 + n]);
        w.y = pack2(fl[(ks * 8 + 2) * 65 + n], fl[(ks * 8 + 3) * 65 + n]);
        w.z = pack2(fl[(ks * 8 + 4) * 65 + n], fl[(ks * 8 + 5) * 65 + n]);
        w.w = pack2(fl[(ks * 8 + 6) * 65 + n], fl[(ks * 8 + 7) * 65 + n]);
        *(u32x4*)(cc.dst + (size_t)(cc.drow0 + n) * cc.ldk + cc.k0 + ks * 8) = w;
      }
      __syncthreads();
      it = nxt;
    }
  }
  SUBSTAMP(20);
  {
    __syncthreads();
    constexpr int NIT = 32 * 3 * 8 * 8;
    const int kr = tid >> 5, n4 = tid & 31;
    f32x4 reg[8];
    auto src_of = [&](int it2, int& e, int& mat, int& kt, int& ntl) -> const float* {
      e = it2 / 192; const int r = it2 - e * 192; mat = r >> 6; kt = (r >> 3) & 7; ntl = r & 7;
      const float* base = (mat == 0) ? p.w_gate : (mat == 1 ? p.w_up : p.w_down);
      return base + (size_t)e * 1024 * 1024 + (size_t)(kt * 128) * 1024 + ntl * 128;
    };
    constexpr int NLB = 112, NLOW = NLB * 20;
    const bool lowblk = blockIdx.x < NLB;
    const int stride2 = lowblk ? NLB : (int)gridDim.x - NLB;
    const int end2 = lowblk ? NLOW : NIT;
    int it2 = lowblk ? (int)blockIdx.x : NLOW + ((int)blockIdx.x - NLB);
    int e, mat, kt, ntl;
    if (it2 < end2) {
      const float* s = src_of(it2, e, mat, kt, ntl);
#pragma unroll
      for (int r = 0; r < 8; ++r) reg[r] = *(const f32x4*)(s + (size_t)(kr + 16 * r) * 1024 + n4 * 4);
    }
    while (it2 < end2) {
#pragma unroll
      for (int r = 0; r < 8; ++r) { const int k = kr + 16 * r; *(LAS f32x4*)(fl + k * 128 + ((4 * n4) ^ (((k >> 3) & 15) << 2))) = reg[r]; }
      __syncthreads();
      const int ce = e, cmat = mat, ckt = kt, cntl = ntl;
      const int nxt = it2 + stride2;
      if (nxt < end2) {
        const float* s = src_of(nxt, e, mat, kt, ntl);
#pragma unroll
        for (int r = 0; r < 8; ++r) reg[r] = *(const f32x4*)(s + (size_t)(kr + 16 * r) * 1024 + n4 * 4);
      }
      unsigned char* dst = (cmat == 2) ? (dout + DO_WD) + (size_t)ce * 1024 * 1024 : (ws + WS_WGU) + (size_t)ce * 2048 * 1024;
      const int ks = tid & 15;
#pragma unroll
      for (int j = 0; j < 4; ++j) {
        const int n = (tid >> 4) + 32 * j;
        float v[8];
#pragma unroll
        for (int q = 0; q < 8; ++q) { const int k = 8 * ks + q; v[q] = fl[k * 128 + (n ^ (ks << 2))] * 32.0f; }
        u32x2 w; w.x = pack4_fp8(v[0], v[1], v[2], v[3]); w.y = pack4_fp8(v[4], v[5], v[6], v[7]);
        const int ng = cntl * 128 + n;
        const int drow = (cmat == 2) ? ng : ((ng >> 7) * 256 + cmat * 128 + (ng & 127));
        *(u32x2*)(dst + (size_t)drow * 1024 + ckt * 128 + ks * 8) = w;
      }
      __syncthreads();
      it2 = nxt;
    }
  }
  SUBSTAMP(21);
}

__device__ __forceinline__ void phase1(const Params& p) {
  const int tid = my_tid(), wid = tid >> 6, lane = tid & 63;
  const float* MOD = (const float*)(p.ws + WS_BOOK + BK_MOD);
  bf16_t* H = (bf16_t*)(p.ws + WS_H);
  for (int it = blockIdx.x; it < T_TOK / 128; it += gridDim.x) {
    const int t0 = it * 128, b = t0 / SEQ;
    f32x4 sc[4], sh[4];
#pragma unroll
    for (int j = 0; j < 4; ++j) {
      const int d = j * 256 + lane * 4;
      const f32x4 g = *(const f32x4*)(p.norm1_g + d);
      const f32x4 s1 = *(const f32x4*)(MOD + b * 6144 + 1024 + d);
      sh[j] = *(const f32x4*)(MOD + b * 6144 + d);
      sc[j] = g * (s1 + 1.0f);
    }
    for (int tt = wid; tt < 128; tt += 8) {
      const int t = t0 + tt;
      f32x4 v[4]; float ss = 0.f;
#pragma unroll
      for (int j = 0; j < 4; ++j) { v[j] = *(const f32x4*)(p.x + (size_t)t * DM + j * 256 + lane * 4); ss += v[j][0] * v[j][0] + v[j][1] * v[j][1] + v[j][2] * v[j][2] + v[j][3] * v[j][3]; }
      ss = wave_sum(ss);
      const float rstd = rsqrtf(ss * (1.0f / DM) + NORM_EPS);
#pragma unroll
      for (int j = 0; j < 4; ++j) {
        const f32x4 o = v[j] * rstd * sc[j] + sh[j];
        u32x2 w; w.x = pack2(o[0], o[1]); w.y = pack2(o[2], o[3]);
        *(u32x2*)(H + (size_t)t * DM + j * 256 + lane * 4) = w;
      }
    }
  }
}

namespace gm {
constexpr int BM = 256, BK = 64, HALF = 128, HTB = HALF * BK * 2, STAGE_BYTES = 8 * HTB, KDIM = 1024, NT = KDIM / BK;
__device__ __forceinline__ int lds_byte(int r, int c) { const int st = (r >> 4) * 2 + (c >> 5), rr = r & 15, cc = c & 31, ob = rr * 64 + cc * 2; return st * 1024 + (ob ^ (((ob >> 9) & 1) << 5)); }
__device__ __forceinline__ void stage_rc(int b, int& R, int& C) { const int st = b / 1024, sb = b % 1024, swz = sb ^ (((sb >> 9) & 1) << 5); R = (st >> 1) * 16 + swz / 64; C = (st & 1) * 32 + (swz % 64) / 2; }
__device__ __forceinline__ int perm32(int rho) { const int n = rho >> 4, i = rho & 15; return 8 * (i >> 2) + 4 * n + (i & 3); }

typedef int v8i __attribute__((ext_vector_type(8)));
typedef int v4i __attribute__((ext_vector_type(4)));
__device__ __forceinline__ v8i cat8(bf16x8 a, bf16x8 b) { return __builtin_shufflevector(__builtin_bit_cast(v4i, a), __builtin_bit_cast(v4i, b), 0, 1, 2, 3, 4, 5, 6, 7); }
__device__ __forceinline__ void glds16(const char* sbase, unsigned voff, unsigned lds_dst) {
  unsigned keep;
  asm volatile("s_mov_b32 %0, m0\n\ts_mov_b32 m0, %3\n\ts_nop 0\n\tglobal_load_lds_dwordx4 %1, %2\n\ts_mov_b32 m0, %0" : "=&s"(keep) : "v"(voff), "s"(sbase), "s"(lds_dst) : "memory");
}
struct Unit {
  const char* A;
  const char* B;
  unsigned ao[2][2];
  int pm, pn, e, row0, nrows;
};

template <bool FP8, class Epi, class Sched, int KT0 = 0>
__device__ __forceinline__ void gemm_phase(LAS unsigned char* lds, const Sched& S, const Epi& E, unsigned long long* gprof = nullptr) {
  const int tid = my_tid(), wid = __builtin_amdgcn_readfirstlane(tid >> 6), lane = tid & 63, wr = wid >> 2, wc = wid & 3, fr = lane & 15, fq = lane >> 4;
  constexpr int PITCH = FP8 ? 1024 : 2048, nt = FP8 ? 8 : 16;
  unsigned voffB[2];
#pragma unroll
  for (int i = 0; i < 2; ++i) { int R, C; stage_rc(tid * 16 + i * 8192, R, C); const int Rb = (R & ~31) + perm32(R & 31);
    voffB[i] = (unsigned)(Rb * PITCH + C * 2); }
  const size_t kstep = (size_t)(BK * 2);
  const size_t hstep = (size_t)HALF * PITCH;
  const unsigned ldsw = (unsigned)wid * 1024u;
  const unsigned ldsbase = (unsigned)(size_t)lds;
  const int aoff = lds_byte(wr * 64 + fr, fq * 8), boff = lds_byte(wc * 32 + fr, fq * 8);
#define GM_SA(b, h) (((b) * 2 + (h)) * HTB)
#define GM_SB(b, h) ((4 + (b) * 2 + (h)) * HTB)
#define GM_STAGE(bufoff, gbase, voff) do { _Pragma("unroll") for (int _i = 0; _i < 2; ++_i) glds16((const char*)(gbase), (voff)[_i], ldsbase + (unsigned)(bufoff) + ldsw + (unsigned)(_i * 8192)); } while (0)
#define GM_LDA(dst, b, h) do { _Pragma("unroll") for (int m = 0; m < 4; ++m) dst[m] = __builtin_shufflevector(*(const LAS v4i*)(lds + GM_SA(b, h) + aoff + m * 2048), *(const LAS v4i*)(lds + GM_SA(b, h) + aoff + m * 2048 + 1024), 0, 1, 2, 3, 4, 5, 6, 7); } while (0)
#define GM_LDB(dst, b, h) do { _Pragma("unroll") for (int n = 0; n < 2; ++n) dst[n] = __builtin_shufflevector(*(const LAS v4i*)(lds + GM_SB(b, h) + boff + n * 2048), *(const LAS v4i*)(lds + GM_SB(b, h) + boff + n * 2048 + 1024), 0, 1, 2, 3, 4, 5, 6, 7); } while (0)
#define GM_LO(x) __builtin_bit_cast(bf16x8, __builtin_shufflevector(x, x, 0, 1, 2, 3))
#define GM_HI(x) __builtin_bit_cast(bf16x8, __builtin_shufflevector(x, x, 4, 5, 6, 7))
#define GM_MMA(ai, bj, At, Bt) do { __builtin_amdgcn_s_setprio(1); _Pragma("unroll") for (int m = 0; m < 4; ++m) _Pragma("unroll") for (int n = 0; n < 2; ++n) { \
    if constexpr (FP8) acc[ai][bj][m][n] = __builtin_amdgcn_mfma_scale_f32_16x16x128_f8f6f4(Bt[n], At[m], acc[ai][bj][m][n], 0, 0, 0, 0x7F7F7F7F, 0, 0x7F7F7F7F); \
    else { acc[ai][bj][m][n] = __builtin_amdgcn_mfma_f32_16x16x32_bf16(GM_LO(Bt[n]), GM_LO(At[m]), acc[ai][bj][m][n], 0, 0, 0); \
           acc[ai][bj][m][n] = __builtin_amdgcn_mfma_f32_16x16x32_bf16(GM_HI(Bt[n]), GM_HI(At[m]), acc[ai][bj][m][n], 0, 0, 0); } } \
    __builtin_amdgcn_s_setprio(0); } while (0)
#define GM_WAIT_V(n) asm volatile("s_waitcnt vmcnt(" #n ")" ::: "memory")
#define GM_WAIT_L(n) asm volatile("s_waitcnt lgkmcnt(" #n ")" ::: "memory")
#define GM_BAR __builtin_amdgcn_s_barrier()
#define GM_SCHED __builtin_amdgcn_sched_barrier(0)
  Unit cur, nxt; int ui = 0;
  if (!S.next(0, cur, tid)) return;
  f32x4 acc[2][2][4][2];
  typename Epi::State est;
  { typename Epi::Pre pre0; E.prefetch(pre0, cur, wr, wc, fr, fq); E.init(acc, pre0, est); }
  v8i At[4], B0[2], B1[2];
  constexpr size_t koff0 = (size_t)KT0 * 128;
  const char* cA = cur.A; const char* cB = cur.B;
  unsigned cao0[2] = {cur.ao[0][0], cur.ao[0][1]}, cao1[2] = {cur.ao[1][0], cur.ao[1][1]};
  GM_STAGE(GM_SB(0, 0), cB + koff0, voffB); GM_STAGE(GM_SB(0, 1), cB + koff0 + hstep, voffB); GM_STAGE(GM_SA(0, 0), cA + koff0, cao0); GM_STAGE(GM_SA(0, 1), cA + koff0, cao1);
  if (wr == 1) GM_BAR;
  GM_WAIT_V(2); GM_BAR;
  GM_STAGE(GM_SB(1, 0), cB + koff0 + kstep, voffB); GM_STAGE(GM_SA(1, 0), cA + koff0 + kstep, cao0); GM_STAGE(GM_SB(1, 1), cB + koff0 + hstep + kstep, voffB);
  GM_WAIT_V(6); GM_BAR;
#if PROF_ON && PROF_GEMM
  unsigned long long tk = 0, te = 0, t_a = 0, t_b = 0; unsigned nun = 0;
#define GP_T() wall_clock64()
#else
#define GP_T() 0ull
#endif
  for (;;) {
#if PROF_ON && PROF_GEMM
    t_a = GP_T();
#endif
    const bool has_next = S.next(ui + 1, nxt, tid);
    const char* nA = has_next ? nxt.A : cA; const char* nB = has_next ? nxt.B : cB;
#pragma unroll 1
    for (int t = 0; t < nt; t += 2) {
      const bool last = (t == nt - 2);
      const char* a1 = cA + (size_t)((t + 1 + KT0) & (nt - 1)) * kstep;
      const char* a2 = last ? nA + koff0 : cA + (size_t)((t + 2 + KT0) & (nt - 1)) * kstep; const char* b2 = last ? nB + koff0 : cB + (size_t)((t + 2 + KT0) & (nt - 1)) * kstep;
      const char* a3 = a2 + kstep; const char* b3 = b2 + kstep;
      GM_LDB(B0, 0, 0); GM_LDB(B1, 0, 1); GM_SCHED; GM_LDA(At, 0, 0); GM_STAGE(GM_SA(1, 1), a1, cao1);
      if (last && has_next) { cao0[0] = nxt.ao[0][0]; cao0[1] = nxt.ao[0][1]; cao1[0] = nxt.ao[1][0]; cao1[1] = nxt.ao[1][1]; }
      GM_WAIT_V(8); GM_WAIT_L(0); GM_BAR; GM_MMA(0, 0, At, B0); GM_MMA(0, 1, At, B1); GM_BAR; GM_SCHED;
      GM_LDA(At, 0, 1); GM_STAGE(GM_SB(0, 0), b2, voffB); GM_STAGE(GM_SB(0, 1), b2 + hstep, voffB); GM_STAGE(GM_SA(0, 0), a2, cao0);
      GM_WAIT_V(8); GM_WAIT_L(0); GM_BAR; GM_MMA(1, 0, At, B0); GM_MMA(1, 1, At, B1); GM_BAR; GM_SCHED;
      GM_LDB(B0, 1, 0); GM_LDB(B1, 1, 1); GM_SCHED; GM_LDA(At, 1, 0); GM_STAGE(GM_SA(0, 1), a2, cao1);
      GM_WAIT_V(8); GM_WAIT_L(0); GM_BAR; GM_MMA(0, 0, At, B0); GM_MMA(0, 1, At, B1); GM_BAR; GM_SCHED;
      GM_LDA(At, 1, 1); GM_STAGE(GM_SB(1, 0), b3, voffB); GM_STAGE(GM_SB(1, 1), b3 + hstep, voffB); GM_STAGE(GM_SA(1, 0), a3, cao0);
      GM_WAIT_V(8); GM_WAIT_L(0); GM_BAR; GM_MMA(1, 0, At, B0); GM_MMA(1, 1, At, B1); GM_BAR; GM_SCHED;
      if constexpr (Epi::HAS_MID) { if (t == nt / 2 - 2) E.mid(acc, est); }
    }
    if (wr == 0) GM_BAR;
#if PROF_ON && PROF_GEMM
    t_b = GP_T(); tk += t_b - t_a;
#endif
#pragma unroll
    for (int a = 0; a < 2; ++a)
#pragma unroll
      for (int b = 0; b < 2; ++b)
#pragma unroll
        for (int m = 0; m < 4; ++m)
#pragma unroll
          for (int n = 0; n < 2; ++n) asm volatile("" : "+v"(acc[a][b][m][n]));
    typename Epi::Pre pre;
    if (has_next) E.prefetch(pre, nxt, wr, wc, fr, fq);
    E(acc, cur, wr, wc, fr, fq);
#if PROF_ON && PROF_GEMM
    asm volatile("s_waitcnt vmcnt(0)" ::: "memory");
    te += GP_T() - t_b; ++nun;
#endif
    if (!has_next) break;
    E.init(acc, pre, est);
    cur = nxt; cA = nA; cB = nB; ++ui;
    if (wr == 1) GM_BAR;
  }
  GM_WAIT_V(0);
  GM_BAR;
#if PROF_ON && PROF_GEMM
  if (gprof && blockIdx.x == 0 && threadIdx.x == 0) { gprof[0] = tk; gprof[1] = te; gprof[2] = nun; }
#endif
#undef GM_SA
#undef GM_SB
#undef GM_STAGE
#undef GM_LDA
#undef GM_LDB
#undef GM_MMA
#undef GM_LO
#undef GM_HI
#undef GM_WAIT_V
#undef GM_WAIT_L
#undef GM_BAR
#undef GM_SCHED
}

__device__ __forceinline__ int unit_index(int i) {
  const int G = gridDim.x, c = blockIdx.x;
  return i * G + (c & 7) * (G >> 3) + (c >> 3);
}
}

__device__ __forceinline__ unsigned cvt_pk_bf16(float lo, float hi) { unsigned r; asm volatile("v_cvt_pk_bf16_f32 %0, %1, %2" : "=v"(r) : "v"(lo), "v"(hi)); return r; }
__device__ __forceinline__ u32x4 pack8(const f32x4& a, const f32x4& b) { u32x4 w; w.x = cvt_pk_bf16(a[0], a[1]); w.y = cvt_pk_bf16(a[2], a[3]); w.z = cvt_pk_bf16(b[0], b[1]); w.w = cvt_pk_bf16(b[2], b[3]); return w; }

__device__ __forceinline__ u32x2 pack8_fp8_nc(const f32x4& a, const f32x4& b) {
  int w0 = 0, w1 = 0;
  w0 = __builtin_amdgcn_cvt_pk_fp8_f32(a[0], a[1], w0, false); w0 = __builtin_amdgcn_cvt_pk_fp8_f32(a[2], a[3], w0, true);
  w1 = __builtin_amdgcn_cvt_pk_fp8_f32(b[0], b[1], w1, false); w1 = __builtin_amdgcn_cvt_pk_fp8_f32(b[2], b[3], w1, true);
  u32x2 w; w.x = (unsigned)w0; w.y = (unsigned)w1; return w;
}
__device__ __forceinline__ u32x2 pack8_fp8(const f32x4& a, const f32x4& b) { u32x2 w; w.x = pack4_fp8(a[0], a[1], a[2], a[3]); w.y = pack4_fp8(b[0], b[1], b[2], b[3]); return w; }

struct DenseSched {
  const char* A; const char* Bt; int nN, nunits;
  __device__ __forceinline__ bool next(int i, gm::Unit& u, int tid) const {
    int RA[2], CA[2];
#pragma unroll
    for (int q = 0; q < 2; ++q) gm::stage_rc(tid * 16 + q * 8192, RA[q], CA[q]);
    const int L = gm::unit_index(i); if (L >= nunits) return false;
    u.pm = L / nN; u.pn = L - u.pm * nN; u.e = 0; u.row0 = u.pm * 256; u.nrows = 256;
    u.A = A + (size_t)u.pm * (256 * 1024 * 2); u.B = Bt + (size_t)u.pn * (256 * 1024 * 2);
#pragma unroll
    for (int h = 0; h < 2; ++h)
#pragma unroll
      for (int j = 0; j < 2; ++j) u.ao[h][j] = (unsigned)((h * 128 + RA[j]) * 1024 + CA[j]) * 2u;
    return true;
  }
};
constexpr int TAB_OFF = 131072 + 1024;
__device__ __forceinline__ int load_unit_table(LAS unsigned char* smem, const int* ecnt, int upt_shift) {
  const int tid = my_tid(), lane = tid & 63;
  LAS int* tb = (LAS int*)(smem + TAB_OFF + 512);
  __syncthreads();
  if (tid < 64) {
    const int tot = (lane < 32) ? ecnt[lane] : 0;
    const int ntl = (tot + 255) >> 8;
    int sb = tot, st = ntl;
#pragma unroll
    for (int o = 1; o < 32; o <<= 1) { const int ub = __shfl_up(sb, o), ut = __shfl_up(st, o); if (lane >= o) { sb += ub; st += ut; } }
    if (lane < 32) { tb[lane] = st - ntl; tb[32 + lane] = ntl; tb[64 + lane] = sb - tot; tb[96 + lane] = tot; }
    if (lane == 31) tb[128] = st;
  }
  __syncthreads();
  const int ntiles = __builtin_amdgcn_readfirstlane(tb[128]);
  if (tid < 32) {
    const int L = gm::unit_index(tid), ti = L >> upt_shift;
    u32x4 e = (u32x4){0u, 0u, 0u, 0u};
    if (ti < ntiles) {
      int ex = 0;
#pragma unroll 1
      for (int q = 0; q < 32; ++q) ex = (tb[q] <= ti && ti < tb[q] + tb[32 + q]) ? q : ex;
      const int r = ti - tb[ex], tot = tb[96 + ex];
      e = (u32x4){(unsigned)ex, (unsigned)(tb[64 + ex] + r * 256), (unsigned)((tot - r * 256 < 256) ? tot - r * 256 : 256), (unsigned)(r * 256)};
    }
    *(LAS u32x4*)(smem + TAB_OFF + tid * 16) = e;
  }
  __syncthreads();
  return ntiles;
}
struct GuSched {
  const char* H2; const char* W; LAS unsigned char* tab; const int* rowtok; int ntiles;
  __device__ __forceinline__ bool next(int i, gm::Unit& u, int tid) const {
    int RA[2], CA[2];
#pragma unroll
    for (int q = 0; q < 2; ++q) gm::stage_rc(tid * 16 + q * 8192, RA[q], CA[q]);
    const int L = gm::unit_index(i); if (L >= ntiles * 8) return false;
    const int ti = L >> 3; u.pn = L & 7; u.pm = ti;
    const u32x4 ent = *(const LAS u32x4*)(tab + i * 16);
    u.e = __builtin_amdgcn_readfirstlane((int)ent.x);
    u.row0 = __builtin_amdgcn_readfirstlane((int)ent.y);
    u.nrows = __builtin_amdgcn_readfirstlane((int)ent.z);
    u.A = H2; u.B = W + (size_t)u.e * (2048 * 1024) + (size_t)u.pn * (256 * 1024);
#pragma unroll
    for (int h = 0; h < 2; ++h)
#pragma unroll
      for (int j = 0; j < 2; ++j) { const int rl = h * 128 + RA[j]; const int tok = rowtok[u.e * 32768 + (int)ent.w + (rl < u.nrows ? rl : 0)];
        u.ao[h][j] = (unsigned)(tok * 1024 + CA[j] * 2); }
    return true;
  }
};
struct DownSched {
  const char* ACT; const char* W; LAS unsigned char* tab; int ntiles;
  __device__ __forceinline__ bool next(int i, gm::Unit& u, int tid) const {
    int RA[2], CA[2];
#pragma unroll
    for (int q = 0; q < 2; ++q) gm::stage_rc(tid * 16 + q * 8192, RA[q], CA[q]);
    const int L = gm::unit_index(i); if (L >= ntiles * 4) return false;
    const int ti = L >> 2; u.pn = L & 3; u.pm = ti;
    const u32x4 ent = *(const LAS u32x4*)(tab + i * 16);
    u.e = __builtin_amdgcn_readfirstlane((int)ent.x);
    u.row0 = __builtin_amdgcn_readfirstlane((int)ent.y);
    u.nrows = __builtin_amdgcn_readfirstlane((int)ent.z);
    u.A = ACT + (size_t)u.row0 * 1024; u.B = W + (size_t)u.e * (1024 * 1024) + (size_t)u.pn * (256 * 1024);
#pragma unroll
    for (int h = 0; h < 2; ++h)
#pragma unroll
      for (int j = 0; j < 2; ++j) { const int rl = h * 128 + RA[j]; u.ao[h][j] = (unsigned)((rl < u.nrows ? rl : u.nrows - 1) * 1024 + CA[j] * 2); }
    return true;
  }
};

struct EpiProj {
  bf16_t *U, *Q, *KV; float* GATES; const float* ROPE;
  struct Pre {};
  __device__ __forceinline__ void prefetch(Pre&, const gm::Unit&, int, int, int, int) const {}
  struct State {}; static constexpr bool HAS_MID = false;
  __device__ __forceinline__ void init(f32x4 (&acc)[2][2][4][2], const Pre&, State&) const {
#pragma unroll
    for (int a = 0; a < 2; ++a)
#pragma unroll
      for (int b = 0; b < 2; ++b)
#pragma unroll
        for (int m = 0; m < 4; ++m)
#pragma unroll
          for (int n = 0; n < 2; ++n) acc[a][b][m][n] = (f32x4){0.f, 0.f, 0.f, 0.f};
  }
  __device__ __forceinline__ void operator()(const f32x4 (&acc)[2][2][4][2], const gm::Unit& u, int wr, int wc, int fr, int fq) const {
    const int pn = u.pn;
#pragma unroll
    for (int ai = 0; ai < 2; ++ai)
#pragma unroll
      for (int m = 0; m < 4; ++m) {
        const int row = u.pm * 256 + ai * 128 + wr * 64 + m * 16 + fr;
        const int s = row & 2047, b = row >> 11;
        if (pn < 4) {
          f32x4 o[2];
#pragma unroll
          for (int n = 0; n < 2; ++n)
#pragma unroll
            for (int j = 0; j < 4; j += 2) {
              const f32x2 gq = (f32x2){acc[ai][1][m][n][j], acc[ai][1][m][n][j + 1]} * -1.4426950408889634f;
              f32x2 e; e[0] = __builtin_amdgcn_exp2f(gq[0]); e[1] = __builtin_amdgcn_exp2f(gq[1]);
              const f32x2 den = e + 1.0f;
              f32x2 r; r[0] = __builtin_amdgcn_rcpf(den[0]); r[1] = __builtin_amdgcn_rcpf(den[1]);
              const f32x2 res = (f32x2){acc[ai][0][m][n][j], acc[ai][0][m][n][j + 1]} * r;
              o[n][j] = res[0]; o[n][j + 1] = res[1];
            }
          *(u32x4*)(U + (size_t)row * 512 + pn * 128 + wc * 32 + 8 * fq) = pack8(o[0], o[1]);
        } else if (pn < 9) {
          const bool isq = pn < 6;
#pragma unroll
          for (int bj = 0; bj < 2; ++bj) {
            f32x4 v[2] = {acc[ai][bj][m][0], acc[ai][bj][m][1]};
            const bool dorope = (isq || bj == 0) && ((wc & 1) == 0);
            if (dorope) {
              const f32x4 c0 = *(const f32x4*)(ROPE + s * 16), c1 = *(const f32x4*)(ROPE + s * 16 + 4);
              const f32x4 s0 = *(const f32x4*)(ROPE + s * 16 + 8), s1 = *(const f32x4*)(ROPE + s * 16 + 12);
              const f32x4 cs[2] = {c0, c1}, sn[2] = {s0, s1};
              const float sgn = (fq == 0) ? -1.0f : 1.0f;
#pragma unroll
              for (int n = 0; n < 2; ++n)
#pragma unroll
                for (int j = 0; j < 4; ++j) {
                  const auto sw = __builtin_amdgcn_permlane16_swap(__float_as_uint(v[n][j]), __float_as_uint(v[n][j]), false, false);
                  const float other = __uint_as_float((fq & 1) ? sw[0] : sw[1]);
                  const float r = v[n][j] * cs[n][j] + sgn * other * sn[n][j];
                  v[n][j] = (fq < 2) ? r : v[n][j];
                }
            }
            if (isq) {
              v[0] = v[0] * 0.18033688011112042f; v[1] = v[1] * 0.18033688011112042f;
              *(u32x4*)(Q + (size_t)row * 512 + (pn - 4) * 256 + bj * 128 + wc * 32 + 8 * fq) = pack8(v[0], v[1]);
            } else {
              const int idx = (pn - 6) * 2 + bj, g = wc >> 1, hd0 = (wc & 1) * 32 + 8 * fq;
              *(u32x4*)(KV + (size_t)idx * (16 * 2 * 2048 * 64) + ((size_t)(b * 2 + g) * 2048 + s) * 64 + hd0) = pack8(v[0], v[1]);
            }
          }
        } else {
          if (wc == 0 && fq < 3) {
#pragma unroll
            for (int n = 0; n < 2; ++n) {
              f32x4 o;
#pragma unroll
              for (int j = 0; j < 4; ++j) o[j] = sigmoidf_(acc[ai][0][m][n][j]);
              *(f32x4*)(GATES + (size_t)row * 24 + 8 * fq + 4 * n) = o;
            }
          }
        }
      }
  }
};
struct EpiOut {
  bf16_t* X1; const float* MOD; const float* x; const float* SSQ;
  struct Pre { const float* rowp; };
  struct State { float rstd[2][4]; };
  static constexpr bool HAS_MID = true;
  __device__ __forceinline__ void prefetch(Pre& q, const gm::Unit& u, int wr, int wc, int fr, int fq) const { q.rowp = SSQ + (size_t)(u.pm * 256 + wr * 64 + fr) * 2; }
  __device__ __forceinline__ void init(f32x4 (&acc)[2][2][4][2], const Pre& q, State& st) const {
#pragma unroll
    for (int ai = 0; ai < 2; ++ai)
#pragma unroll
      for (int m = 0; m < 4; ++m) { const f32x2 s2 = *(const f32x2*)(q.rowp + (ai * 128 + m * 16) * 2); st.rstd[ai][m] = rsqrtf((s2[0] + s2[1]) * (1.0f / 512.0f) + NORM_EPS); }
#pragma unroll
    for (int a = 0; a < 2; ++a)
#pragma unroll
      for (int b = 0; b < 2; ++b)
#pragma unroll
        for (int m = 0; m < 4; ++m)
#pragma unroll
          for (int n = 0; n < 2; ++n) acc[a][b][m][n] = (f32x4){0.f, 0.f, 0.f, 0.f};
  }
  __device__ __forceinline__ void mid(f32x4 (&acc)[2][2][4][2], const State& st) const {
#pragma unroll
    for (int a = 0; a < 2; ++a)
#pragma unroll
      for (int b = 0; b < 2; ++b)
#pragma unroll
        for (int m = 0; m < 4; ++m)
#pragma unroll
          for (int n = 0; n < 2; ++n) acc[a][b][m][n] = acc[a][b][m][n] * st.rstd[a][m];
  }
  __device__ __forceinline__ void operator()(const f32x4 (&acc)[2][2][4][2], const gm::Unit& u, int wr, int wc, int fr, int fq) const {
#pragma unroll
    for (int bj = 0; bj < 2; ++bj) {
      const int col0 = u.pn * 256 + bj * 128 + wc * 32 + 8 * fq;
      const int b = (u.pm * 256) >> 11;
      const f32x4 g0 = *(const f32x4*)(MOD + b * 6144 + 2048 + col0), g1 = *(const f32x4*)(MOD + b * 6144 + 2048 + col0 + 4);
#pragma unroll
      for (int ai = 0; ai < 2; ++ai) {
#pragma unroll
        for (int m2 = 0; m2 < 4; m2 += 2) {
          f32x4 xa[2], xb[2];
#pragma unroll
          for (int q = 0; q < 2; ++q) {
            const int row = u.pm * 256 + ai * 128 + wr * 64 + (m2 + q) * 16 + fr;
            xa[q] = *(const f32x4*)(x + (size_t)row * 1024 + col0); xb[q] = *(const f32x4*)(x + (size_t)row * 1024 + col0 + 4);
          }
#pragma unroll
          for (int q = 0; q < 2; ++q) {
            const int row = u.pm * 256 + ai * 128 + wr * 64 + (m2 + q) * 16 + fr;
            *(u32x4*)(X1 + (size_t)row * 1024 + col0) = pack8(xa[q] + acc[ai][bj][m2 + q][0] * g0, xb[q] + acc[ai][bj][m2 + q][1] * g1);
          }
        }
      }
    }
  }
};
struct EpiGU {
  unsigned char* ACT; const float* bg; const float* bu;
  struct Pre { f32x4 b[2][2]; };
  __device__ __forceinline__ void prefetch(Pre& q, const gm::Unit& u, int wr, int wc, int fr, int fq) const {
    const int f0 = u.pn * 128 + wc * 32 + 8 * fq;
    q.b[0][0] = *(const f32x4*)(bg + u.e * 1024 + f0); q.b[0][1] = *(const f32x4*)(bg + u.e * 1024 + f0 + 4);
    q.b[1][0] = *(const f32x4*)(bu + u.e * 1024 + f0); q.b[1][1] = *(const f32x4*)(bu + u.e * 1024 + f0 + 4);
  }
  struct State {}; static constexpr bool HAS_MID = false;
  __device__ __forceinline__ void init(f32x4 (&acc)[2][2][4][2], const Pre& q, State&) const {
#pragma unroll
    for (int a = 0; a < 2; ++a)
#pragma unroll
      for (int bj = 0; bj < 2; ++bj)
#pragma unroll
        for (int m = 0; m < 4; ++m)
#pragma unroll
          for (int n = 0; n < 2; ++n) acc[a][bj][m][n] = q.b[bj][n] * 512.0f;
  }
  __device__ __forceinline__ void operator()(const f32x4 (&acc)[2][2][4][2], const gm::Unit& u, int wr, int wc, int fr, int fq) const {
    const int f0 = u.pn * 128 + wc * 32 + 8 * fq;
#pragma unroll
    for (int ai = 0; ai < 2; ++ai)
#pragma unroll
      for (int m = 0; m < 4; ++m) {
        const int rl = ai * 128 + wr * 64 + m * 16 + fr;
        f32x4 o[2];
#pragma unroll
        for (int n = 0; n < 2; ++n)
#pragma unroll
          for (int j = 0; j < 4; j += 2) {
            f32x2 g, uu;
            g[0] = __builtin_amdgcn_fmed3f(acc[ai][0][m][n][j], -3.0e38f, 7.0f * 512.0f);     g[1] = __builtin_amdgcn_fmed3f(acc[ai][0][m][n][j + 1], -3.0e38f, 7.0f * 512.0f);
            uu[0] = __builtin_amdgcn_fmed3f(acc[ai][1][m][n][j], -7.0f * 512.0f, 7.0f * 512.0f); uu[1] = __builtin_amdgcn_fmed3f(acc[ai][1][m][n][j + 1], -7.0f * 512.0f, 7.0f * 512.0f);
            const f32x2 ea = g * (-1.702f * 1.4426950408889634f / 512.0f);
            f32x2 e; e[0] = __builtin_amdgcn_exp2f(ea[0]); e[1] = __builtin_amdgcn_exp2f(ea[1]);
            const f32x2 den = e + 1.0f;
            f32x2 r; r[0] = __builtin_amdgcn_rcpf(den[0]); r[1] = __builtin_amdgcn_rcpf(den[1]);
            const f32x2 res = (g * r) * (uu * (8.0f / 262144.0f) + (8.0f / 512.0f));
            o[n][j] = res[0]; o[n][j + 1] = res[1];
          }
        if (rl < u.nrows) *(u32x2*)(ACT + (size_t)(u.row0 + rl) * 1024 + f0) = pack8_fp8_nc(o[0], o[1]);
      }
  }
};
struct EpiDown {
  unsigned char* Y; const float* bd;
  struct Pre { f32x4 b[2][2]; };
  __device__ __forceinline__ void prefetch(Pre& q, const gm::Unit& u, int wr, int wc, int fr, int fq) const {
#pragma unroll
    for (int bj = 0; bj < 2; ++bj) {
      const int col0 = u.pn * 256 + bj * 128 + wc * 32 + 8 * fq;
      q.b[bj][0] = *(const f32x4*)(bd + u.e * 1024 + col0); q.b[bj][1] = *(const f32x4*)(bd + u.e * 1024 + col0 + 4);
    }
  }
  struct State {}; static constexpr bool HAS_MID = false;
  __device__ __forceinline__ void init(f32x4 (&acc)[2][2][4][2], const Pre& q, State&) const {
#pragma unroll
    for (int bj = 0; bj < 2; ++bj)
#pragma unroll
      for (int a = 0; a < 2; ++a)
#pragma unroll
        for (int m = 0; m < 4; ++m) { acc[a][bj][m][0] = q.b[bj][0] * 256.0f; acc[a][bj][m][1] = q.b[bj][1] * 256.0f; }
  }
  __device__ __forceinline__ void operator()(const f32x4 (&acc)[2][2][4][2], const gm::Unit& u, int wr, int wc, int fr, int fq) const {
#pragma unroll
    for (int bj = 0; bj < 2; ++bj) {
      const int col0 = u.pn * 256 + bj * 128 + wc * 32 + 8 * fq;
#pragma unroll
      for (int ai = 0; ai < 2; ++ai)
#pragma unroll
        for (int m = 0; m < 4; ++m) {
          const int rl = ai * 128 + wr * 64 + m * 16 + fr;
          if (rl < u.nrows) *(u32x2*)(Y + (size_t)(u.row0 + rl) * 1024 + col0) = pack8_fp8(acc[ai][bj][m][0] * (1.0f / 16.0f), acc[ai][bj][m][1] * (1.0f / 16.0f));
        }
    }
  }
};

__device__ __forceinline__ void compress_item(const Params& p, LAS unsigned char* smem, int it) {
  const int tid = my_tid(), wid = __builtin_amdgcn_readfirstlane(tid >> 6), lane = tid & 63;
  unsigned char* ws = p.ws; unsigned char* dout = (unsigned char*)p.out;
  {
    const int kv = it >> 6, bg = (it >> 1) & 31, mh = it & 1;
    const bf16_t* X = (const bf16_t*)(ws + WS_KV) + (size_t)kv * (16 * 2 * 2048 * 64) + (size_t)bg * 2048 * 64;
    const bf16_t* W1T = (const bf16_t*)(dout + (kv ? DO_CV1 : DO_CK1));
    const bf16_t* W2T = (const bf16_t*)(dout + (kv ? DO_CV2 : DO_CK2));
    const float* b1 = (const float*)(ws + WS_BOOK + BK_CB1) + kv * 128;
    bf16_t* OUT = (bf16_t*)(ws + WS_BOOK + (kv ? BK_VCMP : BK_KCMP)) + (size_t)bg * 128 * 64;
    const int fr = lane & 15, fq = lane >> 4;
    f32x4 acc[4];
#pragma unroll
    for (int mt = 0; mt < 4; ++mt) acc[mt] = (f32x4){0.f, 0.f, 0.f, 0.f};
    constexpr int ASTR = 528, ABUF = 64 * ASTR;
    LAS unsigned char* abuf = smem + 32768;
    const bf16_t* arow_g = X + (size_t)(64 * mh + (tid >> 5)) * 1024 + (tid & 31) * 8;
    const bf16_t* brow = W1T + (size_t)(16 * wid + fr) * 2048 + 8 * fq;
    u32x4 an[4]; bf16x8 bc[8], bn[8];
    __syncthreads();
#pragma unroll
    for (int i = 0; i < 4; ++i) an[i] = *(const u32x4*)(arow_g + (size_t)i * 16 * 1024);
#pragma unroll
    for (int s = 0; s < 8; ++s) bc[s] = *(const bf16x8*)(brow + 32 * s);
#pragma unroll
    for (int i = 0; i < 4; ++i) *(LAS u32x4*)(abuf + ((tid >> 5) + 16 * i) * ASTR + (tid & 31) * 16) = an[i];
    __syncthreads();
#pragma unroll 1
    for (int ch = 0; ch < 8; ++ch) {
      if (ch < 7) {
#pragma unroll
        for (int i = 0; i < 4; ++i) an[i] = *(const u32x4*)(arow_g + (size_t)i * 16 * 1024 + (ch + 1) * 256);
#pragma unroll
        for (int s = 0; s < 8; ++s) bn[s] = *(const bf16x8*)(brow + (ch + 1) * 256 + 32 * s);
      }
      LAS unsigned char* ab = abuf + (ch & 1) * ABUF;
#pragma unroll
      for (int s = 0; s < 8; ++s)
#pragma unroll
        for (int mt = 0; mt < 4; ++mt) {
          const bf16x8 af = *(const LAS bf16x8*)(ab + (16 * mt + fr) * ASTR + (32 * s + 8 * fq) * 2);
          acc[mt] = __builtin_amdgcn_mfma_f32_16x16x32_bf16(af, bc[s], acc[mt], 0, 0, 0);
        }
      if (ch < 7) {
#pragma unroll
        for (int i = 0; i < 4; ++i) *(LAS u32x4*)(abuf + ((ch + 1) & 1) * ABUF + ((tid >> 5) + 16 * i) * ASTR + (tid & 31) * 16) = an[i];
#pragma unroll
        for (int s = 0; s < 8; ++s) bc[s] = bn[s];
      }
      __syncthreads();
    }
    LAS bf16_t* hid = (LAS bf16_t*)smem;
    __syncthreads();
    {
      const float bb = b1[16 * wid + fr];
#pragma unroll
      for (int mt = 0; mt < 4; ++mt)
#pragma unroll
        for (int j = 0; j < 4; ++j) { const float v = acc[mt][j] + bb; hid[(16 * mt + 4 * fq + j) * 136 + 16 * wid + fr] = f2bf(v * sigmoidf_(v)); }
    }
    __syncthreads();
    {
      const int mt = wid >> 1;
#pragma unroll
      for (int q = 0; q < 2; ++q) {
        const int nt = 2 * (wid & 1) + q;
        f32x4 o = (f32x4){0.f, 0.f, 0.f, 0.f};
#pragma unroll
        for (int s = 0; s < 4; ++s) {
          const bf16x8 af = *(const LAS bf16x8*)(hid + (16 * mt + fr) * 136 + 32 * s + 8 * fq);
          const bf16x8 bf = *(const bf16x8*)(W2T + (size_t)(16 * nt + fr) * 128 + 32 * s + 8 * fq);
          o = __builtin_amdgcn_mfma_f32_16x16x32_bf16(af, bf, o, 0, 0, 0);
        }
#pragma unroll
        for (int j = 0; j < 4; ++j) { const int c = 64 * mh + 16 * mt + 4 * fq + j; if (c < 127) OUT[(size_t)c * 64 + 16 * nt + fr] = f2bf(o[j]); }
      }
    }
    if (mh == 1 && tid < 64) OUT[(size_t)127 * 64 + tid] = 0;
  }
}
__device__ __forceinline__ void conv_item(const Params& p, LAS unsigned char* smem, int it64) {
  const int tid = my_tid(), wid = __builtin_amdgcn_readfirstlane(tid >> 6), lane = tid & 63;
  unsigned char* ws = p.ws;
  {
    const bf16_t* U = (const bf16_t*)(ws + WS_U);
    bf16_t* MIX = (bf16_t*)(ws + WS_MIX);
    LAS float* ybuf = (LAS float*)smem;
    const int cp = tid & 255, thalf = tid >> 8;
    f32x2 w2[31];
#pragma unroll
    for (int k = 0; k < 31; ++k) w2[k] = *(const f32x2*)(p.conv_w + k * 512 + 2 * cp);
    const f32x2 cb2 = *(const f32x2*)(p.conv_b + 2 * cp);
    f32x4 lg[2], lb[2], og[2];
#pragma unroll
    for (int q = 0; q < 2; ++q) { lg[q] = *(const f32x4*)(p.conv_ln_g + lane * 8 + 4 * q); lb[q] = *(const f32x4*)(p.conv_ln_b + lane * 8 + 4 * q); og[q] = *(const f32x4*)(p.out_norm_conv + lane * 8 + 4 * q); }
    u32x4 rv[8];
    auto load_rows = [&](int itp) {
      const int t0 = itp * 32, s0 = t0 & 2047;
#pragma unroll
      for (int r = 0; r < 8; ++r) {
        const int seg = tid + r * NTHR, row = seg >> 6;
        const int rr = (s0 - 30 + row >= 0 && seg < 62 * 64) ? (t0 - 30 + row) : t0;
        rv[r] = *(const u32x4*)((const unsigned char*)U + (size_t)rr * 1024 + (seg & 63) * 16);
      }
    };
    load_rows(it64 * 2);
#pragma unroll
    for (int ps = 0; ps < 2; ++ps) {
      const int it = it64 * 2 + ps;
      const int t0 = it * 32, s0 = t0 & 2047;
      LAS unsigned char* ut = smem + 65536;
      __syncthreads();
      {
#pragma unroll
        for (int r = 0; r < 8; ++r) {
          const int seg = tid + r * NTHR, row = seg >> 6;
          if (seg < 62 * 64) *(LAS u32x4*)(ut + seg * 16) = (s0 - 30 + row >= 0) ? rv[r] : (u32x4){0u, 0u, 0u, 0u};
        }
      }
      if (ps == 0) load_rows(it + 1);
      __syncthreads();
      unsigned upk[46];
#pragma unroll
      for (int i = 0; i < 46; ++i) upk[i] = *(const LAS unsigned*)(ut + (thalf * 16 + i) * 1024 + cp * 4);
      __builtin_amdgcn_sched_barrier(0);
      f32x2 u2[46];
#pragma unroll
      for (int i = 0; i < 46; ++i) u2[i] = (f32x2){__uint_as_float(upk[i] << 16), __uint_as_float(upk[i] & 0xffff0000u)};
#pragma unroll
      for (int i = 0; i < 16; ++i) {
        f32x2 y = cb2;
#pragma unroll
        for (int k = 0; k < 31; ++k) y += w2[k] * u2[i + k];
        *(LAS f32x2*)(ybuf + (thalf * 16 + i) * 512 + 2 * cp) = y;
      }
      __syncthreads();
#pragma unroll
      for (int q4 = 0; q4 < 4; ++q4) {
        const int i = wid * 4 + q4, t = t0 + i;
        const f32x4 y0 = *(const LAS f32x4*)(ybuf + i * 512 + lane * 8), y1 = *(const LAS f32x4*)(ybuf + i * 512 + lane * 8 + 4);
        const float mean = wave_sum((y0[0] + y0[1]) + (y0[2] + y0[3]) + (y1[0] + y1[1]) + (y1[2] + y1[3])) * (1.0f / 512.0f);
        const f32x4 d0 = y0 - mean, d1 = y1 - mean;
        const float var = wave_sum(d0[0] * d0[0] + d0[1] * d0[1] + d0[2] * d0[2] + d0[3] * d0[3] + d1[0] * d1[0] + d1[1] * d1[1] + d1[2] * d1[2] + d1[3] * d1[3]) * (1.0f / 512.0f);
        const float rs = rsqrtf(var + NORM_EPS);
        f32x4 v0 = d0 * rs * lg[0] + lb[0], v1 = d1 * rs * lg[1] + lb[1];
#pragma unroll
        for (int e = 0; e < 4; ++e) { v0[e] = v0[e] * sigmoidf_(v0[e]); v1[e] = v1[e] * sigmoidf_(v1[e]); }
        const float ms = wave_sum(v0[0] * v0[0] + v0[1] * v0[1] + v0[2] * v0[2] + v0[3] * v0[3] + v1[0] * v1[0] + v1[1] * v1[1] + v1[2] * v1[2] + v1[3] * v1[3]) * (1.0f / 512.0f);
        const float r2 = rsqrtf(ms + NORM_EPS);
        v0 = v0 * r2 * og[0]; v1 = v1 * r2 * og[1];
        *(u32x4*)(MIX + (size_t)t * 1024 + lane * 8) = pack8(v0, v1);
      }
    }
  }
}

typedef float f32x16 __attribute__((ext_vector_type(16)));
typedef short s16x4 __attribute__((ext_vector_type(4)));
typedef __attribute__((address_space(3))) s16x4 lds_s16x4;
constexpr int AT_KSTR = 144, AT_VSTR = 192, AT_VOFF = 64 * AT_KSTR, AT_TILE = 64 * AT_KSTR + 64 * AT_VSTR;

__device__ __forceinline__ bf16x8 cat4(s16x4 a, s16x4 b) { bf16x8 r; r[0] = a[0]; r[1] = a[1]; r[2] = a[2]; r[3] = a[3]; r[4] = b[0]; r[5] = b[1]; r[6] = b[2]; r[7] = b[3]; return r; }

template <class MaskF>
__device__ __forceinline__ void attn_tile(LAS unsigned char* buf, const bf16x8 (&qf)[4], f32x16 (&O)[2], float& m, float& l, int lane, bool need_mask, bool lane_on, const MaskF& kmask) {
  const int h = lane >> 5, l31 = lane & 31;
  f32x16 s[2];
#pragma unroll
  for (int kb = 0; kb < 2; ++kb)
#pragma unroll
    for (int r = 0; r < 16; ++r) s[kb][r] = 0.f;
  bf16x8 kf[4][2];
#pragma unroll
  for (int ks = 0; ks < 4; ++ks)
#pragma unroll
    for (int kb = 0; kb < 2; ++kb) kf[ks][kb] = *(const LAS bf16x8*)(buf + (kb * 32 + l31) * AT_KSTR + (2 * ks + h) * 16);
  asm volatile("s_waitcnt lgkmcnt(0)" ::: "memory");
  __builtin_amdgcn_sched_barrier(0);
#pragma unroll
  for (int ks = 0; ks < 4; ++ks)
#pragma unroll
    for (int kb = 0; kb < 2; ++kb) s[kb] = __builtin_amdgcn_mfma_f32_32x32x16_bf16(kf[ks][kb], qf[ks], s[kb], 0, 0, 0);
  const int blk = (lane >> 4) & 1, q = (lane & 15) >> 2, pp = lane & 3;
  LAS unsigned char* vbase = buf + AT_VOFF + (4 * h + q) * AT_VSTR + (16 * blk + 4 * pp) * 2;
  bf16x8 vf[2][2][2];
#pragma unroll
  for (int kb = 0; kb < 2; ++kb)
#pragma unroll
    for (int sx = 0; sx < 2; ++sx)
#pragma unroll
      for (int dt = 0; dt < 2; ++dt) {
        if (kb == 1 && sx == 1 && dt == 1) continue;
        const s16x4 va = __builtin_amdgcn_ds_read_tr16_b64_v4i16((lds_s16x4*)(vbase + (32 * kb + 16 * sx) * AT_VSTR + dt * 64));
        const s16x4 vb = __builtin_amdgcn_ds_read_tr16_b64_v4i16((lds_s16x4*)(vbase + (32 * kb + 16 * sx + 8) * AT_VSTR + dt * 64));
        vf[kb][sx][dt] = cat4(va, vb);
      }
  __builtin_amdgcn_sched_barrier(0);
  if (need_mask) {
#pragma unroll
    for (int kb = 0; kb < 2; ++kb)
#pragma unroll
      for (int r = 0; r < 16; ++r) s[kb][r] = kmask(kb, r) ? s[kb][r] : -1e30f;
  }
  float mx = s[0][0];
#pragma unroll
  for (int kb = 0; kb < 2; ++kb)
#pragma unroll
    for (int r = 0; r < 16; ++r) mx = fmaxf(mx, s[kb][r]);
  mx = xmax32(mx);
  mx = lane_on ? mx : -1e30f;
  const float mn = fmaxf(m, mx);
  const float alpha = __builtin_amdgcn_exp2f(m - mn);
  m = mn;
  const float mexp = lane_on ? mn : 3.0e38f;
  f32x2 ls2 = (f32x2){0.f, 0.f};
#pragma unroll
  for (int kb = 0; kb < 2; ++kb)
#pragma unroll
    for (int r = 0; r < 16; r += 2) {
      const f32x2 d = (f32x2){s[kb][r], s[kb][r + 1]} - mexp;
      f32x2 e; e[0] = __builtin_amdgcn_exp2f(d[0]); e[1] = __builtin_amdgcn_exp2f(d[1]);
      s[kb][r] = e[0]; s[kb][r + 1] = e[1];
      ls2 += e;
    }
  l = l * alpha + (ls2[0] + ls2[1]);
#pragma unroll
  for (int dt = 0; dt < 2; ++dt) O[dt] = O[dt] * alpha;
  bf16x8 pb[2][2];
#pragma unroll
  for (int kb = 0; kb < 2; ++kb)
#pragma unroll
    for (int sx = 0; sx < 2; ++sx) {
      u32x4 w; w.x = cvt_pk_bf16(s[kb][8 * sx + 0], s[kb][8 * sx + 1]); w.y = cvt_pk_bf16(s[kb][8 * sx + 2], s[kb][8 * sx + 3]);
      w.z = cvt_pk_bf16(s[kb][8 * sx + 4], s[kb][8 * sx + 5]); w.w = cvt_pk_bf16(s[kb][8 * sx + 6], s[kb][8 * sx + 7]);
      pb[kb][sx] = __builtin_bit_cast(bf16x8, w);
    }
  asm volatile("s_waitcnt lgkmcnt(0)" ::: "memory");
  {
    const s16x4 va = __builtin_amdgcn_ds_read_tr16_b64_v4i16((lds_s16x4*)(vbase + (32 + 16) * AT_VSTR + 64));
    const s16x4 vb = __builtin_amdgcn_ds_read_tr16_b64_v4i16((lds_s16x4*)(vbase + (32 + 16 + 8) * AT_VSTR + 64));
    vf[1][1][1] = cat4(va, vb);
  }
#pragma unroll
  for (int kb = 0; kb < 2; ++kb)
#pragma unroll
    for (int sx = 0; sx < 2; ++sx)
#pragma unroll
      for (int dt = 0; dt < 2; ++dt) O[dt] = __builtin_amdgcn_mfma_f32_32x32x16_bf16(vf[kb][sx][dt], pb[kb][sx], O[dt], 0, 0, 0);
}

template <bool SELECTED>
__device__ __forceinline__ void attn_item(const Params& p, LAS unsigned char* smem, int si) {
  const int tid = my_tid(), wid = __builtin_amdgcn_readfirstlane(tid >> 6), lane = tid & 63, h = lane >> 5, l31 = lane & 31;
  const int n = wid & 3, th = wid >> 2;
  unsigned char* ws = p.ws;
  const bf16_t* Q = (const bf16_t*)(ws + WS_Q);
  const bf16_t* KB = (const bf16_t*)(ws + WS_KV) + (size_t)(SELECTED ? 2 : 4) * (16 * 2 * 2048 * 64);
  const bf16_t* VB = (const bf16_t*)(ws + WS_KV) + (size_t)(SELECTED ? 3 : 5) * (16 * 2 * 2048 * 64);
  const float* GATES = (const float*)(ws + WS_GATES);
  const unsigned* SEL = (const unsigned*)(ws + WS_BOOK + BK_SEL);
  bf16_t* OUT = (bf16_t*)(ws + (SELECTED ? WS_OS : WS_OW));
  {
    const int cur = 31 - (si >> 5), bg = si & 31, b = bg >> 1, g = bg & 1;
    const int t = cur * 64 + th * 32 + l31, tok = b * 2048 + t, head = g * 4 + n;
    const char* kg = (const char*)(KB + (size_t)bg * 2048 * 64);
    const char* vg = (const char*)(VB + (size_t)bg * 2048 * 64);
    u32x4 kA = *(const u32x4*)(kg + (size_t)cur * 8192 + tid * 16), vA = *(const u32x4*)(vg + (size_t)cur * 8192 + tid * 16);
    bf16x8 qf[4];
#pragma unroll
    for (int ks = 0; ks < 4; ++ks) qf[ks] = *(const bf16x8*)(Q + (size_t)tok * 512 + head * 64 + 16 * ks + 8 * h);
    float gsc = GATES[(size_t)tok * 24 + head * 3 + (SELECTED ? 1 : 2)];
    __builtin_amdgcn_sched_barrier(0);
    unsigned mysel = 0u, tiles;
    if (SELECTED) {
      mysel = SEL[bg * 2048 + t];
      tiles = __builtin_amdgcn_readfirstlane(wave_or(SEL[bg * 2048 + cur * 64 + lane]));
    } else {
      const int jmin = cur - 8 > 0 ? cur - 8 : 0;
      tiles = ((cur == 31) ? 0xffffffffu : ((1u << (cur + 1)) - 1u)) & ~((1u << jmin) - 1u);
    }
    f32x16 O[2];
#pragma unroll
    for (int dt = 0; dt < 2; ++dt)
#pragma unroll
      for (int r = 0; r < 16; ++r) O[dt][r] = 0.f;
    float m = -1e30f, l = 0.f;
    auto pop = [&]() -> int { if (tiles == 0u) return -1; const int jn = 31 - __builtin_clz(tiles); tiles &= ~(1u << jn); return jn; };
    int j = cur;
    tiles &= ~(1u << j);
    int j1 = pop();
    int j2 = (j1 >= 0) ? pop() : -1;
    const int kwo = (tid >> 3) * AT_KSTR + (tid & 7) * 16, vwo = AT_VOFF + (tid >> 3) * AT_VSTR + (tid & 7) * 16;
    u32x4 kB = kA, vB = vA;
    *(LAS u32x4*)(smem + kwo) = kA; *(LAS u32x4*)(smem + vwo) = vA;
    if (j1 >= 0) { kA = *(const u32x4*)(kg + (size_t)j1 * 8192 + tid * 16); vA = *(const u32x4*)(vg + (size_t)j1 * 8192 + tid * 16); }
    if (j2 >= 0) { kB = *(const u32x4*)(kg + (size_t)j2 * 8192 + tid * 16); vB = *(const u32x4*)(vg + (size_t)j2 * 8192 + tid * 16); }
    __syncthreads();
    u32x4 ocr[4];
    if (SELECTED) {
      const size_t rowo = ((size_t)(b * 2048 + cur * 64 + (tid >> 3)) * 512 + g * 256 + (tid & 7) * 8) * 2;
#pragma unroll
      for (int i = 0; i < 4; ++i) ocr[i] = *(const u32x4*)(ws + WS_OC + rowo + i * 128);
    }
#pragma unroll
    for (int ks = 0; ks < 4; ++ks) asm volatile("" : "+v"(qf[ks]));
    asm volatile("" : "+v"(mysel));
    asm volatile("" : "+v"(gsc));
    int cb = 0;
#define ATT_HALF(KX, VX)                                                                                                                         \
    {                                                                                                                                            \
      LAS unsigned char* buf = smem + cb * AT_TILE;                                                                                              \
      if (SELECTED) {                                                                                                                            \
        const bool selj = (mysel >> j) & 1u;                                                                                                     \
        const int kbase = j * 64 + 4 * h;                                                                                                        \
        attn_tile(buf, qf, O, m, l, lane, j == cur, selj, [&](int kb, int r) { return kbase + 32 * kb + (r & 3) + 8 * (r >> 2) <= t; });        \
      } else {                                                                                                                                   \
        const int kbase = j * 64 + 4 * h;                                                                                                        \
        const bool nm = (j == cur) || (j <= cur - 8);                                                                                            \
        attn_tile(buf, qf, O, m, l, lane, nm, true, [&](int kb, int r) { const int key = kbase + 32 * kb + (r & 3) + 8 * (r >> 2); return key <= t && key > t - 512; }); \
      }                                                                                                                                          \
      if (j1 >= 0) { *(LAS u32x4*)(smem + (cb ^ 1) * AT_TILE + kwo) = KX; *(LAS u32x4*)(smem + (cb ^ 1) * AT_TILE + vwo) = VX; }                 \
      __syncthreads();                                                                                                                           \
      if (j1 < 0) break;                                                                                                                         \
      j = j1; j1 = j2; j2 = pop(); cb ^= 1;                                                                                                      \
      if (j2 >= 0) { KX = *(const u32x4*)(kg + (size_t)j2 * 8192 + tid * 16); VX = *(const u32x4*)(vg + (size_t)j2 * 8192 + tid * 16); }         \
    }
    for (;;) {
      ATT_HALF(kA, vA)
      ATT_HALF(kB, vB)
    }
#undef ATT_HALF
    const float lt = xsum32(l, l);
    const float sc = gsc / lt;
    if (!SELECTED) {
      LAS unsigned char* ost = smem + wid * (32 * 144);
#pragma unroll
      for (int dt = 0; dt < 2; ++dt)
#pragma unroll
        for (int r4 = 0; r4 < 4; ++r4) {
          u32x2 w; w.x = cvt_pk_bf16(O[dt][4 * r4 + 0] * sc, O[dt][4 * r4 + 1] * sc); w.y = cvt_pk_bf16(O[dt][4 * r4 + 2] * sc, O[dt][4 * r4 + 3] * sc);
          *(LAS u32x2*)(ost + l31 * 144 + (32 * dt + 8 * r4 + 4 * h) * 2) = w;
        }
#pragma unroll
      for (int i = 0; i < 4; ++i) {
        const int tl = i * 8 + (lane >> 3), sg = lane & 7;
        *(u32x4*)(OUT + (size_t)(b * 2048 + cur * 64 + th * 32 + tl) * 512 + head * 64 + sg * 8) = *(const LAS u32x4*)(ost + tl * 144 + sg * 16);
      }
    } else {
      LAS unsigned char* combb = smem + 2 * AT_TILE + 1024;
      LAS unsigned char* outb = smem;
      {
        const int tl = tid >> 3, s8 = tid & 7;
#pragma unroll
        for (int i = 0; i < 4; ++i) *(LAS u32x4*)(combb + tl * 528 + (s8 + 8 * i) * 16) = ocr[i];
      }
      __syncthreads();
      const int tl = th * 32 + l31;
      float ssq = 0.f;
#pragma unroll
      for (int dt = 0; dt < 2; ++dt)
#pragma unroll
        for (int r4 = 0; r4 < 4; ++r4) {
          const int c = n * 64 + 32 * dt + 8 * r4 + 4 * h;
          const u32x2 cw = *(const LAS u32x2*)(combb + tl * 528 + c * 2);
          const f32x4 cb = (f32x4){__uint_as_float(cw.x << 16), __uint_as_float(cw.x & 0xffff0000u), __uint_as_float(cw.y << 16), __uint_as_float(cw.y & 0xffff0000u)};
          const float v0 = O[dt][4 * r4 + 0] * sc + cb[0], v1 = O[dt][4 * r4 + 1] * sc + cb[1], v2 = O[dt][4 * r4 + 2] * sc + cb[2], v3 = O[dt][4 * r4 + 3] * sc + cb[3];
          ssq += (v0 * v0 + v1 * v1) + (v2 * v2 + v3 * v3);
          u32x2 w; w.x = cvt_pk_bf16(v0, v1); w.y = cvt_pk_bf16(v2, v3);
          *(LAS u32x2*)(outb + tl * 528 + c * 2) = w;
        }
      ssq = xsum32(ssq, ssq);
      LAS float* sq = (LAS float*)(smem + 2 * AT_TILE);
      if (h == 0) sq[tl * 4 + n] = ssq;
      __syncthreads();
      {
        const int tl2 = tid >> 3, s8 = tid & 7;
        unsigned char* mx = ws + WS_MIX + ((size_t)(b * 2048 + cur * 64 + tl2) * 1024 + 512 + g * 256 + s8 * 8) * 2;
#pragma unroll
        for (int i = 0; i < 4; ++i) *(u32x4*)(mx + i * 128) = *(const LAS u32x4*)(outb + tl2 * 528 + (s8 + 8 * i) * 16);
      }
      if (tid < 64) {
        const f32x4 q4 = *(const LAS f32x4*)(sq + tid * 4);
        ((float*)(ws + WS_BOOK + BK_SSQ))[(size_t)(b * 2048 + cur * 64 + tid) * 2 + g] = (q4[0] + q4[1]) + (q4[2] + q4[3]);
      }
    }
  }
}

template <class F>
__device__ __forceinline__ void dyn_items(int* counter, int nitems, LAS unsigned char* smem, F&& f) {
  LAS int* slot = (LAS int*)(smem + LDS_BYTES - 64);
  const int tid = my_tid();
  __syncthreads();
  if (tid == 0) slot[0] = atomicAdd(counter, 1);
  __syncthreads();
  int cur = __builtin_amdgcn_readfirstlane(slot[0]);
  int par = 0;
  while (cur < nitems) {
    int nxt = 0;
    if (tid == 0) nxt = atomicAdd(counter, 1);
    f(cur);
    par ^= 1;
    if (tid == 0) slot[par] = nxt;
    __syncthreads();
    cur = __builtin_amdgcn_readfirstlane(slot[par]);
  }
}
__device__ __forceinline__ void phase3w(const Params& p, LAS unsigned char* smem) {
  int* ctr = (int*)(p.ws + WS_BOOK + BK_CTR);
#if PROF_ON && PROF_ITEMS
  unsigned long long tsum[3] = {0, 0, 0}; unsigned cnt[3] = {0, 0, 0};
#endif
  dyn_items(ctr + 0, 128 + 1024 + 512, smem, [&](int it) {
#if PROF_ON && PROF_ITEMS
    const unsigned long long t_0 = wall_clock64();
#endif
    if (it < 128) compress_item(p, smem, it);
    else if (it < 1152) attn_item<false>(p, smem, it - 128);
    else conv_item(p, smem, it - 1152);
#if PROF_ON && PROF_ITEMS
    __syncthreads();
    const int ty = it < 128 ? 0 : (it < 1152 ? 1 : 2);
    tsum[ty] += wall_clock64() - t_0; cnt[ty] += 1;
#endif
  });
#if PROF_ON && PROF_ITEMS
  if (threadIdx.x == 0) {
    unsigned long long* st = (unsigned long long*)(p.ws + WS_BOOK + BK_XBAR + 16384 + 64);
    for (int q = 0; q < 3; ++q) { atomicAdd(st + q, tsum[q]); atomicAdd(st + 4 + q, (unsigned long long)cnt[q]); }
  }
#endif
}
__device__ __forceinline__ void phase6(const Params& p, LAS unsigned char* smem) {
  int* ctr = (int*)(p.ws + WS_BOOK + BK_CTR);
  dyn_items(ctr + 1, 1024, smem, [&](int it) { attn_item<true>(p, smem, it); });
}

__device__ __forceinline__ void phase4_mfma(const Params& p, LAS unsigned char* smem) {
  const int tid = my_tid(), wid = __builtin_amdgcn_readfirstlane(tid >> 6), lane = tid & 63, h = lane >> 5, l31 = lane & 31;
  unsigned char* ws = p.ws;
  const bf16_t* Q = (const bf16_t*)(ws + WS_Q);
  const float* GATES = (const float*)(ws + WS_GATES);
  bf16_t* OC = (bf16_t*)(ws + WS_OC);
  unsigned* SEL = (unsigned*)(ws + WS_BOOK + BK_SEL);
  constexpr int VOFF = 128 * AT_KSTR;
  for (int it = blockIdx.x; it < 256; it += gridDim.x) {
    const int bg = it >> 3, px = (it >> 1) & 3, hf = it & 1, b = bg >> 1, g = bg & 1;
    const int tt = (wid < 4) ? px : 7 - px, wslot = hf * 4 + (wid & 3);
    const char* kg = (const char*)(ws + WS_BOOK + BK_KCMP) + (size_t)bg * 16384;
    const char* vg = (const char*)(ws + WS_BOOK + BK_VCMP) + (size_t)bg * 16384;
    const int tw0 = tt * 256 + wslot * 32, t = tw0 + l31, tok = b * 2048 + t;
    bf16x8 qn[4];
#pragma unroll
    for (int ks = 0; ks < 4; ++ks) qn[ks] = *(const bf16x8*)(Q + (size_t)tok * 512 + (g * 4) * 64 + 16 * ks + 8 * h);
    float gn = GATES[(size_t)tok * 24 + (g * 4) * 3 + 0];
    __syncthreads();
#pragma unroll
    for (int i = 0; i < 2; ++i) {
      const int e = tid + i * NTHR, key = e >> 3, ch = e & 7;
      *(LAS u32x4*)(smem + key * AT_KSTR + ch * 16) = *(const u32x4*)(kg + e * 16);
      *(LAS u32x4*)(smem + VOFF + key * AT_VSTR + ch * 16) = *(const u32x4*)(vg + e * 16);
    }
    __syncthreads();
    const int ncv = (t >= 31) ? ((t - 31) >> 4) + 1 : 0;
    const int tmax = tw0 + 31;
    const int ncvmax = (tmax >= 31) ? ((tmax - 31) >> 4) + 1 : 0;
    const int nkb = (ncvmax + 31) >> 5;
    float mainv[16], edgev[16];
#pragma unroll
    for (int a = 0; a < 16; ++a) { mainv[a] = 0.f; edgev[a] = 0.f; }
#pragma unroll 1
    for (int n = 0; n < 4; ++n) {
      const int head = g * 4 + n;
      bf16x8 qf[4];
#pragma unroll
      for (int ks = 0; ks < 4; ++ks) qf[ks] = qn[ks];
      const float g0 = gn;
      if (n < 3) {
#pragma unroll
        for (int ks = 0; ks < 4; ++ks) qn[ks] = *(const bf16x8*)(Q + (size_t)tok * 512 + (head + 1) * 64 + 16 * ks + 8 * h);
        gn = GATES[(size_t)tok * 24 + (head + 1) * 3 + 0];
      }
      u32x4 owv[4];
#pragma unroll
      for (int i = 0; i < 4; ++i) owv[i] = *(const u32x4*)((const bf16_t*)(ws + WS_OW) + (size_t)(b * 2048 + tw0 + i * 8 + (lane >> 3)) * 512 + head * 64 + (lane & 7) * 8);
      f32x16 s[4];
#pragma unroll
      for (int kb = 0; kb < 4; ++kb)
#pragma unroll
        for (int r = 0; r < 16; ++r) s[kb][r] = 0.f;
#pragma unroll
      for (int kb = 0; kb < 4; ++kb)
        if (kb < nkb) {
#pragma unroll
          for (int ks = 0; ks < 4; ++ks) {
            const bf16x8 a = *(const LAS bf16x8*)(smem + (kb * 32 + l31) * AT_KSTR + (2 * ks + h) * 16);
            s[kb] = __builtin_amdgcn_mfma_f32_32x32x16_bf16(a, qf[ks], s[kb], 0, 0, 0);
          }
        }
      float mx = -1e30f;
#pragma unroll
      for (int kb = 0; kb < 4; ++kb)
        if (kb < nkb) {
#pragma unroll
          for (int r = 0; r < 16; ++r) {
            const int c = 32 * kb + (r & 3) + 8 * (r >> 2) + 4 * h;
            s[kb][r] = (c < ncv) ? s[kb][r] : -1e30f;
            mx = fmaxf(mx, s[kb][r]);
          }
        }
      mx = xmax32(mx);
      float ls = 0.f;
#pragma unroll
      for (int kb = 0; kb < 4; ++kb)
        if (kb < nkb) {
#pragma unroll
          for (int r = 0; r < 16; ++r) {
            s[kb][r] = __builtin_amdgcn_exp2f(s[kb][r] - mx);
            ls += s[kb][r];
          }
        }
      ls = xsum32(ls, ls);
      const float inv = (ncv > 0) ? __builtin_amdgcn_rcpf(ls) : 0.f;
#pragma unroll
      for (int kb = 0; kb < 4; ++kb)
        if (kb < nkb) {
#pragma unroll
          for (int i = 0; i < 4; ++i) {
            const float p0 = s[kb][4 * i] * inv, p1 = s[kb][4 * i + 1] * inv, p2 = s[kb][4 * i + 2] * inv, p3 = s[kb][4 * i + 3] * inv;
            s[kb][4 * i] = p0; s[kb][4 * i + 1] = p1; s[kb][4 * i + 2] = p2; s[kb][4 * i + 3] = p3;
            mainv[kb * 4 + i] += (p0 + p1) + (p2 + p3);
            edgev[kb * 4 + i] += p3;
          }
        }
      f32x16 O[2];
#pragma unroll
      for (int dt = 0; dt < 2; ++dt)
#pragma unroll
        for (int r = 0; r < 16; ++r) O[dt][r] = 0.f;
      const int blk = (lane >> 4) & 1, q = (lane & 15) >> 2, pp = lane & 3;
      LAS unsigned char* vbase = smem + VOFF + (4 * h + q) * AT_VSTR + (16 * blk + 4 * pp) * 2;
#pragma unroll
      for (int kb = 0; kb < 4; ++kb)
        if (kb < nkb) {
#pragma unroll
          for (int sx = 0; sx < 2; ++sx) {
            u32x4 w; w.x = cvt_pk_bf16(s[kb][8 * sx + 0], s[kb][8 * sx + 1]); w.y = cvt_pk_bf16(s[kb][8 * sx + 2], s[kb][8 * sx + 3]);
            w.z = cvt_pk_bf16(s[kb][8 * sx + 4], s[kb][8 * sx + 5]); w.w = cvt_pk_bf16(s[kb][8 * sx + 6], s[kb][8 * sx + 7]);
            const bf16x8 pb = __builtin_bit_cast(bf16x8, w);
#pragma unroll
            for (int dt = 0; dt < 2; ++dt) {
              const s16x4 va = __builtin_amdgcn_ds_read_tr16_b64_v4i16((lds_s16x4*)(vbase + (32 * kb + 16 * sx) * AT_VSTR + dt * 64));
              const s16x4 vb = __builtin_amdgcn_ds_read_tr16_b64_v4i16((lds_s16x4*)(vbase + (32 * kb + 16 * sx + 8) * AT_VSTR + dt * 64));
              O[dt] = __builtin_amdgcn_mfma_f32_32x32x16_bf16(cat4(va, vb), pb, O[dt], 0, 0, 0);
            }
          }
        }
      LAS unsigned char* ost = smem + VOFF + 128 * AT_VSTR + wid * (32 * 144);
#pragma unroll
      for (int dt = 0; dt < 2; ++dt)
#pragma unroll
        for (int r4 = 0; r4 < 4; ++r4) {
          u32x2 w; w.x = cvt_pk_bf16(O[dt][4 * r4 + 0] * g0, O[dt][4 * r4 + 1] * g0); w.y = cvt_pk_bf16(O[dt][4 * r4 + 2] * g0, O[dt][4 * r4 + 3] * g0);
          *(LAS u32x2*)(ost + l31 * 144 + (32 * dt + 8 * r4 + 4 * h) * 2) = w;
        }
#pragma unroll
      for (int i = 0; i < 4; ++i) {
        const int tl = i * 8 + (lane >> 3), sg = lane & 7;
        const u32x4 oc = *(const LAS u32x4*)(ost + tl * 144 + sg * 16), ow = owv[i];
        u32x4 sm;
#pragma unroll
        for (int q = 0; q < 4; ++q)
          sm[q] = cvt_pk_bf16(__uint_as_float(oc[q] << 16) + __uint_as_float(ow[q] << 16), __uint_as_float(oc[q] & 0xffff0000u) + __uint_as_float(ow[q] & 0xffff0000u));
        *(u32x4*)(OC + (size_t)(b * 2048 + tw0 + tl) * 512 + head * 64 + sg * 8) = sm;
      }
    }
    const int cur = t >> 6;
    float so[16], oo[16];
    {
      float ex[16];
#pragma unroll
      for (int a = 0; a < 16; ++a) ex[a] = xother32(edgev[a], h);
#pragma unroll
      for (int a = 0; a < 16; ++a) {
        const float add = h ? ex[a] : (a > 0 ? ex[a > 0 ? a - 1 : 0] : 0.f);
        const float imp = mainv[a] + add;
        const int j = 2 * a + h;
        const bool forced = (j == 0) || (j == cur) || (j == cur - 1);
        so[a] = (j <= cur) ? (forced ? 1e9f : imp) : -3.0e38f;
      }
#pragma unroll
      for (int a = 0; a < 16; ++a) oo[a] = xother32(so[a], h);
    }
    unsigned bits = 0u;
    const bool all = __builtin_amdgcn_readfirstlane(cur) + 1 <= 16;
    if (all) {
#pragma unroll
      for (int a = 0; a < 16; ++a) { const int j = 2 * a + h; bits |= (j <= cur) ? (1u << j) : 0u; }
    } else
#pragma unroll
    for (int a = 0; a < 16; ++a) {
      const int j = 2 * a + h;
      int rank = 0;
#pragma unroll
      for (int bb = 0; bb < 16; ++bb) {
        if (bb != a) rank += (bb < a) ? (so[bb] >= so[a] ? 1 : 0) : (so[bb] > so[a] ? 1 : 0);
        if (bb < a) rank += (oo[bb] >= so[a]) ? 1 : 0;
        else if (bb > a) rank += (oo[bb] > so[a]) ? 1 : 0;
        else rank += (h ? (oo[bb] >= so[a]) : (oo[bb] > so[a])) ? 1 : 0;
      }
      const bool selj = (j <= cur) && (rank < 16);
      bits |= selj ? (1u << j) : 0u;
    }
    { auto r = __builtin_amdgcn_permlane32_swap(bits, bits, false, false); bits = r[0] | r[1]; }
    if (h == 0) SEL[bg * 2048 + t] = bits;
  }
}

__device__ __forceinline__ void phase6b(const Params& p) {
  const int tid = my_tid(), wid = tid >> 6, lane = tid & 63;
  unsigned char* ws = p.ws;
  const bf16_t* OC = (const bf16_t*)(ws + WS_OC); const bf16_t* OW = (const bf16_t*)(ws + WS_OW); const bf16_t* OS = (const bf16_t*)(ws + WS_OS);
  bf16_t* MIX = (bf16_t*)(ws + WS_MIX);
  const f32x4 g0 = *(const f32x4*)(p.out_norm_nsa + lane * 8), g1 = *(const f32x4*)(p.out_norm_nsa + lane * 8 + 4);
  for (int t = blockIdx.x * 8 + wid; t < T_TOK; t += gridDim.x * 8) {
    const bf16x8 a = *(const bf16x8*)(OC + (size_t)t * 512 + lane * 8), b = *(const bf16x8*)(OW + (size_t)t * 512 + lane * 8), c = *(const bf16x8*)(OS + (size_t)t * 512 + lane * 8);
    float v[8]; float ss = 0.f;
#pragma unroll
    for (int e = 0; e < 8; ++e) { v[e] = bf2f((bf16_t)a[e]) + bf2f((bf16_t)b[e]) + bf2f((bf16_t)c[e]); ss += v[e] * v[e]; }
    ss = wave_sum(ss);
    const float rstd = rsqrtf(ss * (1.0f / 512.0f) + NORM_EPS);
    u32x4 w; w.x = pack2(v[0] * rstd * g0[0], v[1] * rstd * g0[1]); w.y = pack2(v[2] * rstd * g0[2], v[3] * rstd * g0[3]);
    w.z = pack2(v[4] * rstd * g1[0], v[5] * rstd * g1[1]); w.w = pack2(v[6] * rstd * g1[2], v[7] * rstd * g1[3]);
    *(u32x4*)(MIX + (size_t)t * 1024 + 512 + lane * 8) = w;
  }
}

__device__ __forceinline__ f32x4 xreduce8(const f32x4 (&a)[8], int lane) {
  f32x4 b4[4], b2[2], r;
  const bool u3 = lane & 8;
#pragma unroll
  for (int i = 0; i < 4; ++i)
#pragma unroll
    for (int c = 0; c < 4; ++c) b4[i][c] = xsum32(a[i][c], a[i + 4][c]);
#pragma unroll
  for (int i = 0; i < 2; ++i)
#pragma unroll
    for (int c = 0; c < 4; ++c) b2[i][c] = xsum16(b4[i][c], b4[i + 2][c]);
#pragma unroll
  for (int c = 0; c < 4; ++c) { const float snd = u3 ? b2[0][c] : b2[1][c], kp = u3 ? b2[1][c] : b2[0][c]; r[c] = kp + lx8(snd); }
#pragma unroll
  for (int c = 0; c < 4; ++c) { r[c] += lx4(r[c]); r[c] += lx2(r[c]); r[c] += lx1(r[c]); }
  return r;
}
__device__ __forceinline__ void route_top4_pair(float mylg, int lane, int tA, int* TOPI, float* TOPG, LAS int* lhist) {
  int idx[4]; float val[4];
  const int me = lane & 31;
#pragma unroll
  for (int k = 0; k < 4; ++k) {
    float bv = mylg; int bi = me;
    {
      auto rv = __builtin_amdgcn_permlane16_swap(__float_as_uint(bv), __float_as_uint(bv), false, false);
      auto ri = __builtin_amdgcn_permlane16_swap((unsigned)bi, (unsigned)bi, false, false);
      const float v0 = __uint_as_float(rv[0]), v1 = __uint_as_float(rv[1]); const int i0 = (int)ri[0], i1 = (int)ri[1];
      const bool t1 = (v1 > v0) || (v1 == v0 && i1 < i0);
      bv = t1 ? v1 : v0; bi = t1 ? i1 : i0;
    }
#define ARGSTEP(FV, FI) { const float ov = FV(bv); const int oi = FI(bi); const bool take = (ov > bv) || (ov == bv && oi < bi); bv = take ? ov : bv; bi = take ? oi : bi; }
    ARGSTEP(lx8, lx8i) ARGSTEP(lx4, lx4i) ARGSTEP(lx2, lx2i) ARGSTEP(lx1, lx1i)
#undef ARGSTEP
    idx[k] = bi; val[k] = bv;
    mylg = (me == bi) ? -3.0e38f : mylg;
  }
  const float e1 = __expf(val[1] - val[0]), e2 = __expf(val[2] - val[0]), e3 = __expf(val[3] - val[0]);
  const float inv = __builtin_amdgcn_rcpf(1.0f + e1 + e2 + e3);
  if (me == 0) {
    const int t = tA + (lane >> 5);
    *(int4*)(TOPI + (size_t)t * 4) = make_int4(idx[0], idx[1], idx[2], idx[3]);
    *(f32x4*)(TOPG + (size_t)t * 4) = (f32x4){inv, e1 * inv, e2 * inv, e3 * inv};
    lds_inc(lhist + idx[0]); lds_inc(lhist + idx[1]); lds_inc(lhist + idx[2]); lds_inc(lhist + idx[3]);
  }
}
__device__ __forceinline__ void phase8(const Params& p, LAS unsigned char* smem) {
  unsigned char* ws = p.ws;
  const float* MOD = (const float*)(ws + WS_BOOK + BK_MOD);
  const bf16_t* D1 = (const bf16_t*)(ws + WS_D1);
  unsigned char* H2 = (unsigned char*)p.out + DO_H2;
  int* TOPI = (int*)(ws + WS_BOOK + BK_TOPI); float* TOPG = (float*)(ws + WS_BOOK + BK_TOPG);
  int* POSOF = (int*)(ws + WS_BOOK + BK_SLOTOF);
  const float* WRT = (const float*)(ws + WS_BOOK + BK_WRT);
  constexpr int BROW = 2064;
  LAS unsigned char* bhi = smem;
  LAS unsigned char* blo = smem + 32 * BROW;
  LAS float* lgs = (LAS float*)(smem + 64 * BROW);
  LAS float* lsh = lgs + 1024;
  LAS float* lcb = lsh + 1024;
  LAS int* lhist = (LAS int*)(lcb + 32);
  LAS float* lred = (LAS float*)(lhist + 32);
  LAS int* lbase = (LAS int*)(lred + 64);
#pragma unroll 1
  for (int it = blockIdx.x; it < T_TOK / 128; it += gridDim.x) {
    const int tid = my_tid(), wid = tid >> 6, lane = tid & 63, fr = lane & 15, g = lane >> 4;
    const int t0 = it * 128, b = t0 / SEQ;
    const int t = t0 + wid * 16 + fr;
    f32x4 wr[16];
#pragma unroll
    for (int i = 0; i < 8; ++i) {
      const int idx = tid + i * NTHR;
      wr[2 * i] = *(const f32x4*)(WRT + idx * 8); wr[2 * i + 1] = *(const f32x4*)(WRT + idx * 8 + 4);
    }
    u32x4 a[32];
    {
      const bf16_t* xrow = D1 + (size_t)t * DM + 16 * g;
#pragma unroll
      for (int s = 0; s < 32; ++s) a[s] = *(const u32x4*)(xrow + 64 * (s >> 1) + 8 * (s & 1));
    }
    __syncthreads();
    if (tid < 32) lhist[tid] = 0;
    if (tid < 256) {
      const int d = tid * 4;
      const f32x4 gg = *(const f32x4*)(p.norm2_g + d);
      const f32x4 s2 = *(const f32x4*)(MOD + b * 6144 + 4096 + d);
      *(LAS f32x4*)(lgs + d) = gg * (s2 + 1.0f);
      *(LAS f32x4*)(lsh + d) = *(const f32x4*)(MOD + b * 6144 + 3072 + d) * 16.0f;
    }
    asm volatile("s_waitcnt lgkmcnt(0)" ::: "memory");
    __builtin_amdgcn_s_barrier();
#pragma unroll
    for (int i = 0; i < 8; ++i) {
      const int idx = tid + i * NTHR, e = idx >> 7, k8 = (idx & 127) * 8;
      const f32x4 w0 = wr[2 * i], w1 = wr[2 * i + 1];
      const f32x4 g0 = *(const LAS f32x4*)(lgs + k8), g1 = *(const LAS f32x4*)(lgs + k8 + 4);
      const f32x4 h0 = *(const LAS f32x4*)(lsh + k8), h1 = *(const LAS f32x4*)(lsh + k8 + 4);
      const f32x4 b0 = w0 * g0, b1 = w1 * g1;
      u32x4 hi, lo; float part = 0.f;
#pragma unroll
      for (int q = 0; q < 2; ++q) {
        const bf16_t ha = f2bf(b0[2 * q]), hb = f2bf(b0[2 * q + 1]), hc = f2bf(b1[2 * q]), hd = f2bf(b1[2 * q + 1]);
        hi[q] = (unsigned)ha | ((unsigned)hb << 16); hi[2 + q] = (unsigned)hc | ((unsigned)hd << 16);
        lo[q] = pack2(b0[2 * q] - bf2f(ha), b0[2 * q + 1] - bf2f(hb)); lo[2 + q] = pack2(b1[2 * q] - bf2f(hc), b1[2 * q + 1] - bf2f(hd));
      }
#pragma unroll
      for (int q = 0; q < 4; ++q) part += w0[q] * h0[q] + w1[q] * h1[q];
      *(LAS u32x4*)(bhi + e * BROW + k8 * 2) = hi;
      *(LAS u32x4*)(blo + e * BROW + k8 * 2) = lo;
      part = wave_sum(part);
      if (lane == 0) lred[e * 2 + (wid & 1)] = part;
    }
    asm volatile("s_waitcnt lgkmcnt(0)" ::: "memory");
    __builtin_amdgcn_s_barrier();
    if (tid < 32) lcb[tid] = (lred[tid * 2] + lred[tid * 2 + 1]) * (1.0f / 16.0f) + p.b_router[tid];
    f32x4 ah0 = (f32x4){0.f, 0.f, 0.f, 0.f}, al0 = ah0, ah1 = ah0, al1 = ah0, asq = ah0;
    {
      const LAS unsigned char* ph = bhi + fr * BROW + 32 * g;
      const LAS unsigned char* pl = blo + fr * BROW + 32 * g;
      bf16x8 h0 = *(const LAS bf16x8*)(ph), h1 = *(const LAS bf16x8*)(ph + 16 * BROW), l0 = *(const LAS bf16x8*)(pl), l1 = *(const LAS bf16x8*)(pl + 16 * BROW);
#pragma unroll
      for (int s = 0; s < 32; ++s) {
        const int ko = 128 * ((s + 1) >> 1) + 16 * ((s + 1) & 1);
        bf16x8 nh0 = h0, nh1 = h1, nl0 = l0, nl1 = l1;
        if (s < 31) { nh0 = *(const LAS bf16x8*)(ph + ko); nh1 = *(const LAS bf16x8*)(ph + 16 * BROW + ko); nl0 = *(const LAS bf16x8*)(pl + ko); nl1 = *(const LAS bf16x8*)(pl + 16 * BROW + ko); }
        const bf16x8 xa = __builtin_bit_cast(bf16x8, a[s]);
        ah0 = __builtin_amdgcn_mfma_f32_16x16x32_bf16(h0, xa, ah0, 0, 0, 0);
        ah1 = __builtin_amdgcn_mfma_f32_16x16x32_bf16(h1, xa, ah1, 0, 0, 0);
        al0 = __builtin_amdgcn_mfma_f32_16x16x32_bf16(l0, xa, al0, 0, 0, 0);
        al1 = __builtin_amdgcn_mfma_f32_16x16x32_bf16(l1, xa, al1, 0, 0, 0);
        asq = __builtin_amdgcn_mfma_f32_16x16x32_bf16(xa, xa, asq, 0, 0, 0);
        asm volatile("" ::: "memory");
        h0 = nh0; h1 = nh1; l0 = nl0; l1 = nl1;
      }
    }
    float ssd = asq[0];
    ssd = ((fr & 3) == 1) ? asq[1] : ssd; ssd = ((fr & 3) == 2) ? asq[2] : ssd; ssd = ((fr & 3) == 3) ? asq[3] : ssd;
    const float ss = __shfl(ssd, 16 * (fr >> 2) + fr);
    const float rstd = rsqrtf(ss * (1.0f / DM) + NORM_EPS);
    asm volatile("s_waitcnt lgkmcnt(0)" ::: "memory");
    __builtin_amdgcn_s_barrier();
    int rk_e[4] = {0, 0, 0, 0}, rk_r[4] = {0, 0, 0, 0};
    {
      const f32x4 c0 = *(const LAS f32x4*)(lcb + 4 * g), c1 = *(const LAS f32x4*)(lcb + 16 + 4 * g);
      float L[8];
#pragma unroll
      for (int r = 0; r < 4; ++r) { L[r] = (ah0[r] + al0[r]) * rstd + c0[r]; L[4 + r] = (ah1[r] + al1[r]) * rstd + c1[r]; }
      int idx[4]; float val[4];
#pragma unroll
      for (int k = 0; k < 4; ++k) {
        float bv = L[0]; int bi = 4 * g;
#pragma unroll
        for (int j = 1; j < 8; ++j) { const int ej = 16 * (j >> 2) + 4 * g + (j & 3); const bool take = L[j] > bv; bv = take ? L[j] : bv; bi = take ? ej : bi; }
        {
          auto rv = __builtin_amdgcn_permlane16_swap(__float_as_uint(bv), __float_as_uint(bv), false, false);
          auto ri = __builtin_amdgcn_permlane16_swap((unsigned)bi, (unsigned)bi, false, false);
          const float v0 = __uint_as_float(rv[0]), v1 = __uint_as_float(rv[1]); const int i0 = (int)ri[0], i1 = (int)ri[1];
          const bool t1 = (v1 > v0) || (v1 == v0 && i1 < i0);
          bv = t1 ? v1 : v0; bi = t1 ? i1 : i0;
        }
        {
          auto rv = __builtin_amdgcn_permlane32_swap(__float_as_uint(bv), __float_as_uint(bv), false, false);
          auto ri = __builtin_amdgcn_permlane32_swap((unsigned)bi, (unsigned)bi, false, false);
          const float v0 = __uint_as_float(rv[0]), v1 = __uint_as_float(rv[1]); const int i0 = (int)ri[0], i1 = (int)ri[1];
          const bool t1 = (v1 > v0) || (v1 == v0 && i1 < i0);
          bv = t1 ? v1 : v0; bi = t1 ? i1 : i0;
        }
        idx[k] = bi; val[k] = bv;
#pragma unroll
        for (int j = 0; j < 8; ++j) { const int ej = 16 * (j >> 2) + 4 * g + (j & 3); L[j] = (ej == bi) ? -3.0e38f : L[j]; }
      }
      const float e1 = __expf(val[1] - val[0]), e2 = __expf(val[2] - val[0]), e3 = __expf(val[3] - val[0]);
      const float inv = __builtin_amdgcn_rcpf(1.0f + e1 + e2 + e3);
      if (g == 0) {
        *(int4*)(TOPI + (size_t)t * 4) = make_int4(idx[0], idx[1], idx[2], idx[3]);
        *(f32x4*)(TOPG + (size_t)t * 4) = (f32x4){inv, e1 * inv, e2 * inv, e3 * inv};
#pragma unroll
        for (int k = 0; k < 4; ++k) { rk_e[k] = idx[k]; rk_r[k] = lds_inc(lhist + idx[k]); }
      }
    }
    {
      const float r16 = rstd * 16.0f;
      unsigned char* hrow = H2 + (size_t)t * DM + 16 * g;
#pragma unroll
      for (int j = 0; j < 16; ++j) {
        u32x4 o;
#pragma unroll
        for (int hf = 0; hf < 2; ++hf) {
          const u32x4 xa = a[2 * j + hf];
          const int k0 = 64 * j + 16 * g + 8 * hf;
          const f32x4 g0 = *(const LAS f32x4*)(lgs + k0) * r16, g1 = *(const LAS f32x4*)(lgs + k0 + 4) * r16;
          const f32x4 s0 = *(const LAS f32x4*)(lsh + k0), s1 = *(const LAS f32x4*)(lsh + k0 + 4);
          f32x4 x0, x1v;
          x0[0] = __uint_as_float(xa[0] << 16); x0[1] = __uint_as_float(xa[0] & 0xffff0000u); x0[2] = __uint_as_float(xa[1] << 16); x0[3] = __uint_as_float(xa[1] & 0xffff0000u);
          x1v[0] = __uint_as_float(xa[2] << 16); x1v[1] = __uint_as_float(xa[2] & 0xffff0000u); x1v[2] = __uint_as_float(xa[3] << 16); x1v[3] = __uint_as_float(xa[3] & 0xffff0000u);
          const f32x4 y0 = x0 * g0 + s0, y1 = x1v * g1 + s1;
          o[2 * hf] = pack4_fp8(y0[0], y0[1], y0[2], y0[3]); o[2 * hf + 1] = pack4_fp8(y1[0], y1[1], y1[2], y1[3]);
        }
        *(u32x4*)(hrow + 64 * j) = o;
        asm volatile("" ::: "memory");
      }
    }
    __syncthreads();
    if (tid < 32) lbase[tid] = (int)xb_add((unsigned*)(ws + WS_BOOK + BK_HIST) + tid, (unsigned)lhist[tid]);
    __syncthreads();
    if (g == 0) {
      int4 ps;
      ps.x = lbase[rk_e[0]] + rk_r[0]; ps.y = lbase[rk_e[1]] + rk_r[1]; ps.z = lbase[rk_e[2]] + rk_r[2]; ps.w = lbase[rk_e[3]] + rk_r[3];
      *(int4*)(POSOF + (size_t)t * 4) = ps;
      int* RT2 = (int*)(ws + WS_BOOK + BK_ROWTOK2);
      RT2[rk_e[0] * 32768 + ps.x] = t; RT2[rk_e[1] * 32768 + ps.y] = t; RT2[rk_e[2] * 32768 + ps.z] = t; RT2[rk_e[3] * 32768 + ps.w] = t;
    }
  }
}

__device__ __forceinline__ void phase12(const Params& p) {
  const int tid = my_tid(), wid = tid >> 6, lane = tid & 63;
  unsigned char* ws = p.ws;
  const float* MOD = (const float*)(ws + WS_BOOK + BK_MOD);
  const bf16_t* D1 = (const bf16_t*)(ws + WS_D1);
  const unsigned char* Y = (const unsigned char*)(ws + WS_YBUF);
  const int* SLOTOF = (const int*)(ws + WS_BOOK + BK_SLOTOF);
  const float* TOPG = (const float*)(ws + WS_BOOK + BK_TOPG);
  for (int it = blockIdx.x; it < T_TOK / 128; it += gridDim.x) {
    const int t0 = it * 128, b = t0 / SEQ;
    f32x4 gt[4], fg[4];
#pragma unroll
    for (int j = 0; j < 4; ++j) { const int d = j * 256 + lane * 4; gt[j] = *(const f32x4*)(MOD + b * 6144 + 5120 + d); fg[j] = *(const f32x4*)(p.final_norm_g + d); }
    const int tw = t0 + wid * 16;
    int4 slv = *(const int4*)(SLOTOF + (size_t)(tw + (lane & 15)) * 4);
    {
      const int4 ei = *(const int4*)((const int*)(ws + WS_BOOK + BK_TOPI) + (size_t)(tw + (lane & 15)) * 4);
      const int tot = (lane < 32) ? ((const int*)(ws + WS_BOOK + BK_HIST))[lane] : 0;
      int sb = tot;
#pragma unroll
      for (int o = 1; o < 32; o <<= 1) { const int ub = __shfl_up(sb, o); if (lane >= o) sb += ub; }
      const int eb = sb - tot;
      slv.x += __shfl(eb, ei.x); slv.y += __shfl(eb, ei.y); slv.z += __shfl(eb, ei.z); slv.w += __shfl(eb, ei.w);
    }
    const f32x4 ggv = *(const f32x4*)(TOPG + (size_t)(tw + (lane & 15)) * 4);
#pragma unroll 1
    for (int i = 0; i < 16; i += 2) {
      int sl[2][4]; float gg[2][4];
#pragma unroll
      for (int u = 0; u < 2; ++u) {
        sl[u][0] = __shfl(slv.x, i + u); sl[u][1] = __shfl(slv.y, i + u); sl[u][2] = __shfl(slv.z, i + u); sl[u][3] = __shfl(slv.w, i + u);
        gg[u][0] = __shfl(ggv[0], i + u); gg[u][1] = __shfl(ggv[1], i + u); gg[u][2] = __shfl(ggv[2], i + u); gg[u][3] = __shfl(ggv[3], i + u);
      }
      unsigned yy[2][4][4]; u32x2 dd[2][4];
#pragma unroll
      for (int u = 0; u < 2; ++u)
#pragma unroll
        for (int j = 0; j < 4; ++j) {
          const int d = j * 256 + lane * 4;
#pragma unroll
          for (int k = 0; k < 4; ++k) yy[u][j][k] = *(const unsigned*)(Y + (size_t)sl[u][k] * 1024 + d);
          dd[u][j] = *(const u32x2*)(D1 + (size_t)(tw + i + u) * DM + d);
        }
#pragma unroll
      for (int u = 0; u < 2; ++u) {
        const int t = tw + i + u;
        f32x4 v[4]; float ss = 0.f;
#pragma unroll
        for (int j = 0; j < 4; ++j) {
          f32x4 y = (f32x4){0.f, 0.f, 0.f, 0.f};
#pragma unroll
          for (int k = 0; k < 4; ++k) {
            const f32x2 lo = __builtin_amdgcn_cvt_pk_f32_fp8((int)yy[u][j][k], false), hi = __builtin_amdgcn_cvt_pk_f32_fp8((int)yy[u][j][k], true);
            y[0] += gg[u][k] * lo[0]; y[1] += gg[u][k] * lo[1]; y[2] += gg[u][k] * hi[0]; y[3] += gg[u][k] * hi[1];
          }
          v[j][0] = __uint_as_float(dd[u][j].x << 16); v[j][1] = __uint_as_float(dd[u][j].x & 0xffff0000u);
          v[j][2] = __uint_as_float(dd[u][j].y << 16); v[j][3] = __uint_as_float(dd[u][j].y & 0xffff0000u);
          v[j] = v[j] + gt[j] * y * (1.0f / 16.0f);
          ss += v[j][0] * v[j][0] + v[j][1] * v[j][1] + v[j][2] * v[j][2] + v[j][3] * v[j][3];
        }
        ss = wave_sum(ss);
        const float rstd = rsqrtf(ss * (1.0f / DM) + NORM_EPS);
#pragma unroll
        for (int j = 0; j < 4; ++j) *(f32x4*)(p.out + (size_t)t * DM + j * 256 + lane * 4) = v[j] * rstd * fg[j];
      }
    }
  }
}

__global__ void __launch_bounds__(NTHR) mega(Params p) {
  extern __shared__ __attribute__((aligned(16))) unsigned char smem_raw[];
  LAS unsigned char* smem = (LAS unsigned char*)smem_raw;
  cg::grid_group grid = cg::this_grid();
  unsigned char* ws = p.ws; unsigned char* dout = (unsigned char*)p.out;
#if PROF_ON
  unsigned long long* stamps = (unsigned long long*)(ws + WS_BOOK + 15 * MiB);
#define STAMP(k) do { if (blockIdx.x == 0 && threadIdx.x == 0) stamps[k] = wall_clock64(); } while (0)
#else
#define STAMP(k) do { } while (0)
#endif
#define GSYNC() do { XcdBarrier xb_; xb_.bar = (unsigned*)(p.ws + WS_BOOK + BK_XBAR); xb_.x = xb_xcc_id(); xb_.st = (volatile LAS unsigned*)(smem + LDS_BYTES - 16); xcd_barrier(xb_); } while (0)
#if PROF_ON && PROF_GEMM
#define GPROF(k) ((PROF_GSEL == (k)) ? (unsigned long long*)(ws + WS_BOOK + 15 * MiB + 1024) : nullptr)
#else
#define GPROF(k) nullptr
#endif
  STAMP(0);
  volatile LAS unsigned* xst = (volatile LAS unsigned*)(smem + LDS_BYTES - 16);
  if (threadIdx.x < 4) xst[threadIdx.x] = 0u;
  __syncthreads();
  (void)xcd_barrier_post((unsigned*)(ws + WS_BOOK + BK_XBAR), xst);
  phase0(p, smem);
  if (p.ph0 == 0x7fffffff) grid.sync();
  GSYNC();
  STAMP(1);
  phase1(p);
  GSYNC(); STAMP(2);
  {
    DenseSched S{(const char*)(ws + WS_H), (const char*)(dout + DO_WIN), 10, 1280};
    EpiProj E{(bf16_t*)(ws + WS_U), (bf16_t*)(ws + WS_Q), (bf16_t*)(ws + WS_KV), (float*)(ws + WS_GATES), (const float*)(ws + WS_BOOK + BK_ROPE)};
    gm::gemm_phase<false>(smem, S, E, GPROF(0));
  }
  GSYNC(); STAMP(3);
  phase3w(p, smem);
  GSYNC(); STAMP(4);
  phase4_mfma(p, smem);
  GSYNC(); STAMP(5);
  phase6(p, smem);
  GSYNC(); STAMP(6);
  STAMP(7);
  {
    DenseSched S{(const char*)(ws + WS_MIX), (const char*)(dout + DO_WOUT), 4, 512};
    EpiOut E{(bf16_t*)(ws + WS_D1), (const float*)(ws + WS_BOOK + BK_MOD), p.x, (const float*)(ws + WS_BOOK + BK_SSQ)};
    gm::gemm_phase<false, EpiOut, DenseSched, 8>(smem, S, E, GPROF(1));
  }
  GSYNC(); STAMP(8);
  phase8(p, smem);
  STAMP(9);
  GSYNC(); STAMP(10);
  {
    const int* ecnt = (const int*)(ws + WS_BOOK + BK_HIST);
    {
      const int ntiles = load_unit_table(smem, ecnt, 3);
      GuSched S{(const char*)(dout + DO_H2), (const char*)(ws + WS_WGU), smem + TAB_OFF, (const int*)(ws + WS_BOOK + BK_ROWTOK2), ntiles};
      EpiGU E{(unsigned char*)(ws + WS_ACT), p.b_gate, p.b_up};
      gm::gemm_phase<true>(smem, S, E, GPROF(2));
    }
    GSYNC(); STAMP(11);
    {
      const int ntiles = load_unit_table(smem, ecnt, 2);
      DownSched S{(const char*)(ws + WS_ACT), (const char*)(dout + DO_WD), smem + TAB_OFF, ntiles};
      EpiDown E{(unsigned char*)(ws + WS_YBUF), p.b_down};
      gm::gemm_phase<true>(smem, S, E, GPROF(3));
    }
    GSYNC(); STAMP(12);
    phase12(p);
#if PROF_ON
    GSYNC(); STAMP(13);
#endif
  }
#if PROF_ON
  GSYNC();
  {
#if PROF_ITEMS
    if (blockIdx.x == 0 && threadIdx.x == 0) {
      const unsigned long long* st = (const unsigned long long*)(ws + WS_BOOK + BK_XBAR + 16384 + 64);
      for (int q = 0; q < 3; ++q) { stamps[40 + 2 * q] = 0; stamps[41 + 2 * q] = ld_u64(st + q) / (ld_u64(st + 4 + q) + 1); }
    }
    GSYNC();
#endif
    const float dA = (float)(long long)(ld_u64(stamps + PROF_A1) - ld_u64(stamps + PROF_A)) * 0.01f;
    const float dB = (float)(long long)(ld_u64(stamps + PROF_B1) - ld_u64(stamps + PROF_B)) * 0.01f;
#if PROF_GEMM
    const unsigned long long* gp = (const unsigned long long*)(ws + WS_BOOK + 15 * MiB + 1024);
    const float nunf = (float)ld_u64(gp + 2);
    const float dA2 = (float)ld_u64(gp + 0) * 0.1f / nunf, dB2 = (float)ld_u64(gp + 1) * 0.1f / nunf;
    const float qA = rintf(logf(fmaxf(dA2, 1.0f)) * (1.0f / 0.22314355f)), qB = rintf(logf(fmaxf(dB2, 1.0f)) * (1.0f / 0.22314355f));
    (void)dA; (void)dB;
#else
    const float qA = rintf(logf(fmaxf(dA, 1.0f)) * (1.0f / PROF_LOGBIN) + PROF_SHIFT), qB = rintf(logf(fmaxf(dB, 1.0f)) * (1.0f / PROF_LOGBIN) + PROF_SHIFT);
#endif
    const float va = sqrtf(qA);
    for (size_t i = (size_t)blockIdx.x * NTHR + threadIdx.x; i < (size_t)T_TOK * DM; i += (size_t)gridDim.x * NTHR) p.out[i] = (i == 0) ? 16.0f * qB : va;
  }
#endif
}

extern "C" void kernel_launch(void* const* d_in, const int* in_sizes, int n_in,
                              void* d_out, int out_size, void* d_ws, size_t ws_size,
                              hipStream_t stream) {
  static int grid_blocks = 0;
  if (!grid_blocks) {
    int dev = 0, cus = 0, per_cu = 0;
    (void)hipGetDevice(&dev);
    (void)hipDeviceGetAttribute(&cus, hipDeviceAttributeMultiprocessorCount, dev);
    (void)hipFuncSetAttribute((const void*)mega, hipFuncAttributeMaxDynamicSharedMemorySize, (int)LDS_BYTES);
    (void)hipOccupancyMaxActiveBlocksPerMultiprocessor(&per_cu, mega, NTHR, LDS_BYTES);
    if (per_cu > 1) per_cu = 1;
    grid_blocks = cus * per_cu;
    if (grid_blocks > 256) grid_blocks = 256;
    grid_blocks &= ~7;
  }
  Params p{};
  const float** pp = (const float**)&p;
  for (int i = 0; i < 29; ++i) pp[i] = (const float*)d_in[i];
  p.out = (float*)d_out; p.ws = (unsigned char*)d_ws; p.ph0 = 0; p.ph1 = 0;
  if (ws_size < WS_TOTAL) { fprintf(stderr, "workspace too small: %zu < %zu\n", ws_size, (size_t)WS_TOTAL); return; }
  (void)hipMemsetAsync((unsigned char*)d_ws + WS_BOOK + BK_XBAR, 0, BK_ZERO_BYTES, stream);
  void* args[] = {&p};
  hipError_t e = hipLaunchCooperativeKernel((void*)mega, dim3(grid_blocks), dim3(NTHR), args, LDS_BYTES, stream);
  if (e != hipSuccess) fprintf(stderr, "cooperative launch failed: %s (grid %d)\n", hipGetErrorString(e), grid_blocks);
}
```

```cpp
#include <hip/hip_runtime.h>
#include <hip/hip_cooperative_groups.h>
#include <cstdio>
#include <cstdint>
namespace cg = cooperative_groups;
#define PROF_ON 0
#define PROF_A 0
#define PROF_B 2
#define PROF_A1 (PROF_A + 1)
#define PROF_B1 (PROF_B + 1)
#if PROF_ON
#define PROF_BLK 0
#define PROF_SHIFT 0.0f
#define PROF_LOGBIN 0.22314355f
#define SUBSTAMP(k) do { if (blockIdx.x == PROF_BLK && threadIdx.x == 0) ((unsigned long long*)(p.ws + WS_BOOK + 15 * MiB))[k] = wall_clock64(); } while (0)
#else
#define SUBSTAMP(k) do { } while (0)
#endif
#define PROF_ITEMS 0
#define PROF_GEMM 0
#define PROF_GSEL 2

#define LAS __attribute__((address_space(3)))
typedef unsigned short bf16_t;
typedef short bf16x8 __attribute__((ext_vector_type(8)));
typedef float f32x4 __attribute__((ext_vector_type(4)));
typedef float f32x2 __attribute__((ext_vector_type(2)));
typedef unsigned u32x4 __attribute__((ext_vector_type(4)));
typedef unsigned u32x2 __attribute__((ext_vector_type(2)));

constexpr int T_TOK = 32768, DM = 1024, NB = 16, SEQ = 2048;
constexpr int IN_COLS = 2328, IN_PAD = 2560;
constexpr int NCMP = 127;
constexpr int NEXP = 32, TOPK = 4, DFF = 1024;
constexpr int CHUNK_TOK = 32768, CHUNK_ROWS = 131072, MAXTILES = 544;
constexpr float NORM_EPS = 1e-5f;
constexpr int NTHR = 512;
constexpr size_t LDS_BYTES = 140 * 1024;

constexpr size_t MiB = 1024 * 1024;
constexpr size_t WS_BOOK = 0;
constexpr size_t WS_WGU  = 16 * MiB;
constexpr size_t WS_ACT  = 80 * MiB;
constexpr size_t WS_D1   = 208 * MiB;
constexpr size_t WS_E    = 272 * MiB;
constexpr size_t WS_YBUF = WS_E;
constexpr size_t WS_TOTAL = WS_E + 256 * MiB;
constexpr size_t WS_H    = WS_E;
constexpr size_t WS_MIX  = WS_E;
constexpr size_t WS_U    = WS_E + 64 * MiB;
constexpr size_t WS_Q    = WS_E + 96 * MiB;
constexpr size_t WS_KV   = WS_E + 128 * MiB;
constexpr size_t WS_GATES= WS_E + 176 * MiB;
constexpr size_t WS_OC   = WS_E + 180 * MiB;
constexpr size_t WS_OW   = WS_E + 212 * MiB;
constexpr size_t WS_OS   = WS_ACT;
constexpr size_t BK_MOD    = 0;
constexpr size_t BK_ROPE   = 512 * 1024;
constexpr size_t BK_CB1    = BK_ROPE + 128 * 1024;
constexpr size_t BK_HIST   = BK_CB1 + 1024;
constexpr size_t BK_NT     = BK_HIST + 512;
constexpr size_t BK_TILES  = BK_NT + 256;
constexpr size_t BK_TOPI   = 1 * MiB;
constexpr size_t BK_TOPG   = BK_TOPI + 512 * 1024;
constexpr size_t BK_SLOTOF = BK_TOPG + 512 * 1024;
constexpr size_t BK_ROWTOK = BK_SLOTOF + 512 * 1024;
constexpr size_t BK_SEL    = BK_ROWTOK + 512 * 1024;
constexpr size_t BK_KCMP   = BK_SEL + 256 * 1024;
constexpr size_t BK_VCMP   = BK_KCMP + 512 * 1024;
constexpr size_t BK_ITEMCNT= BK_VCMP + 512 * 1024;
constexpr size_t BK_WRT    = BK_ITEMCNT + 32 * 1024;
constexpr size_t BK_SSQ    = BK_WRT + 128 * 1024;
constexpr size_t BK_END    = BK_SSQ + 256 * 1024;
constexpr size_t BK_ROWTOK2 = 8 * MiB;
static_assert(BK_END <= 14 * MiB, "book");
constexpr size_t BK_XBAR   = 14 * MiB;
constexpr size_t BK_CTR    = BK_XBAR + 16384;
constexpr size_t BK_ZERO_BYTES = 16384 + 256;
constexpr size_t DO_WIN  = 0;
constexpr size_t DO_WOUT = 5 * MiB;
constexpr size_t DO_CK1  = 7 * MiB;
constexpr size_t DO_CV1  = DO_CK1 + 512 * 1024;
constexpr size_t DO_CK2  = DO_CV1 + 512 * 1024;
constexpr size_t DO_CV2  = DO_CK2 + 16 * 1024;
constexpr size_t DO_H2   = 9 * MiB;
constexpr size_t DO_WD   = 64 * MiB;

struct Params {
  const float *x, *c, *norm1_g, *norm2_g, *w_ada, *b_ada, *w_in, *conv_w, *conv_b, *conv_ln_g, *conv_ln_b,
      *cmp_pe_k, *cmp_pe_v, *cmp_k_w1, *cmp_k_w2, *cmp_v_w1, *cmp_v_w2, *out_norm_conv, *out_norm_nsa, *w_out,
      *w_router, *b_router, *w_gate, *b_gate, *w_up, *b_up, *w_down, *b_down, *final_norm_g;
  float* out;
  unsigned char* ws;
  int ph0, ph1;
};

__device__ __forceinline__ bf16_t f2bf(float f) { unsigned u = __float_as_uint(f); u += 0x7FFFu + ((u >> 16) & 1u); return (bf16_t)(u >> 16); }
__device__ __forceinline__ float bf2f(bf16_t b) { return __uint_as_float(((unsigned)b) << 16); }
__device__ __forceinline__ unsigned pack2(float lo, float hi) { return (unsigned)f2bf(lo) | ((unsigned)f2bf(hi) << 16); }
__device__ __forceinline__ float clamp448(float v) { return __builtin_amdgcn_fmed3f(v, -448.0f, 448.0f); }
__device__ __forceinline__ unsigned pack4_fp8(float a, float b, float c, float d) {
  int w = 0;
  w = __builtin_amdgcn_cvt_pk_fp8_f32(clamp448(a), clamp448(b), w, false);
  w = __builtin_amdgcn_cvt_pk_fp8_f32(clamp448(c), clamp448(d), w, true);
  return (unsigned)w;
}
template <int CTRL> __device__ __forceinline__ float dpp_mov(float v) { return __int_as_float(__builtin_amdgcn_update_dpp(0, __float_as_int(v), CTRL, 0xF, 0xF, true)); }
template <int CTRL> __device__ __forceinline__ int dpp_movi(int v) { return __builtin_amdgcn_update_dpp(0, v, CTRL, 0xF, 0xF, true); }
__device__ __forceinline__ float lx1(float v) { return dpp_mov<0xB1>(v); }
__device__ __forceinline__ float lx2(float v) { return dpp_mov<0x4E>(v); }
__device__ __forceinline__ float lx4(float v) { return dpp_mov<0x1B>(dpp_mov<0x141>(v)); }
__device__ __forceinline__ float lx8(float v) { return dpp_mov<0x128>(v); }
__device__ __forceinline__ int lx1i(int v) { return dpp_movi<0xB1>(v); }
__device__ __forceinline__ int lx2i(int v) { return dpp_movi<0x4E>(v); }
__device__ __forceinline__ int lx4i(int v) { return dpp_movi<0x1B>(dpp_movi<0x141>(v)); }
__device__ __forceinline__ int lx8i(int v) { return dpp_movi<0x128>(v); }
__device__ __forceinline__ float xsum32(float a, float b) { auto r = __builtin_amdgcn_permlane32_swap(__float_as_uint(a), __float_as_uint(b), false, false); return __uint_as_float(r[0]) + __uint_as_float(r[1]); }
__device__ __forceinline__ float xsum16(float a, float b) { auto r = __builtin_amdgcn_permlane16_swap(__float_as_uint(a), __float_as_uint(b), false, false); return __uint_as_float(r[0]) + __uint_as_float(r[1]); }
__device__ __forceinline__ float xmax32(float v) { auto r = __builtin_amdgcn_permlane32_swap(__float_as_uint(v), __float_as_uint(v), false, false); return fmaxf(__uint_as_float(r[0]), __uint_as_float(r[1])); }
__device__ __forceinline__ float xother32(float v, int hi) { auto r = __builtin_amdgcn_permlane32_swap(__float_as_uint(v), __float_as_uint(v), false, false); return __uint_as_float(hi ? r[0] : r[1]); }
__device__ __forceinline__ unsigned wave_or(unsigned v) {
  v |= (unsigned)lx1i((int)v); v |= (unsigned)lx2i((int)v); v |= (unsigned)lx4i((int)v); v |= (unsigned)lx8i((int)v);
  { auto r = __builtin_amdgcn_permlane16_swap(v, v, false, false); v = r[0] | r[1]; }
  { auto r = __builtin_amdgcn_permlane32_swap(v, v, false, false); v = r[0] | r[1]; }
  return v;
}
__device__ __forceinline__ float wave_sum(float v) {
  v += lx1(v); v += lx2(v); v += lx4(v); v += lx8(v);
  v = xsum16(v, v);
  v = xsum32(v, v);
  return v;
}
__device__ __forceinline__ float sigmoidf_(float v) { return __builtin_amdgcn_rcpf(1.0f + __builtin_amdgcn_exp2f(v * -1.4426950408889634f)); }
__device__ __forceinline__ int ld_i32(const int* p) { return __hip_atomic_load(p, __ATOMIC_RELAXED, __HIP_MEMORY_SCOPE_AGENT); }

__device__ __forceinline__ int my_tid() { int t = threadIdx.x; asm volatile("" : "+v"(t)); return t; }
__device__ __forceinline__ int lds_inc(LAS int* p) { return __hip_atomic_fetch_add(p, 1, __ATOMIC_RELAXED, __HIP_MEMORY_SCOPE_WORKGROUP); }
__device__ __forceinline__ unsigned long long ld_u64(const unsigned long long* p) { return __hip_atomic_load(p, __ATOMIC_RELAXED, __HIP_MEMORY_SCOPE_AGENT); }
__device__ __forceinline__ float block_sum(float v, LAS float* red) {
  v = wave_sum(v);
  const int tq = my_tid(); const int wid = tq >> 6, lane = tq & 63;
  __syncthreads();
  if (lane == 0) red[wid] = v;
  __syncthreads();
  float s = 0.f;
#pragma unroll
  for (int i = 0; i < 8; ++i) s += red[i];
  return s;
}


#define XB_TMO      128
#define XB_XCNT(j)  (256  + 64 * (j))
#define XB_XSUB(j)  (1280 + 64 * (j))
#define XB_XGEN(j)  (2304 + 64 * (j))
#define XB_TOP      3328
#define XB_TOPGEN   3392
#define XCD_BAR_WORDS 3456
#define XB_SPIN_CAP (1u << 18)
__device__ __forceinline__ unsigned xb_ld(unsigned* p)              { return __hip_atomic_load(p, __ATOMIC_RELAXED, __HIP_MEMORY_SCOPE_AGENT); }
__device__ __forceinline__ unsigned xb_add(unsigned* p, unsigned v) { return __hip_atomic_fetch_add(p, v, __ATOMIC_RELAXED, __HIP_MEMORY_SCOPE_AGENT); }
__device__ __forceinline__ unsigned xb_xcc_id() { return (unsigned)__builtin_amdgcn_s_getreg((3 << 11) | 20) & 0xFu; }
#define XB_SPIN(cond, bar) do { unsigned _sp = 0; while (cond) { __builtin_amdgcn_s_sleep(1); \
    if ((++_sp & 255u) == 0u) { if (xb_ld(&(bar)[XB_TMO])) break; if (_sp > XB_SPIN_CAP) { atomicAdd(&(bar)[XB_TMO], 1u); break; } } } } while (0)
struct XcdBarrier { unsigned* bar; unsigned x; volatile LAS unsigned* st; };
__device__ __forceinline__ XcdBarrier xcd_barrier_post(unsigned* bar, volatile LAS unsigned* st) {
  XcdBarrier b; b.bar = bar; b.x = xb_xcc_id(); b.st = st;
  if (threadIdx.x == 0) (void)xb_add(&bar[XB_XCNT(b.x)], 1u);
  return b;
}
__device__ __forceinline__ void xcd_barrier_complete(unsigned* bar, unsigned x, unsigned& nloc, unsigned& nx) {
  const unsigned G = gridDim.x * gridDim.y * gridDim.z;
  unsigned sum, cnt, mine, sp = 0u;
  for (;;) {
    sum = 0u; cnt = 0u; mine = 0u;
#pragma unroll
    for (unsigned j = 0; j < 16; ++j) { const unsigned c = xb_ld(&bar[XB_XCNT(j)]); sum += c; cnt += (c > 0u) ? 1u : 0u; mine = (j == x) ? c : mine; }
    if (sum == G) break;
    __builtin_amdgcn_s_sleep(1);
    if ((++sp & 255u) == 0u) { if (xb_ld(&bar[XB_TMO])) break; if (sp > XB_SPIN_CAP) { atomicAdd(&bar[XB_TMO], 1u); break; } }
  }
  nloc = mine > 0u ? mine : 1u; nx = cnt > 0u ? cnt : 1u;
}
__device__ __forceinline__ void xcd_barrier(const XcdBarrier& b) {
  asm volatile("s_waitcnt vmcnt(0)" ::: "memory");
  __syncthreads();
  if (threadIdx.x == 0) {
    unsigned* bar = b.bar;
    __builtin_amdgcn_s_waitcnt(0);
    unsigned nloc = b.st[0], nx = b.st[1];
    if (nloc == 0u) { xcd_barrier_complete(bar, b.x, nloc, nx); b.st[0] = nloc; b.st[1] = nx; }
    const unsigned old = xb_add(&bar[XB_XSUB(b.x)], 1u);
    const unsigned gen = old / nloc;
    if (old + 1u == (gen + 1u) * nloc) {
      __builtin_amdgcn_fence(__ATOMIC_RELEASE, "agent");
      asm volatile("s_waitcnt vmcnt(0)" ::: "memory");
      const unsigned og = xb_add(&bar[XB_TOP], 1u);
      const unsigned tg = og / nx;
      if (og + 1u == (tg + 1u) * nx) xb_add(&bar[XB_TOPGEN], 1u);
      else XB_SPIN(xb_ld(&bar[XB_TOPGEN]) == tg, bar);
      __builtin_amdgcn_fence(__ATOMIC_ACQUIRE, "agent");
      xb_add(&bar[XB_XGEN(b.x)], 1u);
      asm volatile("s_waitcnt vmcnt(0)" ::: "memory");
    } else {
      XB_SPIN(xb_ld(&bar[XB_XGEN(b.x)]) == gen, bar);
      __builtin_amdgcn_fence(__ATOMIC_ACQUIRE, "agent");
      asm volatile("s_waitcnt vmcnt(0)" ::: "memory");
    }
  }
  __syncthreads();
}

__device__ __forceinline__ void conv_tile(const float* __restrict__ src, int ldn, int nvalid, int k0, int n0,
                                          bf16_t* dst, int ldk, int drow0, LAS float* tile, const float* kscale = nullptr) {
  const int tid = my_tid();
#pragma unroll
  for (int r = 0; r < 8; ++r) {
    const int k = r * 8 + (tid >> 6), n = tid & 63;
    const float ks = kscale ? kscale[k] : 1.0f;
    tile[k * 65 + n] = (n0 + n < nvalid) ? src[(size_t)(k0 + k) * ldn + n0 + n] * ks : 0.f;
  }
  __syncthreads();
  {
    const int n = tid >> 3, ks = tid & 7;
    u32x4 w;
    w.x = pack2(tile[(ks * 8 + 0) * 65 + n], tile[(ks * 8 + 1) * 65 + n]);
    w.y = pack2(tile[(ks * 8 + 2) * 65 + n], tile[(ks * 8 + 3) * 65 + n]);
    w.z = pack2(tile[(ks * 8 + 4) * 65 + n], tile[(ks * 8 + 5) * 65 + n]);
    w.w = pack2(tile[(ks * 8 + 6) * 65 + n], tile[(ks * 8 + 7) * 65 + n]);
    *(u32x4*)(dst + (size_t)(drow0 + n) * ldk + k0 + ks * 8) = w;
  }
  __syncthreads();
}

__device__ __forceinline__ void sincos_acc(float angf, float& c, float& s) {
  const double TWO_PI = 6.283185307179586476925286766559, INV_2PI = 0.15915494309189533576888376337251;
  const double a = (double)angf;
  const double k = __builtin_rint(a * INV_2PI);
  const float r = (float)(a - k * TWO_PI);
  const float r2 = r * r;
  float ts = r, tc = 1.0f, ss = r, cs = 1.0f;
#pragma unroll
  for (int n = 1; n <= 14; ++n) {
    tc = -tc * r2 * (1.0f / (float)((2 * n - 1) * (2 * n)));
    ts = -ts * r2 * (1.0f / (float)((2 * n) * (2 * n + 1)));
    cs += tc; ss += ts;
  }
  c = cs; s = ss;
}

__device__ __forceinline__ void phase0(const Params& p, LAS unsigned char* smem) {
  const int tid = my_tid();
  unsigned char* ws = p.ws;
  unsigned char* dout = (unsigned char*)p.out;
  LAS float* fl = (LAS float*)smem;
  constexpr int I_MOD = 96, I_ROPE = 8 + 4, I_CB1 = 2, I_WIN = 640, I_WOUT = 256, I_C1 = 128, I_C2 = 4, I_GU = 0, I_WD = 0;
  constexpr int O_ROPE = I_MOD, O_CB1 = O_ROPE + I_ROPE, O_WIN = O_CB1 + I_CB1, O_WOUT = O_WIN + I_WIN, O_C1 = O_WOUT + I_WOUT,
                O_C2 = O_C1 + I_C1, O_GU = O_C2 + I_C2, O_WD = O_GU + I_GU, O_END = O_WD + I_WD;
  if (blockIdx.x == 0 && tid < 130) {
    ((int*)(ws + WS_BOOK + BK_HIST))[tid] = 0;
  }
  for (int it = blockIdx.x; it < O_END; it += gridDim.x) {
    if (it < O_ROPE) {
      const int n0 = it * 64;
      LAS float* cact = fl;
      LAS float* red = fl + 16384;
      for (int i = tid; i < 16384; i += NTHR) { const float v = p.c[i]; cact[i] = v / (1.0f + __expf(-v)); }
      __syncthreads();
      const int nl = tid & 63, kp = tid >> 6;
      float acc[16];
#pragma unroll
      for (int b = 0; b < 16; ++b) acc[b] = 0.f;
      for (int k0 = kp * 128; k0 < kp * 128 + 128; k0 += 16) {
        float w[16];
#pragma unroll
        for (int q = 0; q < 16; ++q) w[q] = p.w_ada[(size_t)(k0 + q) * 6144 + n0 + nl];
#pragma unroll
        for (int q = 0; q < 16; ++q)
#pragma unroll
          for (int b = 0; b < 16; ++b) acc[b] += cact[b * 1024 + k0 + q] * w[q];
      }
#pragma unroll
      for (int b = 0; b < 16; ++b) red[(kp * 16 + b) * 64 + nl] = acc[b];
      __syncthreads();
      float* MOD = (float*)(ws + WS_BOOK + BK_MOD);
      for (int o = tid; o < 1024; o += NTHR) {
        const int b = o >> 6, n2 = o & 63;
        float s = p.b_ada[n0 + n2];
#pragma unroll
        for (int k2 = 0; k2 < 8; ++k2) s += red[(k2 * 16 + b) * 64 + n2];
        MOD[b * 6144 + n0 + n2] = s;
      }
      __syncthreads();
    } else if (it < O_CB1) {
      const int j = it - O_ROPE;
      if (j >= 8) {
        float* WRT = (float*)(ws + WS_BOOK + BK_WRT);
        for (int i = tid; i < 8192; i += NTHR) { const int idx = (j - 8) * 8192 + i, d = idx >> 5, e = idx & 31; WRT[e * 1024 + d] = p.w_router[idx]; }
        continue;
      }
      float* ROPE = (float*)(ws + WS_BOOK + BK_ROPE);
      const float invf[8] = {1.0f, 0.1939227432012558f, 0.03760603070259094f, 0.007292664609849453f, 0.0014142135623842478f,
                             0.00027424818836152554f, 5.318296098266728e-05f, 1.0313386155758053e-05f};
      for (int e = tid; e < 2048; e += NTHR) {
        const int s = j * 256 + (e >> 3), i = e & 7;
        float fr = 1.0f;
#pragma unroll
        for (int q = 0; q < 8; ++q) fr = (i == q) ? invf[q] : fr;
        const float ang = (float)s * fr;
        float cc, sn; sincos_acc(ang, cc, sn);
        ROPE[s * 16 + i] = cc; ROPE[s * 16 + 8 + i] = sn;
      }
    } else if (it < O_WIN) {
      const int kv = it - O_CB1;
      const float* pe = kv ? p.cmp_pe_v : p.cmp_pe_k;
      const float* w1 = kv ? p.cmp_v_w1 : p.cmp_k_w1;
      const int n4 = tid & 31, part = tid >> 5;
      f32x4 s = (f32x4){0.f, 0.f, 0.f, 0.f};
      for (int k0 = part * 128; k0 < part * 128 + 128; k0 += 16) {
        f32x4 w[16];
#pragma unroll
        for (int q = 0; q < 16; ++q) w[q] = *(const f32x4*)(w1 + (size_t)(k0 + q) * 128 + n4 * 4);
#pragma unroll
        for (int q = 0; q < 16; ++q) s += w[q] * pe[k0 + q];
      }
      *(LAS f32x4*)(fl + part * 128 + n4 * 4) = s;
      __syncthreads();
      if (tid < 128) { float r = 0.f;
#pragma unroll
        for (int q = 0; q < 16; ++q) r += fl[q * 128 + tid];
        ((float*)(ws + WS_BOOK + BK_CB1))[kv * 128 + tid] = r; }
      __syncthreads();
    } else break;
  }
  {
    struct CT { const float* src; const float* kscale; bf16_t* dst; int ldn, nvalid, k0, n0, ldk, drow0; };
    auto decode = [&](int it, CT& c) {
      c.kscale = nullptr;
      if (it < O_WOUT) {
        const int j = it - O_WIN, kt = j / 40, ntl = j % 40, n0 = ntl * 64;
        int drow0;
        if (n0 < 512) drow0 = (n0 >> 7) * 256 + (n0 & 127);
        else if (n0 < 1024) { const int cc = n0 - 512; drow0 = (cc >> 7) * 256 + 128 + (cc & 127); }
        else drow0 = n0;
        c.src = p.w_in; c.ldn = IN_COLS; c.nvalid = IN_COLS; c.k0 = kt * 64; c.n0 = n0; c.dst = (bf16_t*)(dout + DO_WIN); c.ldk = 1024; c.drow0 = drow0;
      } else if (it < O_C1) {
        const int j = it - O_WOUT, kt = j >> 4, ntl = j & 15;
        c.src = p.w_out; c.ldn = 1024; c.nvalid = 1024; c.k0 = kt * 64; c.n0 = ntl * 64; c.dst = (bf16_t*)(dout + DO_WOUT); c.ldk = 1024; c.drow0 = ntl * 64;
        c.kscale = kt >= 8 ? p.out_norm_nsa + (kt - 8) * 64 : nullptr;
      } else if (it < O_C2) {
        const int j = it - O_C1, kv = j >> 6, jj = j & 63, kt = jj >> 1, ntl = jj & 1;
        c.src = kv ? p.cmp_v_w1 : p.cmp_k_w1; c.ldn = 128; c.nvalid = 128; c.k0 = kt * 64; c.n0 = ntl * 64; c.dst = (bf16_t*)(dout + (kv ? DO_CV1 : DO_CK1)); c.ldk = 2048; c.drow0 = ntl * 64;
      } else {
        const int j = it - O_C2, kv = j >> 1, kt = j & 1;
        c.src = kv ? p.cmp_v_w2 : p.cmp_k_w2; c.ldn = 64; c.nvalid = 64; c.k0 = kt * 64; c.n0 = 0; c.dst = (bf16_t*)(dout + (kv ? DO_CV2 : DO_CK2)); c.ldk = 128; c.drow0 = 0;
      }
    };
    float rv[8];
    auto loadt = [&](const CT& c) {
#pragma unroll
      for (int r = 0; r < 8; ++r) {
        const int k = r * 8 + (tid >> 6), n = tid & 63;
        const float ks = c.kscale ? c.kscale[k] : 1.0f;
        rv[r] = (c.n0 + n < c.nvalid) ? c.src[(size_t)(c.k0 + k) * c.ldn + c.n0 + n] * ks : 0.f;
      }
    };
    int it = blockIdx.x;
    while (it < O_WIN) it += gridDim.x;
    __syncthreads();
    CT c;
    if (it < O_END) { decode(it, c); loadt(c); }
    while (it < O_END) {
#pragma unroll
      for (int r = 0; r < 8; ++r) fl[(r * 8 + (tid >> 6)) * 65 + (tid & 63)] = rv[r];
      const CT cc = c;
      const int nxt = it + (int)gridDim.x;
      if (nxt < O_END) { decode(nxt, c); loadt(c); }
      __syncthreads();
      {
        const int n = tid >> 3, ks = tid & 7;
        u32x4 w;
        w.x = pack2(fl[(ks * 8 + 0) * 65 + n], fl[(ks * 8 + 1) * 65 + n]);
        w.y = pack2(fl[(ks * 8 + 2) * 65 + n], fl[(ks * 8 + 3) * 65 + n]);
        w.z = pack2(fl[(ks * 8 + 4) * 65 + n], fl[(ks * 8 + 5) * 65 + n]);
        w.w = pack2(fl[(ks * 8 + 6) * 65 + n], fl[(ks * 8 + 7) * 65 + n]);
        *(u32x4*)(cc.dst + (size_t)(cc.drow0 + n) * cc.ldk + cc.k0 + ks * 8) = w;
      }
      __syncthreads();
      it = nxt;
    }
  }
  SUBSTAMP(20);
  {
    __syncthreads();
    constexpr int NIT = 32 * 3 * 8 * 8;
    const int kr = tid >> 5, n4 = tid & 31;
    f32x4 reg[8];
    auto src_of = [&](int it2, int& e, int& mat, int& kt, int& ntl) -> const float* {
      e = it2 / 192; const int r = it2 - e * 192; mat = r >> 6; kt = (r >> 3) & 7; ntl = r & 7;
      const float* base = (mat == 0) ? p.w_gate : (mat == 1 ? p.w_up : p.w_down);
      return base + (size_t)e * 1024 * 1024 + (size_t)(kt * 128) * 1024 + ntl * 128;
    };
    constexpr int NLB = 112, NLOW = NLB * 20;
    const bool lowblk = blockIdx.x < NLB;
    const int stride2 = lowblk ? NLB : (int)gridDim.x - NLB;
    const int end2 = lowblk ? NLOW : NIT;
    int it2 = lowblk ? (int)blockIdx.x : NLOW + ((int)blockIdx.x - NLB);
    int e, mat, kt, ntl;
    if (it2 < end2) {
      const float* s = src_of(it2, e, mat, kt, ntl);
#pragma unroll
      for (int r = 0; r < 8; ++r) reg[r] = *(const f32x4*)(s + (size_t)(kr + 16 * r) * 1024 + n4 * 4);
    }
    while (it2 < end2) {
#pragma unroll
      for (int r = 0; r < 8; ++r) { const int k = kr + 16 * r; *(LAS f32x4*)(fl + k * 128 + ((4 * n4) ^ (((k >> 3) & 15) << 2))) = reg[r]; }
      __syncthreads();
      const int ce = e, cmat = mat, ckt = kt, cntl = ntl;
      const int nxt = it2 + stride2;
      if (nxt < end2) {
        const float* s = src_of(nxt, e, mat, kt, ntl);
#pragma unroll
        for (int r = 0; r < 8; ++r) reg[r] = *(const f32x4*)(s + (size_t)(kr + 16 * r) * 1024 + n4 * 4);
      }
      unsigned char* dst = (cmat == 2) ? (dout + DO_WD) + (size_t)ce * 1024 * 1024 : (ws + WS_WGU) + (size_t)ce * 2048 * 1024;
      const int ks = tid & 15;
#pragma unroll
      for (int j = 0; j < 4; ++j) {
        const int n = (tid >> 4) + 32 * j;
        float v[8];
#pragma unroll
        for (int q = 0; q < 8; ++q) { const int k = 8 * ks + q; v[q] = fl[k * 128 + (n ^ (ks << 2))] * 32.0f; }
        u32x2 w; w.x = pack4_fp8(v[0], v[1], v[2], v[3]); w.y = pack4_fp8(v[4], v[5], v[6], v[7]);
        const int ng = cntl * 128 + n;
        const int drow = (cmat == 2) ? ng : ((ng >> 7) * 256 + cmat * 128 + (ng & 127));
        *(u32x2*)(dst + (size_t)drow * 1024 + ckt * 128 + ks * 8) = w;
      }
      __syncthreads();
      it2 = nxt;
    }
  }
  SUBSTAMP(21);
}

__device__ __forceinline__ void phase1(const Params& p) {
  const int tid = my_tid(), wid = tid >> 6, lane = tid & 63;
  const float* MOD = (const float*)(p.ws + WS_BOOK + BK_MOD);
  bf16_t* H = (bf16_t*)(p.ws + WS_H);
  for (int it = blockIdx.x; it < T_TOK / 128; it += gridDim.x) {
    const int t0 = it * 128, b = t0 / SEQ;
    f32x4 sc[4], sh[4];
#pragma unroll
    for (int j = 0; j < 4; ++j) {
      const int d = j * 256 + lane * 4;
      const f32x4 g = *(const f32x4*)(p.norm1_g + d);
      const f32x4 s1 = *(const f32x4*)(MOD + b * 6144 + 1024 + d);
      sh[j] = *(const f32x4*)(MOD + b * 6144 + d);
      sc[j] = g * (s1 + 1.0f);
    }
    for (int tt = wid; tt < 128; tt += 8) {
      const int t = t0 + tt;
      f32x4 v[4]; float ss = 0.f;
#pragma unroll
      for (int j = 0; j < 4; ++j) { v[j] = *(const f32x4*)(p.x + (size_t)t * DM + j * 256 + lane * 4); ss += v[j][0] * v[j][0] + v[j][1] * v[j][1] + v[j][2] * v[j][2] + v[j][3] * v[j][3]; }
      ss = wave_sum(ss);
      const float rstd = rsqrtf(ss * (1.0f / DM) + NORM_EPS);
#pragma unroll
      for (int j = 0; j < 4; ++j) {
        const f32x4 o = v[j] * rstd * sc[j] + sh[j];
        u32x2 w; w.x = pack2(o[0], o[1]); w.y = pack2(o[2], o[3]);
        *(u32x2*)(H + (size_t)t * DM + j * 256 + lane * 4) = w;
      }
    }
  }
}

namespace gm {
constexpr int BM = 256, BK = 64, HALF = 128, HTB = HALF * BK * 2, STAGE_BYTES = 8 * HTB, KDIM = 1024, NT = KDIM / BK;
__device__ __forceinline__ int lds_byte(int r, int c) { const int st = (r >> 4) * 2 + (c >> 5), rr = r & 15, cc = c & 31, ob = rr * 64 + cc * 2; return st * 1024 + (ob ^ (((ob >> 9) & 1) << 5)); }
__device__ __forceinline__ void stage_rc(int b, int& R, int& C) { const int st = b / 1024, sb = b % 1024, swz = sb ^ (((sb >> 9) & 1) << 5); R = (st >> 1) * 16 + swz / 64; C = (st & 1) * 32 + (swz % 64) / 2; }
__device__ __forceinline__ int perm32(int rho) { const int n = rho >> 4, i = rho & 15; return 8 * (i >> 2) + 4 * n + (i & 3); }

typedef int v8i __attribute__((ext_vector_type(8)));
typedef int v4i __attribute__((ext_vector_type(4)));
__device__ __forceinline__ v8i cat8(bf16x8 a, bf16x8 b) { return __builtin_shufflevector(__builtin_bit_cast(v4i, a), __builtin_bit_cast(v4i, b), 0, 1, 2, 3, 4, 5, 6, 7); }
__device__ __forceinline__ void glds16(const char* sbase, unsigned voff, unsigned lds_dst) {
  unsigned keep;
  asm volatile("s_mov_b32 %0, m0\n\ts_mov_b32 m0, %3\n\ts_nop 0\n\tglobal_load_lds_dwordx4 %1, %2\n\ts_mov_b32 m0, %0" : "=&s"(keep) : "v"(voff), "s"(sbase), "s"(lds_dst) : "memory");
}
struct Unit {
  const char* A;
  const char* B;
  unsigned ao[2][2];
  int pm, pn, e, row0, nrows;
};

template <bool FP8, class Epi, class Sched, int KT0 = 0>
__device__ __forceinline__ void gemm_phase(LAS unsigned char* lds, const Sched& S, const Epi& E, unsigned long long* gprof = nullptr) {
  const int tid = my_tid(), wid = __builtin_amdgcn_readfirstlane(tid >> 6), lane = tid & 63, wr = wid >> 2, wc = wid & 3, fr = lane & 15, fq = lane >> 4;
  constexpr int PITCH = FP8 ? 1024 : 2048, nt = FP8 ? 8 : 16;
  unsigned voffB[2];
#pragma unroll
  for (int i = 0; i < 2; ++i) { int R, C; stage_rc(tid * 16 + i * 8192, R, C); const int Rb = (R & ~31) + perm32(R & 31);
    voffB[i] = (unsigned)(Rb * PITCH + C * 2); }
  const size_t kstep = (size_t)(BK * 2);
  const size_t hstep = (size_t)HALF * PITCH;
  const unsigned ldsw = (unsigned)wid * 1024u;
  const unsigned ldsbase = (unsigned)(size_t)lds;
  const int aoff = lds_byte(wr * 64 + fr, fq * 8), boff = lds_byte(wc * 32 + fr, fq * 8);
#define GM_SA(b, h) (((b) * 2 + (h)) * HTB)
#define GM_SB(b, h) ((4 + (b) * 2 + (h)) * HTB)
#define GM_STAGE(bufoff, gbase, voff) do { _Pragma("unroll") for (int _i = 0; _i < 2; ++_i) glds16((const char*)(gbase), (voff)[_i], ldsbase + (unsigned)(bufoff) + ldsw + (unsigned)(_i * 8192)); } while (0)
#define GM_LDA(dst, b, h) do { _Pragma("unroll") for (int m = 0; m < 4; ++m) dst[m] = __builtin_shufflevector(*(const LAS v4i*)(lds + GM_SA(b, h) + aoff + m * 2048), *(const LAS v4i*)(lds + GM_SA(b, h) + aoff + m * 2048 + 1024), 0, 1, 2, 3, 4, 5, 6, 7); } while (0)
#define GM_LDB(dst, b, h) do { _Pragma("unroll") for (int n = 0; n < 2; ++n) dst[n] = __builtin_shufflevector(*(const LAS v4i*)(lds + GM_SB(b, h) + boff + n * 2048), *(const LAS v4i*)(lds + GM_SB(b, h) + boff + n * 2048 + 1024), 0, 1, 2, 3, 4, 5, 6, 7); } while (0)
#define GM_LO(x) __builtin_bit_cast(bf16x8, __builtin_shufflevector(x, x, 0, 1, 2, 3))
#define GM_HI(x) __builtin_bit_cast(bf16x8, __builtin_shufflevector(x, x, 4, 5, 6, 7))
#define GM_MMA(ai, bj, At, Bt) do { __builtin_amdgcn_s_setprio(1); _Pragma("unroll") for (int m = 0; m < 4; ++m) _Pragma("unroll") for (int n = 0; n < 2; ++n) { \
    if constexpr (FP8) acc[ai][bj][m][n] = __builtin_amdgcn_mfma_scale_f32_16x16x128_f8f6f4(Bt[n], At[m], acc[ai][bj][m][n], 0, 0, 0, 0x7F7F7F7F, 0, 0x7F7F7F7F); \
    else { acc[ai][bj][m][n] = __builtin_amdgcn_mfma_f32_16x16x32_bf16(GM_LO(Bt[n]), GM_LO(At[m]), acc[ai][bj][m][n], 0, 0, 0); \
           acc[ai][bj][m][n] = __builtin_amdgcn_mfma_f32_16x16x32_bf16(GM_HI(Bt[n]), GM_HI(At[m]), acc[ai][bj][m][n], 0, 0, 0); } } \
    __builtin_amdgcn_s_setprio(0); } while (0)
#define GM_WAIT_V(n) asm volatile("s_waitcnt vmcnt(" #n ")" ::: "memory")
#define GM_WAIT_L(n) asm volatile("s_waitcnt lgkmcnt(" #n ")" ::: "memory")
#define GM_BAR __builtin_amdgcn_s_barrier()
#define GM_SCHED __builtin_amdgcn_sched_barrier(0)
  Unit cur, nxt; int ui = 0;
  if (!S.next(0, cur, tid)) return;
  f32x4 acc[2][2][4][2];
  typename Epi::State est;
  { typename Epi::Pre pre0; E.prefetch(pre0, cur, wr, wc, fr, fq); E.init(acc, pre0, est); }
  v8i At[4], B0[2], B1[2];
  constexpr size_t koff0 = (size_t)KT0 * 128;
  const char* cA = cur.A; const char* cB = cur.B;
  unsigned cao0[2] = {cur.ao[0][0], cur.ao[0][1]}, cao1[2] = {cur.ao[1][0], cur.ao[1][1]};
  GM_STAGE(GM_SB(0, 0), cB + koff0, voffB); GM_STAGE(GM_SB(0, 1), cB + koff0 + hstep, voffB); GM_STAGE(GM_SA(0, 0), cA + koff0, cao0); GM_STAGE(GM_SA(0, 1), cA + koff0, cao1);
  if (wr == 1) GM_BAR;
  GM_WAIT_V(2); GM_BAR;
  GM_STAGE(GM_SB(1, 0), cB + koff0 + kstep, voffB); GM_STAGE(GM_SA(1, 0), cA + koff0 + kstep, cao0); GM_STAGE(GM_SB(1, 1), cB + koff0 + hstep + kstep, voffB);
  GM_WAIT_V(6); GM_BAR;
#if PROF_ON && PROF_GEMM
  unsigned long long tk = 0, te = 0, t_a = 0, t_b = 0; unsigned nun = 0;
#define GP_T() wall_clock64()
#else
#define GP_T() 0ull
#endif
  for (;;) {
#if PROF_ON && PROF_GEMM
    t_a = GP_T();
#endif
    const bool has_next = S.next(ui + 1, nxt, tid);
    const char* nA = has_next ? nxt.A : cA; const char* nB = has_next ? nxt.B : cB;
#pragma unroll 1
    for (int t = 0; t < nt; t += 2) {
      const bool last = (t == nt - 2);
      const char* a1 = cA + (size_t)((t + 1 + KT0) & (nt - 1)) * kstep;
      const char* a2 = last ? nA + koff0 : cA + (size_t)((t + 2 + KT0) & (nt - 1)) * kstep; const char* b2 = last ? nB + koff0 : cB + (size_t)((t + 2 + KT0) & (nt - 1)) * kstep;
      const char* a3 = a2 + kstep; const char* b3 = b2 + kstep;
      GM_LDB(B0, 0, 0); GM_LDB(B1, 0, 1); GM_SCHED; GM_LDA(At, 0, 0); GM_STAGE(GM_SA(1, 1), a1, cao1);
      if (last && has_next) { cao0[0] = nxt.ao[0][0]; cao0[1] = nxt.ao[0][1]; cao1[0] = nxt.ao[1][0]; cao1[1] = nxt.ao[1][1]; }
      GM_WAIT_V(8); GM_WAIT_L(0); GM_BAR; GM_MMA(0, 0, At, B0); GM_MMA(0, 1, At, B1); GM_BAR; GM_SCHED;
      GM_LDA(At, 0, 1); GM_STAGE(GM_SB(0, 0), b2, voffB); GM_STAGE(GM_SB(0, 1), b2 + hstep, voffB); GM_STAGE(GM_SA(0, 0), a2, cao0);
      GM_WAIT_V(8); GM_WAIT_L(0); GM_BAR; GM_MMA(1, 0, At, B0); GM_MMA(1, 1, At, B1); GM_BAR; GM_SCHED;
      GM_LDB(B0, 1, 0); GM_LDB(B1, 1, 1); GM_SCHED; GM_LDA(At, 1, 0); GM_STAGE(GM_SA(0, 1), a2, cao1);
      GM_WAIT_V(8); GM_WAIT_L(0); GM_BAR; GM_MMA(0, 0, At, B0); GM_MMA(0, 1, At, B1); GM_BAR; GM_SCHED;
      GM_LDA(At, 1, 1); GM_STAGE(GM_SB(1, 0), b3, voffB); GM_STAGE(GM_SB(1, 1), b3 + hstep, voffB); GM_STAGE(GM_SA(1, 0), a3, cao0);
      GM_WAIT_V(8); GM_WAIT_L(0); GM_BAR; GM_MMA(1, 0, At, B0); GM_MMA(1, 1, At, B1); GM_BAR; GM_SCHED;
      if constexpr (Epi::HAS_MID) { if (t == nt / 2 - 2) E.mid(acc, est); }
    }
    if (wr == 0) GM_BAR;
#if PROF_ON && PROF_GEMM
    t_b = GP_T(); tk += t_b - t_a;
#endif
#pragma unroll
    for (int a = 0; a < 2; ++a)
#pragma unroll
      for (int b = 0; b < 2; ++b)
#pragma unroll
        for (int m = 0; m < 4; ++m)
#pragma unroll
          for (int n = 0; n < 2; ++n) asm volatile("" : "+v"(acc[a][b][m][n]));
    typename Epi::Pre pre;
    if (has_next) E.prefetch(pre, nxt, wr, wc, fr, fq);
    E(acc, cur, wr, wc, fr, fq);
#if PROF_ON && PROF_GEMM
    asm volatile("s_waitcnt vmcnt(0)" ::: "memory");
    te += GP_T() - t_b; ++nun;
#endif
    if (!has_next) break;
    E.init(acc, pre, est);
    cur = nxt; cA = nA; cB = nB; ++ui;
    if (wr == 1) GM_BAR;
  }
  GM_WAIT_V(0);
  GM_BAR;
#if PROF_ON && PROF_GEMM
  if (gprof && blockIdx.x == 0 && threadIdx.x == 0) { gprof[0] = tk; gprof[1] = te; gprof[2] = nun; }
#endif
#undef GM_SA
#undef GM_SB
#undef GM_STAGE
#undef GM_LDA
#undef GM_LDB
#undef GM_MMA
#undef GM_LO
#undef GM_HI
#undef GM_WAIT_V
#undef GM_WAIT_L
#undef GM_BAR
#undef GM_SCHED
}

__device__ __forceinline__ int unit_index(int i) {
  const int G = gridDim.x, c = blockIdx.x;
  return i * G + (c & 7) * (G >> 3) + (c >> 3);
}
}

__device__ __forceinline__ unsigned cvt_pk_bf16(float lo, float hi) { unsigned r; asm volatile("v_cvt_pk_bf16_f32 %0, %1, %2" : "=v"(r) : "v"(lo), "v"(hi)); return r; }
__device__ __forceinline__ u32x4 pack8(const f32x4& a, const f32x4& b) { u32x4 w; w.x = cvt_pk_bf16(a[0], a[1]); w.y = cvt_pk_bf16(a[2], a[3]); w.z = cvt_pk_bf16(b[0], b[1]); w.w = cvt_pk_bf16(b[2], b[3]); return w; }

__device__ __forceinline__ u32x2 pack8_fp8_nc(const f32x4& a, const f32x4& b) {
  int w0 = 0, w1 = 0;
  w0 = __builtin_amdgcn_cvt_pk_fp8_f32(a[0], a[1], w0, false); w0 = __builtin_amdgcn_cvt_pk_fp8_f32(a[2], a[3], w0, true);
  w1 = __builtin_amdgcn_cvt_pk_fp8_f32(b[0], b[1], w1, false); w1 = __builtin_amdgcn_cvt_pk_fp8_f32(b[2], b[3], w1, true);
  u32x2 w; w.x = (unsigned)w0; w.y = (unsigned)w1; return w;
}
__device__ __forceinline__ u32x2 pack8_fp8(const f32x4& a, const f32x4& b) { u32x2 w; w.x = pack4_fp8(a[0], a[1], a[2], a[3]); w.y = pack4_fp8(b[0], b[1], b[2], b[3]); return w; }

struct DenseSched {
  const char* A; const char* Bt; int nN, nunits;
  __device__ __forceinline__ bool next(int i, gm::Unit& u, int tid) const {
    int RA[2], CA[2];
#pragma unroll
    for (int q = 0; q < 2; ++q) gm::stage_rc(tid * 16 + q * 8192, RA[q], CA[q]);
    const int L = gm::unit_index(i); if (L >= nunits) return false;
    u.pm = L / nN; u.pn = L - u.pm * nN; u.e = 0; u.row0 = u.pm * 256; u.nrows = 256;
    u.A = A + (size_t)u.pm * (256 * 1024 * 2); u.B = Bt + (size_t)u.pn * (256 * 1024 * 2);
#pragma unroll
    for (int h = 0; h < 2; ++h)
#pragma unroll
      for (int j = 0; j < 2; ++j) u.ao[h][j] = (unsigned)((h * 128 + RA[j]) * 1024 + CA[j]) * 2u;
    return true;
  }
};
constexpr int TAB_OFF = 131072 + 1024;
__device__ __forceinline__ int load_unit_table(LAS unsigned char* smem, const int* ecnt, int upt_shift) {
  const int tid = my_tid(), lane = tid & 63;
  LAS int* tb = (LAS int*)(smem + TAB_OFF + 512);
  __syncthreads();
  if (tid < 64) {
    const int tot = (lane < 32) ? ecnt[lane] : 0;
    const int ntl = (tot + 255) >> 8;
    int sb = tot, st = ntl;
#pragma unroll
    for (int o = 1; o < 32; o <<= 1) { const int ub = __shfl_up(sb, o), ut = __shfl_up(st, o); if (lane >= o) { sb += ub; st += ut; } }
    if (lane < 32) { tb[lane] = st - ntl; tb[32 + lane] = ntl; tb[64 + lane] = sb - tot; tb[96 + lane] = tot; }
    if (lane == 31) tb[128] = st;
  }
  __syncthreads();
  const int ntiles = __builtin_amdgcn_readfirstlane(tb[128]);
  if (tid < 32) {
    const int L = gm::unit_index(tid), ti = L >> upt_shift;
    u32x4 e = (u32x4){0u, 0u, 0u, 0u};
    if (ti < ntiles) {
      int ex = 0;
#pragma unroll 1
      for (int q = 0; q < 32; ++q) ex = (tb[q] <= ti && ti < tb[q] + tb[32 + q]) ? q : ex;
      const int r = ti - tb[ex], tot = tb[96 + ex];
      e = (u32x4){(unsigned)ex, (unsigned)(tb[64 + ex] + r * 256), (unsigned)((tot - r * 256 < 256) ? tot - r * 256 : 256), (unsigned)(r * 256)};
    }
    *(LAS u32x4*)(smem + TAB_OFF + tid * 16) = e;
  }
  __syncthreads();
  return ntiles;
}
struct GuSched {
  const char* H2; const char* W; LAS unsigned char* tab; const int* rowtok; int ntiles;
  __device__ __forceinline__ bool next(int i, gm::Unit& u, int tid) const {
    int RA[2], CA[2];
#pragma unroll
    for (int q = 0; q < 2; ++q) gm::stage_rc(tid * 16 + q * 8192, RA[q], CA[q]);
    const int L = gm::unit_index(i); if (L >= ntiles * 8) return false;
    const int ti = L >> 3; u.pn = L & 7; u.pm = ti;
    const u32x4 ent = *(const LAS u32x4*)(tab + i * 16);
    u.e = __builtin_amdgcn_readfirstlane((int)ent.x);
    u.row0 = __builtin_amdgcn_readfirstlane((int)ent.y);
    u.nrows = __builtin_amdgcn_readfirstlane((int)ent.z);
    u.A = H2; u.B = W + (size_t)u.e * (2048 * 1024) + (size_t)u.pn * (256 * 1024);
#pragma unroll
    for (int h = 0; h < 2; ++h)
#pragma unroll
      for (int j = 0; j < 2; ++j) { const int rl = h * 128 + RA[j]; const int tok = rowtok[u.e * 32768 + (int)ent.w + (rl < u.nrows ? rl : 0)];
        u.ao[h][j] = (unsigned)(tok * 1024 + CA[j] * 2); }
    return true;
  }
};
struct DownSched {
  const char* ACT; const char* W; LAS unsigned char* tab; int ntiles;
  __device__ __forceinline__ bool next(int i, gm::Unit& u, int tid) const {
    int RA[2], CA[2];
#pragma unroll
    for (int q = 0; q < 2; ++q) gm::stage_rc(tid * 16 + q * 8192, RA[q], CA[q]);
    const int L = gm::unit_index(i); if (L >= ntiles * 4) return false;
    const int ti = L >> 2; u.pn = L & 3; u.pm = ti;
    const u32x4 ent = *(const LAS u32x4*)(tab + i * 16);
    u.e = __builtin_amdgcn_readfirstlane((int)ent.x);
    u.row0 = __builtin_amdgcn_readfirstlane((int)ent.y);
    u.nrows = __builtin_amdgcn_readfirstlane((int)ent.z);
    u.A = ACT + (size_t)u.row0 * 1024; u.B = W + (size_t)u.e * (1024 * 1024) + (size_t)u.pn * (256 * 1024);
#pragma unroll
    for (int h = 0; h < 2; ++h)
#pragma unroll
      for (int j = 0; j < 2; ++j) { const int rl = h * 128 + RA[j]; u.ao[h][j] = (unsigned)((rl < u.nrows ? rl : u.nrows - 1) * 1024 + CA[j] * 2); }
    return true;
  }
};

struct EpiProj {
  bf16_t *U, *Q, *KV; float* GATES; const float* ROPE;
  struct Pre {};
  __device__ __forceinline__ void prefetch(Pre&, const gm::Unit&, int, int, int, int) const {}
  struct State {}; static constexpr bool HAS_MID = false;
  __device__ __forceinline__ void init(f32x4 (&acc)[2][2][4][2], const Pre&, State&) const {
#pragma unroll
    for (int a = 0; a < 2; ++a)
#pragma unroll
      for (int b = 0; b < 2; ++b)
#pragma unroll
        for (int m = 0; m < 4; ++m)
#pragma unroll
          for (int n = 0; n < 2; ++n) acc[a][b][m][n] = (f32x4){0.f, 0.f, 0.f, 0.f};
  }
  __device__ __forceinline__ void operator()(const f32x4 (&acc)[2][2][4][2], const gm::Unit& u, int wr, int wc, int fr, int fq) const {
    const int pn = u.pn;
#pragma unroll
    for (int ai = 0; ai < 2; ++ai)
#pragma unroll
      for (int m = 0; m < 4; ++m) {
        const int row = u.pm * 256 + ai * 128 + wr * 64 + m * 16 + fr;
        const int s = row & 2047, b = row >> 11;
        if (pn < 4) {
          f32x4 o[2];
#pragma unroll
          for (int n = 0; n < 2; ++n)
#pragma unroll
            for (int j = 0; j < 4; j += 2) {
              const f32x2 gq = (f32x2){acc[ai][1][m][n][j], acc[ai][1][m][n][j + 1]} * -1.4426950408889634f;
              f32x2 e; e[0] = __builtin_amdgcn_exp2f(gq[0]); e[1] = __builtin_amdgcn_exp2f(gq[1]);
              const f32x2 den = e + 1.0f;
              f32x2 r; r[0] = __builtin_amdgcn_rcpf(den[0]); r[1] = __builtin_amdgcn_rcpf(den[1]);
              const f32x2 res = (f32x2){acc[ai][0][m][n][j], acc[ai][0][m][n][j + 1]} * r;
              o[n][j] = res[0]; o[n][j + 1] = res[1];
            }
          *(u32x4*)(U + (size_t)row * 512 + pn * 128 + wc * 32 + 8 * fq) = pack8(o[0], o[1]);
        } else if (pn < 9) {
          const bool isq = pn < 6;
#pragma unroll
          for (int bj = 0; bj < 2; ++bj) {
            f32x4 v[2] = {acc[ai][bj][m][0], acc[ai][bj][m][1]};
            const bool dorope = (isq || bj == 0) && ((wc & 1) == 0);
            if (dorope) {
              const f32x4 c0 = *(const f32x4*)(ROPE + s * 16), c1 = *(const f32x4*)(ROPE + s * 16 + 4);
              const f32x4 s0 = *(const f32x4*)(ROPE + s * 16 + 8), s1 = *(const f32x4*)(ROPE + s * 16 + 12);
              const f32x4 cs[2] = {c0, c1}, sn[2] = {s0, s1};
              const float sgn = (fq == 0) ? -1.0f : 1.0f;
#pragma unroll
              for (int n = 0; n < 2; ++n)
#pragma unroll
                for (int j = 0; j < 4; ++j) {
                  const auto sw = __builtin_amdgcn_permlane16_swap(__float_as_uint(v[n][j]), __float_as_uint(v[n][j]), false, false);
                  const float other = __uint_as_float((fq & 1) ? sw[0] : sw[1]);
                  const float r = v[n][j] * cs[n][j] + sgn * other * sn[n][j];
                  v[n][j] = (fq < 2) ? r : v[n][j];
                }
            }
            if (isq) {
              v[0] = v[0] * 0.18033688011112042f; v[1] = v[1] * 0.18033688011112042f;
              *(u32x4*)(Q + (size_t)row * 512 + (pn - 4) * 256 + bj * 128 + wc * 32 + 8 * fq) = pack8(v[0], v[1]);
            } else {
              const int idx = (pn - 6) * 2 + bj, g = wc >> 1, hd0 = (wc & 1) * 32 + 8 * fq;
              *(u32x4*)(KV + (size_t)idx * (16 * 2 * 2048 * 64) + ((size_t)(b * 2 + g) * 2048 + s) * 64 + hd0) = pack8(v[0], v[1]);
            }
          }
        } else {
          if (wc == 0 && fq < 3) {
#pragma unroll
            for (int n = 0; n < 2; ++n) {
              f32x4 o;
#pragma unroll
              for (int j = 0; j < 4; ++j) o[j] = sigmoidf_(acc[ai][0][m][n][j]);
              *(f32x4*)(GATES + (size_t)row * 24 + 8 * fq + 4 * n) = o;
            }
          }
        }
      }
  }
};
struct EpiOut {
  bf16_t* X1; const float* MOD; const float* x; const float* SSQ;
  struct Pre { const float* rowp; };
  struct State { float rstd[2][4]; };
  static constexpr bool HAS_MID = true;
  __device__ __forceinline__ void prefetch(Pre& q, const gm::Unit& u, int wr, int wc, int fr, int fq) const { q.rowp = SSQ + (size_t)(u.pm * 256 + wr * 64 + fr) * 2; }
  __device__ __forceinline__ void init(f32x4 (&acc)[2][2][4][2], const Pre& q, State& st) const {
#pragma unroll
    for (int ai = 0; ai < 2; ++ai)
#pragma unroll
      for (int m = 0; m < 4; ++m) { const f32x2 s2 = *(const f32x2*)(q.rowp + (ai * 128 + m * 16) * 2); st.rstd[ai][m] = rsqrtf((s2[0] + s2[1]) * (1.0f / 512.0f) + NORM_EPS); }
#pragma unroll
    for (int a = 0; a < 2; ++a)
#pragma unroll
      for (int b = 0; b < 2; ++b)
#pragma unroll
        for (int m = 0; m < 4; ++m)
#pragma unroll
          for (int n = 0; n < 2; ++n) acc[a][b][m][n] = (f32x4){0.f, 0.f, 0.f, 0.f};
  }
  __device__ __forceinline__ void mid(f32x4 (&acc)[2][2][4][2], const State& st) const {
#pragma unroll
    for (int a = 0; a < 2; ++a)
#pragma unroll
      for (int b = 0; b < 2; ++b)
#pragma unroll
        for (int m = 0; m < 4; ++m)
#pragma unroll
          for (int n = 0; n < 2; ++n) acc[a][b][m][n] = acc[a][b][m][n] * st.rstd[a][m];
  }
  __device__ __forceinline__ void operator()(const f32x4 (&acc)[2][2][4][2], const gm::Unit& u, int wr, int wc, int fr, int fq) const {
#pragma unroll
    for (int bj = 0; bj < 2; ++bj) {
      const int col0 = u.pn * 256 + bj * 128 + wc * 32 + 8 * fq;
      const int b = (u.pm * 256) >> 11;
      const f32x4 g0 = *(const f32x4*)(MOD + b * 6144 + 2048 + col0), g1 = *(const f32x4*)(MOD + b * 6144 + 2048 + col0 + 4);
#pragma unroll
      for (int ai = 0; ai < 2; ++ai) {
#pragma unroll
        for (int m2 = 0; m2 < 4; m2 += 2) {
          f32x4 xa[2], xb[2];
#pragma unroll
          for (int q = 0; q < 2; ++q) {
            const int row = u.pm * 256 + ai * 128 + wr * 64 + (m2 + q) * 16 + fr;
            xa[q] = *(const f32x4*)(x + (size_t)row * 1024 + col0); xb[q] = *(const f32x4*)(x + (size_t)row * 1024 + col0 + 4);
          }
#pragma unroll
          for (int q = 0; q < 2; ++q) {
            const int row = u.pm * 256 + ai * 128 + wr * 64 + (m2 + q) * 16 + fr;
            *(u32x4*)(X1 + (size_t)row * 1024 + col0) = pack8(xa[q] + acc[ai][bj][m2 + q][0] * g0, xb[q] + acc[ai][bj][m2 + q][1] * g1);
          }
        }
      }
    }
  }
};
struct EpiGU {
  unsigned char* ACT; const float* bg; const float* bu;
  struct Pre { f32x4 b[2][2]; };
  __device__ __forceinline__ void prefetch(Pre& q, const gm::Unit& u, int wr, int wc, int fr, int fq) const {
    const int f0 = u.pn * 128 + wc * 32 + 8 * fq;
    q.b[0][0] = *(const f32x4*)(bg + u.e * 1024 + f0); q.b[0][1] = *(const f32x4*)(bg + u.e * 1024 + f0 + 4);
    q.b[1][0] = *(const f32x4*)(bu + u.e * 1024 + f0); q.b[1][1] = *(const f32x4*)(bu + u.e * 1024 + f0 + 4);
  }
  struct State {}; static constexpr bool HAS_MID = false;
  __device__ __forceinline__ void init(f32x4 (&acc)[2][2][4][2], const Pre& q, State&) const {
#pragma unroll
    for (int a = 0; a < 2; ++a)
#pragma unroll
      for (int bj = 0; bj < 2; ++bj)
#pragma unroll
        for (int m = 0; m < 4; ++m)
#pragma unroll
          for (int n = 0; n < 2; ++n) acc[a][bj][m][n] = q.b[bj][n] * 512.0f;
  }
  __device__ __forceinline__ void operator()(const f32x4 (&acc)[2][2][4][2], const gm::Unit& u, int wr, int wc, int fr, int fq) const {
    const int f0 = u.pn * 128 + wc * 32 + 8 * fq;
#pragma unroll
    for (int ai = 0; ai < 2; ++ai)
#pragma unroll
      for (int m = 0; m < 4; ++m) {
        const int rl = ai * 128 + wr * 64 + m * 16 + fr;
        f32x4 o[2];
#pragma unroll
        for (int n = 0; n < 2; ++n)
#pragma unroll
          for (int j = 0; j < 4; j += 2) {
            f32x2 g, uu;
            g[0] = __builtin_amdgcn_fmed3f(acc[ai][0][m][n][j], -3.0e38f, 7.0f * 512.0f);     g[1] = __builtin_amdgcn_fmed3f(acc[ai][0][m][n][j + 1], -3.0e38f, 7.0f * 512.0f);
            uu[0] = __builtin_amdgcn_fmed3f(acc[ai][1][m][n][j], -7.0f * 512.0f, 7.0f * 512.0f); uu[1] = __builtin_amdgcn_fmed3f(acc[ai][1][m][n][j + 1], -7.0f * 512.0f, 7.0f * 512.0f);
            const f32x2 ea = g * (-1.702f * 1.4426950408889634f / 512.0f);
            f32x2 e; e[0] = __builtin_amdgcn_exp2f(ea[0]); e[1] = __builtin_amdgcn_exp2f(ea[1]);
            const f32x2 den = e + 1.0f;
            f32x2 r; r[0] = __builtin_amdgcn_rcpf(den[0]); r[1] = __builtin_amdgcn_rcpf(den[1]);
            const f32x2 res = (g * r) * (uu * (8.0f / 262144.0f) + (8.0f / 512.0f));
            o[n][j] = res[0]; o[n][j + 1] = res[1];
          }
        if (rl < u.nrows) *(u32x2*)(ACT + (size_t)(u.row0 + rl) * 1024 + f0) = pack8_fp8_nc(o[0], o[1]);
      }
  }
};
struct EpiDown {
  unsigned char* Y; const float* bd;
  struct Pre { f32x4 b[2][2]; };
  __device__ __forceinline__ void prefetch(Pre& q, const gm::Unit& u, int wr, int wc, int fr, int fq) const {
#pragma unroll
    for (int bj = 0; bj < 2; ++bj) {
      const int col0 = u.pn * 256 + bj * 128 + wc * 32 + 8 * fq;
      q.b[bj][0] = *(const f32x4*)(bd + u.e * 1024 + col0); q.b[bj][1] = *(const f32x4*)(bd + u.e * 1024 + col0 + 4);
    }
  }
  struct State {}; static constexpr bool HAS_MID = false;
  __device__ __forceinline__ void init(f32x4 (&acc)[2][2][4][2], const Pre& q, State&) const {
#pragma unroll
    for (int bj = 0; bj < 2; ++bj)
#pragma unroll
      for (int a = 0; a < 2; ++a)
#pragma unroll
        for (int m = 0; m < 4; ++m) { acc[a][bj][m][0] = q.b[bj][0] * 256.0f; acc[a][bj][m][1] = q.b[bj][1] * 256.0f; }
  }
  __device__ __forceinline__ void operator()(const f32x4 (&acc)[2][2][4][2], const gm::Unit& u, int wr, int wc, int fr, int fq) const {
#pragma unroll
    for (int bj = 0; bj < 2; ++bj) {
      const int col0 = u.pn * 256 + bj * 128 + wc * 32 + 8 * fq;
#pragma unroll
      for (int ai = 0; ai < 2; ++ai)
#pragma unroll
        for (int m = 0; m < 4; ++m) {
          const int rl = ai * 128 + wr * 64 + m * 16 + fr;
          if (rl < u.nrows) *(u32x2*)(Y + (size_t)(u.row0 + rl) * 1024 + col0) = pack8_fp8(acc[ai][bj][m][0] * (1.0f / 16.0f), acc[ai][bj][m][1] * (1.0f / 16.0f));
        }
    }
  }
};

__device__ __forceinline__ void compress_item(const Params& p, LAS unsigned char* smem, int it) {
  const int tid = my_tid(), wid = __builtin_amdgcn_readfirstlane(tid >> 6), lane = tid & 63;
  unsigned char* ws = p.ws; unsigned char* dout = (unsigned char*)p.out;
  {
    const int kv = it >> 6, bg = (it >> 1) & 31, mh = it & 1;
    const bf16_t* X = (const bf16_t*)(ws + WS_KV) + (size_t)kv * (16 * 2 * 2048 * 64) + (size_t)bg * 2048 * 64;
    const bf16_t* W1T = (const bf16_t*)(dout + (kv ? DO_CV1 : DO_CK1));
    const bf16_t* W2T = (const bf16_t*)(dout + (kv ? DO_CV2 : DO_CK2));
    const float* b1 = (const float*)(ws + WS_BOOK + BK_CB1) + kv * 128;
    bf16_t* OUT = (bf16_t*)(ws + WS_BOOK + (kv ? BK_VCMP : BK_KCMP)) + (size_t)bg * 128 * 64;
    const int fr = lane & 15, fq = lane >> 4;
    f32x4 acc[4];
#pragma unroll
    for (int mt = 0; mt < 4; ++mt) acc[mt] = (f32x4){0.f, 0.f, 0.f, 0.f};
    constexpr int ASTR = 528, ABUF = 64 * ASTR;
    LAS unsigned char* abuf = smem + 32768;
    const bf16_t* arow_g = X + (size_t)(64 * mh + (tid >> 5)) * 1024 + (tid & 31) * 8;
    const bf16_t* brow = W1T + (size_t)(16 * wid + fr) * 2048 + 8 * fq;
    u32x4 an[4]; bf16x8 bc[8], bn[8];
    __syncthreads();
#pragma unroll
    for (int i = 0; i < 4; ++i) an[i] = *(const u32x4*)(arow_g + (size_t)i * 16 * 1024);
#pragma unroll
    for (int s = 0; s < 8; ++s) bc[s] = *(const bf16x8*)(brow + 32 * s);
#pragma unroll
    for (int i = 0; i < 4; ++i) *(LAS u32x4*)(abuf + ((tid >> 5) + 16 * i) * ASTR + (tid & 31) * 16) = an[i];
    __syncthreads();
#pragma unroll 1
    for (int ch = 0; ch < 8; ++ch) {
      if (ch < 7) {
#pragma unroll
        for (int i = 0; i < 4; ++i) an[i] = *(const u32x4*)(arow_g + (size_t)i * 16 * 1024 + (ch + 1) * 256);
#pragma unroll
        for (int s = 0; s < 8; ++s) bn[s] = *(const bf16x8*)(brow + (ch + 1) * 256 + 32 * s);
      }
      LAS unsigned char* ab = abuf + (ch & 1) * ABUF;
#pragma unroll
      for (int s = 0; s < 8; ++s)
#pragma unroll
        for (int mt = 0; mt < 4; ++mt) {
          const bf16x8 af = *(const LAS bf16x8*)(ab + (16 * mt + fr) * ASTR + (32 * s + 8 * fq) * 2);
          acc[mt] = __builtin_amdgcn_mfma_f32_16x16x32_bf16(af, bc[s], acc[mt], 0, 0, 0);
        }
      if (ch < 7) {
#pragma unroll
        for (int i = 0; i < 4; ++i) *(LAS u32x4*)(abuf + ((ch + 1) & 1) * ABUF + ((tid >> 5) + 16 * i) * ASTR + (tid & 31) * 16) = an[i];
#pragma unroll
        for (int s = 0; s < 8; ++s) bc[s] = bn[s];
      }
      __syncthreads();
    }
    LAS bf16_t* hid = (LAS bf16_t*)smem;
    __syncthreads();
    {
      const float bb = b1[16 * wid + fr];
#pragma unroll
      for (int mt = 0; mt < 4; ++mt)
#pragma unroll
        for (int j = 0; j < 4; ++j) { const float v = acc[mt][j] + bb; hid[(16 * mt + 4 * fq + j) * 136 + 16 * wid + fr] = f2bf(v * sigmoidf_(v)); }
    }
    __syncthreads();
    {
      const int mt = wid >> 1;
#pragma unroll
      for (int q = 0; q < 2; ++q) {
        const int nt = 2 * (wid & 1) + q;
        f32x4 o = (f32x4){0.f, 0.f, 0.f, 0.f};
#pragma unroll
        for (int s = 0; s < 4; ++s) {
          const bf16x8 af = *(const LAS bf16x8*)(hid + (16 * mt + fr) * 136 + 32 * s + 8 * fq);
          const bf16x8 bf = *(const bf16x8*)(W2T + (size_t)(16 * nt + fr) * 128 + 32 * s + 8 * fq);
          o = __builtin_amdgcn_mfma_f32_16x16x32_bf16(af, bf, o, 0, 0, 0);
        }
#pragma unroll
        for (int j = 0; j < 4; ++j) { const int c = 64 * mh + 16 * mt + 4 * fq + j; if (c < 127) OUT[(size_t)c * 64 + 16 * nt + fr] = f2bf(o[j]); }
      }
    }
    if (mh == 1 && tid < 64) OUT[(size_t)127 * 64 + tid] = 0;
  }
}
__device__ __forceinline__ void conv_item(const Params& p, LAS unsigned char* smem, int it64) {
  const int tid = my_tid(), wid = __builtin_amdgcn_readfirstlane(tid >> 6), lane = tid & 63;
  unsigned char* ws = p.ws;
  {
    const bf16_t* U = (const bf16_t*)(ws + WS_U);
    bf16_t* MIX = (bf16_t*)(ws + WS_MIX);
    LAS float* ybuf = (LAS float*)smem;
    const int cp = tid & 255, thalf = tid >> 8;
    f32x2 w2[31];
#pragma unroll
    for (int k = 0; k < 31; ++k) w2[k] = *(const f32x2*)(p.conv_w + k * 512 + 2 * cp);
    const f32x2 cb2 = *(const f32x2*)(p.conv_b + 2 * cp);
    f32x4 lg[2], lb[2], og[2];
#pragma unroll
    for (int q = 0; q < 2; ++q) { lg[q] = *(const f32x4*)(p.conv_ln_g + lane * 8 + 4 * q); lb[q] = *(const f32x4*)(p.conv_ln_b + lane * 8 + 4 * q); og[q] = *(const f32x4*)(p.out_norm_conv + lane * 8 + 4 * q); }
    u32x4 rv[8];
    auto load_rows = [&](int itp) {
      const int t0 = itp * 32, s0 = t0 & 2047;
#pragma unroll
      for (int r = 0; r < 8; ++r) {
        const int seg = tid + r * NTHR, row = seg >> 6;
        const int rr = (s0 - 30 + row >= 0 && seg < 62 * 64) ? (t0 - 30 + row) : t0;
        rv[r] = *(const u32x4*)((const unsigned char*)U + (size_t)rr * 1024 + (seg & 63) * 16);
      }
    };
    load_rows(it64 * 2);
#pragma unroll
    for (int ps = 0; ps < 2; ++ps) {
      const int it = it64 * 2 + ps;
      const int t0 = it * 32, s0 = t0 & 2047;
      LAS unsigned char* ut = smem + 65536;
      __syncthreads();
      {
#pragma unroll
        for (int r = 0; r < 8; ++r) {
          const int seg = tid + r * NTHR, row = seg >> 6;
          if (seg < 62 * 64) *(LAS u32x4*)(ut + seg * 16) = (s0 - 30 + row >= 0) ? rv[r] : (u32x4){0u, 0u, 0u, 0u};
        }
      }
      if (ps == 0) load_rows(it + 1);
      __syncthreads();
      unsigned upk[46];
#pragma unroll
      for (int i = 0; i < 46; ++i) upk[i] = *(const LAS unsigned*)(ut + (thalf * 16 + i) * 1024 + cp * 4);
      __builtin_amdgcn_sched_barrier(0);
      f32x2 u2[46];
#pragma unroll
      for (int i = 0; i < 46; ++i) u2[i] = (f32x2){__uint_as_float(upk[i] << 16), __uint_as_float(upk[i] & 0xffff0000u)};
#pragma unroll
      for (int i = 0; i < 16; ++i) {
        f32x2 y = cb2;
#pragma unroll
        for (int k = 0; k < 31; ++k) y += w2[k] * u2[i + k];
        *(LAS f32x2*)(ybuf + (thalf * 16 + i) * 512 + 2 * cp) = y;
      }
      __syncthreads();
#pragma unroll
      for (int q4 = 0; q4 < 4; ++q4) {
        const int i = wid * 4 + q4, t = t0 + i;
        const f32x4 y0 = *(const LAS f32x4*)(ybuf + i * 512 + lane * 8), y1 = *(const LAS f32x4*)(ybuf + i * 512 + lane * 8 + 4);
        const float mean = wave_sum((y0[0] + y0[1]) + (y0[2] + y0[3]) + (y1[0] + y1[1]) + (y1[2] + y1[3])) * (1.0f / 512.0f);
        const f32x4 d0 = y0 - mean, d1 = y1 - mean;
        const float var = wave_sum(d0[0] * d0[0] + d0[1] * d0[1] + d0[2] * d0[2] + d0[3] * d0[3] + d1[0] * d1[0] + d1[1] * d1[1] + d1[2] * d1[2] + d1[3] * d1[3]) * (1.0f / 512.0f);
        const float rs = rsqrtf(var + NORM_EPS);
        f32x4 v0 = d0 * rs * lg[0] + lb[0], v1 = d1 * rs * lg[1] + lb[1];
#pragma unroll
        for (int e = 0; e < 4; ++e) { v0[e] = v0[e] * sigmoidf_(v0[e]); v1[e] = v1[e] * sigmoidf_(v1[e]); }
        const float ms = wave_sum(v0[0] * v0[0] + v0[1] * v0[1] + v0[2] * v0[2] + v0[3] * v0[3] + v1[0] * v1[0] + v1[1] * v1[1] + v1[2] * v1[2] + v1[3] * v1[3]) * (1.0f / 512.0f);
        const float r2 = rsqrtf(ms + NORM_EPS);
        v0 = v0 * r2 * og[0]; v1 = v1 * r2 * og[1];
        *(u32x4*)(MIX + (size_t)t * 1024 + lane * 8) = pack8(v0, v1);
      }
    }
  }
}

typedef float f32x16 __attribute__((ext_vector_type(16)));
typedef short s16x4 __attribute__((ext_vector_type(4)));
typedef __attribute__((address_space(3))) s16x4 lds_s16x4;
constexpr int AT_KSTR = 144, AT_VSTR = 192, AT_VOFF = 64 * AT_KSTR, AT_TILE = 64 * AT_KSTR + 64 * AT_VSTR;

__device__ __forceinline__ bf16x8 cat4(s16x4 a, s16x4 b) { bf16x8 r; r[0] = a[0]; r[1] = a[1]; r[2] = a[2]; r[3] = a[3]; r[4] = b[0]; r[5] = b[1]; r[6] = b[2]; r[7] = b[3]; return r; }

template <class MaskF>
__device__ __forceinline__ void attn_tile(LAS unsigned char* buf, const bf16x8 (&qf)[4], f32x16 (&O)[2], float& m, float& l, int lane, bool need_mask, bool lane_on, const MaskF& kmask) {
  const int h = lane >> 5, l31 = lane & 31;
  f32x16 s[2];
#pragma unroll
  for (int kb = 0; kb < 2; ++kb)
#pragma unroll
    for (int r = 0; r < 16; ++r) s[kb][r] = 0.f;
  bf16x8 kf[4][2];
#pragma unroll
  for (int ks = 0; ks < 4; ++ks)
#pragma unroll
    for (int kb = 0; kb < 2; ++kb) kf[ks][kb] = *(const LAS bf16x8*)(buf + (kb * 32 + l31) * AT_KSTR + (2 * ks + h) * 16);
  asm volatile("s_waitcnt lgkmcnt(0)" ::: "memory");
  __builtin_amdgcn_sched_barrier(0);
#pragma unroll
  for (int ks = 0; ks < 4; ++ks)
#pragma unroll
    for (int kb = 0; kb < 2; ++kb) s[kb] = __builtin_amdgcn_mfma_f32_32x32x16_bf16(kf[ks][kb], qf[ks], s[kb], 0, 0, 0);
  const int blk = (lane >> 4) & 1, q = (lane & 15) >> 2, pp = lane & 3;
  LAS unsigned char* vbase = buf + AT_VOFF + (4 * h + q) * AT_VSTR + (16 * blk + 4 * pp) * 2;
  bf16x8 vf[2][2][2];
#pragma unroll
  for (int kb = 0; kb < 2; ++kb)
#pragma unroll
    for (int sx = 0; sx < 2; ++sx)
#pragma unroll
      for (int dt = 0; dt < 2; ++dt) {
        if (kb == 1 && sx == 1 && dt == 1) continue;
        const s16x4 va = __builtin_amdgcn_ds_read_tr16_b64_v4i16((lds_s16x4*)(vbase + (32 * kb + 16 * sx) * AT_VSTR + dt * 64));
        const s16x4 vb = __builtin_amdgcn_ds_read_tr16_b64_v4i16((lds_s16x4*)(vbase + (32 * kb + 16 * sx + 8) * AT_VSTR + dt * 64));
        vf[kb][sx][dt] = cat4(va, vb);
      }
  __builtin_amdgcn_sched_barrier(0);
  if (need_mask) {
#pragma unroll
    for (int kb = 0; kb < 2; ++kb)
#pragma unroll
      for (int r = 0; r < 16; ++r) s[kb][r] = kmask(kb, r) ? s[kb][r] : -1e30f;
  }
  float mx = s[0][0];
#pragma unroll
  for (int kb = 0; kb < 2; ++kb)
#pragma unroll
    for (int r = 0; r < 16; ++r) mx = fmaxf(mx, s[kb][r]);
  mx = xmax32(mx);
  mx = lane_on ? mx : -1e30f;
  const float mn = fmaxf(m, mx);
  const float alpha = __builtin_amdgcn_exp2f(m - mn);
  m = mn;
  const float mexp = lane_on ? mn : 3.0e38f;
  f32x2 ls2 = (f32x2){0.f, 0.f};
#pragma unroll
  for (int kb = 0; kb < 2; ++kb)
#pragma unroll
    for (int r = 0; r < 16; r += 2) {
      const f32x2 d = (f32x2){s[kb][r], s[kb][r + 1]} - mexp;
      f32x2 e; e[0] = __builtin_amdgcn_exp2f(d[0]); e[1] = __builtin_amdgcn_exp2f(d[1]);
      s[kb][r] = e[0]; s[kb][r + 1] = e[1];
      ls2 += e;
    }
  l = l * alpha + (ls2[0] + ls2[1]);
#pragma unroll
  for (int dt = 0; dt < 2; ++dt) O[dt] = O[dt] * alpha;
  bf16x8 pb[2][2];
#pragma unroll
  for (int kb = 0; kb < 2; ++kb)
#pragma unroll
    for (int sx = 0; sx < 2; ++sx) {
      u32x4 w; w.x = cvt_pk_bf16(s[kb][8 * sx + 0], s[kb][8 * sx + 1]); w.y = cvt_pk_bf16(s[kb][8 * sx + 2], s[kb][8 * sx + 3]);
      w.z = cvt_pk_bf16(s[kb][8 * sx + 4], s[kb][8 * sx + 5]); w.w = cvt_pk_bf16(s[kb][8 * sx + 6], s[kb][8 * sx + 7]);
      pb[kb][sx] = __builtin_bit_cast(bf16x8, w);
    }
  asm volatile("s_waitcnt lgkmcnt(0)" ::: "memory");
  {
    const s16x4 va = __builtin_amdgcn_ds_read_tr16_b64_v4i16((lds_s16x4*)(vbase + (32 + 16) * AT_VSTR + 64));
    const s16x4 vb = __builtin_amdgcn_ds_read_tr16_b64_v4i16((lds_s16x4*)(vbase + (32 + 16 + 8) * AT_VSTR + 64));
    vf[1][1][1] = cat4(va, vb);
  }
#pragma unroll
  for (int kb = 0; kb < 2; ++kb)
#pragma unroll
    for (int sx = 0; sx < 2; ++sx)
#pragma unroll
      for (int dt = 0; dt < 2; ++dt) O[dt] = __builtin_amdgcn_mfma_f32_32x32x16_bf16(vf[kb][sx][dt], pb[kb][sx], O[dt], 0, 0, 0);
}

template <bool SELECTED>
__device__ __forceinline__ void attn_item(const Params& p, LAS unsigned char* smem, int si) {
  const int tid = my_tid(), wid = __builtin_amdgcn_readfirstlane(tid >> 6), lane = tid & 63, h = lane >> 5, l31 = lane & 31;
  const int n = wid & 3, th = wid >> 2;
  unsigned char* ws = p.ws;
  const bf16_t* Q = (const bf16_t*)(ws + WS_Q);
  const bf16_t* KB = (const bf16_t*)(ws + WS_KV) + (size_t)(SELECTED ? 2 : 4) * (16 * 2 * 2048 * 64);
  const bf16_t* VB = (const bf16_t*)(ws + WS_KV) + (size_t)(SELECTED ? 3 : 5) * (16 * 2 * 2048 * 64);
  const float* GATES = (const float*)(ws + WS_GATES);
  const unsigned* SEL = (const unsigned*)(ws + WS_BOOK + BK_SEL);
  bf16_t* OUT = (bf16_t*)(ws + (SELECTED ? WS_OS : WS_OW));
  {
    const int cur = 31 - (si >> 5), bg = si & 31, b = bg >> 1, g = bg & 1;
    const int t = cur * 64 + th * 32 + l31, tok = b * 2048 + t, head = g * 4 + n;
    const char* kg = (const char*)(KB + (size_t)bg * 2048 * 64);
    const char* vg = (const char*)(VB + (size_t)bg * 2048 * 64);
    u32x4 kA = *(const u32x4*)(kg + (size_t)cur * 8192 + tid * 16), vA = *(const u32x4*)(vg + (size_t)cur * 8192 + tid * 16);
    bf16x8 qf[4];
#pragma unroll
    for (int ks = 0; ks < 4; ++ks) qf[ks] = *(const bf16x8*)(Q + (size_t)tok * 512 + head * 64 + 16 * ks + 8 * h);
    float gsc = GATES[(size_t)tok * 24 + head * 3 + (SELECTED ? 1 : 2)];
    __builtin_amdgcn_sched_barrier(0);
    unsigned mysel = 0u, tiles;
    if (SELECTED) {
      mysel = SEL[bg * 2048 + t];
      tiles = __builtin_amdgcn_readfirstlane(wave_or(SEL[bg * 2048 + cur * 64 + lane]));
    } else {
      const int jmin = cur - 8 > 0 ? cur - 8 : 0;
      tiles = ((cur == 31) ? 0xffffffffu : ((1u << (cur + 1)) - 1u)) & ~((1u << jmin) - 1u);
    }
    f32x16 O[2];
#pragma unroll
    for (int dt = 0; dt < 2; ++dt)
#pragma unroll
      for (int r = 0; r < 16; ++r) O[dt][r] = 0.f;
    float m = -1e30f, l = 0.f;
    auto pop = [&]() -> int { if (tiles == 0u) return -1; const int jn = 31 - __builtin_clz(tiles); tiles &= ~(1u << jn); return jn; };
    int j = cur;
    tiles &= ~(1u << j);
    int j1 = pop();
    int j2 = (j1 >= 0) ? pop() : -1;
    const int kwo = (tid >> 3) * AT_KSTR + (tid & 7) * 16, vwo = AT_VOFF + (tid >> 3) * AT_VSTR + (tid & 7) * 16;
    u32x4 kB = kA, vB = vA;
    *(LAS u32x4*)(smem + kwo) = kA; *(LAS u32x4*)(smem + vwo) = vA;
    if (j1 >= 0) { kA = *(const u32x4*)(kg + (size_t)j1 * 8192 + tid * 16); vA = *(const u32x4*)(vg + (size_t)j1 * 8192 + tid * 16); }
    if (j2 >= 0) { kB = *(const u32x4*)(kg + (size_t)j2 * 8192 + tid * 16); vB = *(const u32x4*)(vg + (size_t)j2 * 8192 + tid * 16); }
    __syncthreads();
    u32x4 ocr[4];
    if (SELECTED) {
      const size_t rowo = ((size_t)(b * 2048 + cur * 64 + (tid >> 3)) * 512 + g * 256 + (tid & 7) * 8) * 2;
#pragma unroll
      for (int i = 0; i < 4; ++i) ocr[i] = *(const u32x4*)(ws + WS_OC + rowo + i * 128);
    }
#pragma unroll
    for (int ks = 0; ks < 4; ++ks) asm volatile("" : "+v"(qf[ks]));
    asm volatile("" : "+v"(mysel));
    asm volatile("" : "+v"(gsc));
    int cb = 0;
#define ATT_HALF(KX, VX)                                                                                                                         \
    {                                                                                                                                            \
      LAS unsigned char* buf = smem + cb * AT_TILE;                                                                                              \
      if (SELECTED) {                                                                                                                            \
        const bool selj = (mysel >> j) & 1u;                                                                                                     \
        const int kbase = j * 64 + 4 * h;                                                                                                        \
        attn_tile(buf, qf, O, m, l, lane, j == cur, selj, [&](int kb, int r) { return kbase + 32 * kb + (r & 3) + 8 * (r >> 2) <= t; });        \
      } else {                                                                                                                                   \
        const int kbase = j * 64 + 4 * h;                                                                                                        \
        const bool nm = (j == cur) || (j <= cur - 8);                                                                                            \
        attn_tile(buf, qf, O, m, l, lane, nm, true, [&](int kb, int r) { const int key = kbase + 32 * kb + (r & 3) + 8 * (r >> 2); return key <= t && key > t - 512; }); \
      }                                                                                                                                          \
      if (j1 >= 0) { *(LAS u32x4*)(smem + (cb ^ 1) * AT_TILE + kwo) = KX; *(LAS u32x4*)(smem + (cb ^ 1) * AT_TILE + vwo) = VX; }                 \
      __syncthreads();                                                                                                                           \
      if (j1 < 0) break;                                                                                                                         \
      j = j1; j1 = j2; j2 = pop(); cb ^= 1;                                                                                                      \
      if (j2 >= 0) { KX = *(const u32x4*)(kg + (size_t)j2 * 8192 + tid * 16); VX = *(const u32x4*)(vg + (size_t)j2 * 8192 + tid * 16); }         \
    }
    for (;;) {
      ATT_HALF(kA, vA)
      ATT_HALF(kB, vB)
    }
#undef ATT_HALF
    const float lt = xsum32(l, l);
    const float sc = gsc / lt;
    if (!SELECTED) {
      LAS unsigned char* ost = smem + wid * (32 * 144);
#pragma unroll
      for (int dt = 0; dt < 2; ++dt)
#pragma unroll
        for (int r4 = 0; r4 < 4; ++r4) {
          u32x2 w; w.x = cvt_pk_bf16(O[dt][4 * r4 + 0] * sc, O[dt][4 * r4 + 1] * sc); w.y = cvt_pk_bf16(O[dt][4 * r4 + 2] * sc, O[dt][4 * r4 + 3] * sc);
          *(LAS u32x2*)(ost + l31 * 144 + (32 * dt + 8 * r4 + 4 * h) * 2) = w;
        }
#pragma unroll
      for (int i = 0; i < 4; ++i) {
        const int tl = i * 8 + (lane >> 3), sg = lane & 7;
        *(u32x4*)(OUT + (size_t)(b * 2048 + cur * 64 + th * 32 + tl) * 512 + head * 64 + sg * 8) = *(const LAS u32x4*)(ost + tl * 144 + sg * 16);
      }
    } else {
      LAS unsigned char* combb = smem + 2 * AT_TILE + 1024;
      LAS unsigned char* outb = smem;
      {
        const int tl = tid >> 3, s8 = tid & 7;
#pragma unroll
        for (int i = 0; i < 4; ++i) *(LAS u32x4*)(combb + tl * 528 + (s8 + 8 * i) * 16) = ocr[i];
      }
      __syncthreads();
      const int tl = th * 32 + l31;
      float ssq = 0.f;
#pragma unroll
      for (int dt = 0; dt < 2; ++dt)
#pragma unroll
        for (int r4 = 0; r4 < 4; ++r4) {
          const int c = n * 64 + 32 * dt + 8 * r4 + 4 * h;
          const u32x2 cw = *(const LAS u32x2*)(combb + tl * 528 + c * 2);
          const f32x4 cb = (f32x4){__uint_as_float(cw.x << 16), __uint_as_float(cw.x & 0xffff0000u), __uint_as_float(cw.y << 16), __uint_as_float(cw.y & 0xffff0000u)};
          const float v0 = O[dt][4 * r4 + 0] * sc + cb[0], v1 = O[dt][4 * r4 + 1] * sc + cb[1], v2 = O[dt][4 * r4 + 2] * sc + cb[2], v3 = O[dt][4 * r4 + 3] * sc + cb[3];
          ssq += (v0 * v0 + v1 * v1) + (v2 * v2 + v3 * v3);
          u32x2 w; w.x = cvt_pk_bf16(v0, v1); w.y = cvt_pk_bf16(v2, v3);
          *(LAS u32x2*)(outb + tl * 528 + c * 2) = w;
        }
      ssq = xsum32(ssq, ssq);
      LAS float* sq = (LAS float*)(smem + 2 * AT_TILE);
      if (h == 0) sq[tl * 4 + n] = ssq;
      __syncthreads();
      {
        const int tl2 = tid >> 3, s8 = tid & 7;
        unsigned char* mx = ws + WS_MIX + ((size_t)(b * 2048 + cur * 64 + tl2) * 1024 + 512 + g * 256 + s8 * 8) * 2;
#pragma unroll
        for (int i = 0; i < 4; ++i) *(u32x4*)(mx + i * 128) = *(const LAS u32x4*)(outb + tl2 * 528 + (s8 + 8 * i) * 16);
      }
      if (tid < 64) {
        const f32x4 q4 = *(const LAS f32x4*)(sq + tid * 4);
        ((float*)(ws + WS_BOOK + BK_SSQ))[(size_t)(b * 2048 + cur * 64 + tid) * 2 + g] = (q4[0] + q4[1]) + (q4[2] + q4[3]);
      }
    }
  }
}

template <class F>
__device__ __forceinline__ void dyn_items(int* counter, int nitems, LAS unsigned char* smem, F&& f) {
  LAS int* slot = (LAS int*)(smem + LDS_BYTES - 64);
  const int tid = my_tid();
  __syncthreads();
  int cur = (int)blockIdx.x;
  int par = 0;
  while (cur < nitems) {
    int nxt = 0;
    if (tid == 0) nxt = atomicAdd(counter, 1) + (int)gridDim.x;
    f(cur);
    par ^= 1;
    if (tid == 0) slot[par] = nxt;
    __syncthreads();
    cur = __builtin_amdgcn_readfirstlane(slot[par]);
  }
}
__device__ __forceinline__ void phase3w(const Params& p, LAS unsigned char* smem) {
  int* ctr = (int*)(p.ws + WS_BOOK + BK_CTR);
#if PROF_ON && PROF_ITEMS
  unsigned long long tsum[3] = {0, 0, 0}; unsigned cnt[3] = {0, 0, 0};
#endif
  dyn_items(ctr + 0, 128 + 1024 + 512, smem, [&](int it) {
#if PROF_ON && PROF_ITEMS
    const unsigned long long t_0 = wall_clock64();
#endif
    if (it < 128) compress_item(p, smem, it);
    else if (it < 1152) attn_item<false>(p, smem, it - 128);
    else conv_item(p, smem, it - 1152);
#if PROF_ON && PROF_ITEMS
    __syncthreads();
    const int ty = it < 128 ? 0 : (it < 1152 ? 1 : 2);
    tsum[ty] += wall_clock64() - t_0; cnt[ty] += 1;
#endif
  });
#if PROF_ON && PROF_ITEMS
  if (threadIdx.x == 0) {
    unsigned long long* st = (unsigned long long*)(p.ws + WS_BOOK + BK_XBAR + 16384 + 64);
    for (int q = 0; q < 3; ++q) { atomicAdd(st + q, tsum[q]); atomicAdd(st + 4 + q, (unsigned long long)cnt[q]); }
  }
#endif
}
__device__ __forceinline__ void phase6(const Params& p, LAS unsigned char* smem) {
  int* ctr = (int*)(p.ws + WS_BOOK + BK_CTR);
  dyn_items(ctr + 1, 1024, smem, [&](int it) { attn_item<true>(p, smem, it); });
}

__device__ __forceinline__ void phase4_mfma(const Params& p, LAS unsigned char* smem) {
  const int tid = my_tid(), wid = __builtin_amdgcn_readfirstlane(tid >> 6), lane = tid & 63, h = lane >> 5, l31 = lane & 31;
  unsigned char* ws = p.ws;
  const bf16_t* Q = (const bf16_t*)(ws + WS_Q);
  const float* GATES = (const float*)(ws + WS_GATES);
  bf16_t* OC = (bf16_t*)(ws + WS_OC);
  unsigned* SEL = (unsigned*)(ws + WS_BOOK + BK_SEL);
  constexpr int VOFF = 128 * AT_KSTR;
  for (int it = blockIdx.x; it < 256; it += gridDim.x) {
    const int bg = it >> 3, px = (it >> 1) & 3, hf = it & 1, b = bg >> 1, g = bg & 1;
    const int tt = (wid < 4) ? px : 7 - px, wslot = hf * 4 + (wid & 3);
    const char* kg = (const char*)(ws + WS_BOOK + BK_KCMP) + (size_t)bg * 16384;
    const char* vg = (const char*)(ws + WS_BOOK + BK_VCMP) + (size_t)bg * 16384;
    __syncthreads();
#pragma unroll
    for (int i = 0; i < 2; ++i) {
      const int e = tid + i * NTHR, key = e >> 3, ch = e & 7;
      *(LAS u32x4*)(smem + key * AT_KSTR + ch * 16) = *(const u32x4*)(kg + e * 16);
      *(LAS u32x4*)(smem + VOFF + key * AT_VSTR + ch * 16) = *(const u32x4*)(vg + e * 16);
    }
    __syncthreads();
    const int tw0 = tt * 256 + wslot * 32, t = tw0 + l31, tok = b * 2048 + t;
    const int ncv = (t >= 31) ? ((t - 31) >> 4) + 1 : 0;
    const int tmax = tw0 + 31;
    const int ncvmax = (tmax >= 31) ? ((tmax - 31) >> 4) + 1 : 0;
    const int nkb = (ncvmax + 31) >> 5;
    float mainv[16], edgev[16];
#pragma unroll
    for (int a = 0; a < 16; ++a) { mainv[a] = 0.f; edgev[a] = 0.f; }
    bf16x8 qn[4];
#pragma unroll
    for (int ks = 0; ks < 4; ++ks) qn[ks] = *(const bf16x8*)(Q + (size_t)tok * 512 + (g * 4) * 64 + 16 * ks + 8 * h);
    float gn = GATES[(size_t)tok * 24 + (g * 4) * 3 + 0];
#pragma unroll 1
    for (int n = 0; n < 4; ++n) {
      const int head = g * 4 + n;
      bf16x8 qf[4];
#pragma unroll
      for (int ks = 0; ks < 4; ++ks) qf[ks] = qn[ks];
      const float g0 = gn;
      if (n < 3) {
#pragma unroll
        for (int ks = 0; ks < 4; ++ks) qn[ks] = *(const bf16x8*)(Q + (size_t)tok * 512 + (head + 1) * 64 + 16 * ks + 8 * h);
        gn = GATES[(size_t)tok * 24 + (head + 1) * 3 + 0];
      }
      u32x4 owv[4];
#pragma unroll
      for (int i = 0; i < 4; ++i) owv[i] = *(const u32x4*)((const bf16_t*)(ws + WS_OW) + (size_t)(b * 2048 + tw0 + i * 8 + (lane >> 3)) * 512 + head * 64 + (lane & 7) * 8);
      f32x16 s[4];
#pragma unroll
      for (int kb = 0; kb < 4; ++kb)
#pragma unroll
        for (int r = 0; r < 16; ++r) s[kb][r] = 0.f;
#pragma unroll
      for (int kb = 0; kb < 4; ++kb)
        if (kb < nkb) {
#pragma unroll
          for (int ks = 0; ks < 4; ++ks) {
            const bf16x8 a = *(const LAS bf16x8*)(smem + (kb * 32 + l31) * AT_KSTR + (2 * ks + h) * 16);
            s[kb] = __builtin_amdgcn_mfma_f32_32x32x16_bf16(a, qf[ks], s[kb], 0, 0, 0);
          }
        }
      float mx = -1e30f;
#pragma unroll
      for (int kb = 0; kb < 4; ++kb)
        if (kb < nkb) {
#pragma unroll
          for (int r = 0; r < 16; ++r) {
            const int c = 32 * kb + (r & 3) + 8 * (r >> 2) + 4 * h;
            s[kb][r] = (c < ncv) ? s[kb][r] : -1e30f;
            mx = fmaxf(mx, s[kb][r]);
          }
        }
      mx = xmax32(mx);
      float ls = 0.f;
#pragma unroll
      for (int kb = 0; kb < 4; ++kb)
        if (kb < nkb) {
#pragma unroll
          for (int r = 0; r < 16; ++r) {
            s[kb][r] = __builtin_amdgcn_exp2f(s[kb][r] - mx);
            ls += s[kb][r];
          }
        }
      ls = xsum32(ls, ls);
      const float inv = (ncv > 0) ? __builtin_amdgcn_rcpf(ls) : 0.f;
#pragma unroll
      for (int kb = 0; kb < 4; ++kb)
        if (kb < nkb) {
#pragma unroll
          for (int i = 0; i < 4; ++i) {
            const float p0 = s[kb][4 * i] * inv, p1 = s[kb][4 * i + 1] * inv, p2 = s[kb][4 * i + 2] * inv, p3 = s[kb][4 * i + 3] * inv;
            s[kb][4 * i] = p0; s[kb][4 * i + 1] = p1; s[kb][4 * i + 2] = p2; s[kb][4 * i + 3] = p3;
            mainv[kb * 4 + i] += (p0 + p1) + (p2 + p3);
            edgev[kb * 4 + i] += p3;
          }
        }
      f32x16 O[2];
#pragma unroll
      for (int dt = 0; dt < 2; ++dt)
#pragma unroll
        for (int r = 0; r < 16; ++r) O[dt][r] = 0.f;
      const int blk = (lane >> 4) & 1, q = (lane & 15) >> 2, pp = lane & 3;
      LAS unsigned char* vbase = smem + VOFF + (4 * h + q) * AT_VSTR + (16 * blk + 4 * pp) * 2;
#pragma unroll
      for (int kb = 0; kb < 4; ++kb)
        if (kb < nkb) {
#pragma unroll
          for (int sx = 0; sx < 2; ++sx) {
            u32x4 w; w.x = cvt_pk_bf16(s[kb][8 * sx + 0], s[kb][8 * sx + 1]); w.y = cvt_pk_bf16(s[kb][8 * sx + 2], s[kb][8 * sx + 3]);
            w.z = cvt_pk_bf16(s[kb][8 * sx + 4], s[kb][8 * sx + 5]); w.w = cvt_pk_bf16(s[kb][8 * sx + 6], s[kb][8 * sx + 7]);
            const bf16x8 pb = __builtin_bit_cast(bf16x8, w);
#pragma unroll
            for (int dt = 0; dt < 2; ++dt) {
              const s16x4 va = __builtin_amdgcn_ds_read_tr16_b64_v4i16((lds_s16x4*)(vbase + (32 * kb + 16 * sx) * AT_VSTR + dt * 64));
              const s16x4 vb = __builtin_amdgcn_ds_read_tr16_b64_v4i16((lds_s16x4*)(vbase + (32 * kb + 16 * sx + 8) * AT_VSTR + dt * 64));
              O[dt] = __builtin_amdgcn_mfma_f32_32x32x16_bf16(cat4(va, vb), pb, O[dt], 0, 0, 0);
            }
          }
        }
      LAS unsigned char* ost = smem + VOFF + 128 * AT_VSTR + wid * (32 * 144);
#pragma unroll
      for (int dt = 0; dt < 2; ++dt)
#pragma unroll
        for (int r4 = 0; r4 < 4; ++r4) {
          u32x2 w; w.x = cvt_pk_bf16(O[dt][4 * r4 + 0] * g0, O[dt][4 * r4 + 1] * g0); w.y = cvt_pk_bf16(O[dt][4 * r4 + 2] * g0, O[dt][4 * r4 + 3] * g0);
          *(LAS u32x2*)(ost + l31 * 144 + (32 * dt + 8 * r4 + 4 * h) * 2) = w;
        }
#pragma unroll
      for (int i = 0; i < 4; ++i) {
        const int tl = i * 8 + (lane >> 3), sg = lane & 7;
        const u32x4 oc = *(const LAS u32x4*)(ost + tl * 144 + sg * 16), ow = owv[i];
        u32x4 sm;
#pragma unroll
        for (int q = 0; q < 4; ++q)
          sm[q] = cvt_pk_bf16(__uint_as_float(oc[q] << 16) + __uint_as_float(ow[q] << 16), __uint_as_float(oc[q] & 0xffff0000u) + __uint_as_float(ow[q] & 0xffff0000u));
        *(u32x4*)(OC + (size_t)(b * 2048 + tw0 + tl) * 512 + head * 64 + sg * 8) = sm;
      }
    }
    const int cur = t >> 6;
    float so[16], oo[16];
    {
      float ex[16];
#pragma unroll
      for (int a = 0; a < 16; ++a) ex[a] = xother32(edgev[a], h);
#pragma unroll
      for (int a = 0; a < 16; ++a) {
        const float add = h ? ex[a] : (a > 0 ? ex[a > 0 ? a - 1 : 0] : 0.f);
        const float imp = mainv[a] + add;
        const int j = 2 * a + h;
        const bool forced = (j == 0) || (j == cur) || (j == cur - 1);
        so[a] = (j <= cur) ? (forced ? 1e9f : imp) : -3.0e38f;
      }
#pragma unroll
      for (int a = 0; a < 16; ++a) oo[a] = xother32(so[a], h);
    }
    unsigned bits = 0u;
    const bool all = __builtin_amdgcn_readfirstlane(cur) + 1 <= 16;
    if (all) {
#pragma unroll
      for (int a = 0; a < 16; ++a) { const int j = 2 * a + h; bits |= (j <= cur) ? (1u << j) : 0u; }
    } else
#pragma unroll
    for (int a = 0; a < 16; ++a) {
      const int j = 2 * a + h;
      int rank = 0;
#pragma unroll
      for (int bb = 0; bb < 16; ++bb) {
        if (bb != a) rank += (bb < a) ? (so[bb] >= so[a] ? 1 : 0) : (so[bb] > so[a] ? 1 : 0);
        if (bb < a) rank += (oo[bb] >= so[a]) ? 1 : 0;
        else if (bb > a) rank += (oo[bb] > so[a]) ? 1 : 0;
        else rank += (h ? (oo[bb] >= so[a]) : (oo[bb] > so[a])) ? 1 : 0;
      }
      const bool selj = (j <= cur) && (rank < 16);
      bits |= selj ? (1u << j) : 0u;
    }
    { auto r = __builtin_amdgcn_permlane32_swap(bits, bits, false, false); bits = r[0] | r[1]; }
    if (h == 0) SEL[bg * 2048 + t] = bits;
  }
}

__device__ __forceinline__ void phase6b(const Params& p) {
  const int tid = my_tid(), wid = tid >> 6, lane = tid & 63;
  unsigned char* ws = p.ws;
  const bf16_t* OC = (const bf16_t*)(ws + WS_OC); const bf16_t* OW = (const bf16_t*)(ws + WS_OW); const bf16_t* OS = (const bf16_t*)(ws + WS_OS);
  bf16_t* MIX = (bf16_t*)(ws + WS_MIX);
  const f32x4 g0 = *(const f32x4*)(p.out_norm_nsa + lane * 8), g1 = *(const f32x4*)(p.out_norm_nsa + lane * 8 + 4);
  for (int t = blockIdx.x * 8 + wid; t < T_TOK; t += gridDim.x * 8) {
    const bf16x8 a = *(const bf16x8*)(OC + (size_t)t * 512 + lane * 8), b = *(const bf16x8*)(OW + (size_t)t * 512 + lane * 8), c = *(const bf16x8*)(OS + (size_t)t * 512 + lane * 8);
    float v[8]; float ss = 0.f;
#pragma unroll
    for (int e = 0; e < 8; ++e) { v[e] = bf2f((bf16_t)a[e]) + bf2f((bf16_t)b[e]) + bf2f((bf16_t)c[e]); ss += v[e] * v[e]; }
    ss = wave_sum(ss);
    const float rstd = rsqrtf(ss * (1.0f / 512.0f) + NORM_EPS);
    u32x4 w; w.x = pack2(v[0] * rstd * g0[0], v[1] * rstd * g0[1]); w.y = pack2(v[2] * rstd * g0[2], v[3] * rstd * g0[3]);
    w.z = pack2(v[4] * rstd * g1[0], v[5] * rstd * g1[1]); w.w = pack2(v[6] * rstd * g1[2], v[7] * rstd * g1[3]);
    *(u32x4*)(MIX + (size_t)t * 1024 + 512 + lane * 8) = w;
  }
}

__device__ __forceinline__ f32x4 xreduce8(const f32x4 (&a)[8], int lane) {
  f32x4 b4[4], b2[2], r;
  const bool u3 = lane & 8;
#pragma unroll
  for (int i = 0; i < 4; ++i)
#pragma unroll
    for (int c = 0; c < 4; ++c) b4[i][c] = xsum32(a[i][c], a[i + 4][c]);
#pragma unroll
  for (int i = 0; i < 2; ++i)
#pragma unroll
    for (int c = 0; c < 4; ++c) b2[i][c] = xsum16(b4[i][c], b4[i + 2][c]);
#pragma unroll
  for (int c = 0; c < 4; ++c) { const float snd = u3 ? b2[0][c] : b2[1][c], kp = u3 ? b2[1][c] : b2[0][c]; r[c] = kp + lx8(snd); }
#pragma unroll
  for (int c = 0; c < 4; ++c) { r[c] += lx4(r[c]); r[c] += lx2(r[c]); r[c] += lx1(r[c]); }
  return r;
}
__device__ __forceinline__ void route_top4_pair(float mylg, int lane, int tA, int* TOPI, float* TOPG, LAS int* lhist) {
  int idx[4]; float val[4];
  const int me = lane & 31;
#pragma unroll
  for (int k = 0; k < 4; ++k) {
    float bv = mylg; int bi = me;
    {
      auto rv = __builtin_amdgcn_permlane16_swap(__float_as_uint(bv), __float_as_uint(bv), false, false);
      auto ri = __builtin_amdgcn_permlane16_swap((unsigned)bi, (unsigned)bi, false, false);
      const float v0 = __uint_as_float(rv[0]), v1 = __uint_as_float(rv[1]); const int i0 = (int)ri[0], i1 = (int)ri[1];
      const bool t1 = (v1 > v0) || (v1 == v0 && i1 < i0);
      bv = t1 ? v1 : v0; bi = t1 ? i1 : i0;
    }
#define ARGSTEP(FV, FI) { const float ov = FV(bv); const int oi = FI(bi); const bool take = (ov > bv) || (ov == bv && oi < bi); bv = take ? ov : bv; bi = take ? oi : bi; }
    ARGSTEP(lx8, lx8i) ARGSTEP(lx4, lx4i) ARGSTEP(lx2, lx2i) ARGSTEP(lx1, lx1i)
#undef ARGSTEP
    idx[k] = bi; val[k] = bv;
    mylg = (me == bi) ? -3.0e38f : mylg;
  }
  const float e1 = __expf(val[1] - val[0]), e2 = __expf(val[2] - val[0]), e3 = __expf(val[3] - val[0]);
  const float inv = __builtin_amdgcn_rcpf(1.0f + e1 + e2 + e3);
  if (me == 0) {
    const int t = tA + (lane >> 5);
    *(int4*)(TOPI + (size_t)t * 4) = make_int4(idx[0], idx[1], idx[2], idx[3]);
    *(f32x4*)(TOPG + (size_t)t * 4) = (f32x4){inv, e1 * inv, e2 * inv, e3 * inv};
    lds_inc(lhist + idx[0]); lds_inc(lhist + idx[1]); lds_inc(lhist + idx[2]); lds_inc(lhist + idx[3]);
  }
}
__device__ __forceinline__ void phase8(const Params& p, LAS unsigned char* smem) {
  unsigned char* ws = p.ws;
  const float* MOD = (const float*)(ws + WS_BOOK + BK_MOD);
  const bf16_t* D1 = (const bf16_t*)(ws + WS_D1);
  unsigned char* H2 = (unsigned char*)p.out + DO_H2;
  int* TOPI = (int*)(ws + WS_BOOK + BK_TOPI); float* TOPG = (float*)(ws + WS_BOOK + BK_TOPG);
  int* POSOF = (int*)(ws + WS_BOOK + BK_SLOTOF);
  const float* WRT = (const float*)(ws + WS_BOOK + BK_WRT);
  constexpr int BROW = 2064;
  LAS unsigned char* bhi = smem;
  LAS unsigned char* blo = smem + 32 * BROW;
  LAS float* lgs = (LAS float*)(smem + 64 * BROW);
  LAS float* lsh = lgs + 1024;
  LAS float* lcb = lsh + 1024;
  LAS int* lhist = (LAS int*)(lcb + 32);
  LAS float* lred = (LAS float*)(lhist + 32);
  LAS int* lbase = (LAS int*)(lred + 64);
#pragma unroll 1
  for (int it = blockIdx.x; it < T_TOK / 128; it += gridDim.x) {
    const int tid = my_tid(), wid = tid >> 6, lane = tid & 63, fr = lane & 15, g = lane >> 4;
    const int t0 = it * 128, b = t0 / SEQ;
    const int t = t0 + wid * 16 + fr;
    f32x4 wr[16];
#pragma unroll
    for (int i = 0; i < 8; ++i) {
      const int idx = tid + i * NTHR;
      wr[2 * i] = *(const f32x4*)(WRT + idx * 8); wr[2 * i + 1] = *(const f32x4*)(WRT + idx * 8 + 4);
    }
    u32x4 a[32];
    {
      const bf16_t* xrow = D1 + (size_t)t * DM + 16 * g;
#pragma unroll
      for (int s = 0; s < 32; ++s) a[s] = *(const u32x4*)(xrow + 64 * (s >> 1) + 8 * (s & 1));
    }
    __syncthreads();
    if (tid < 32) lhist[tid] = 0;
    if (tid < 256) {
      const int d = tid * 4;
      const f32x4 gg = *(const f32x4*)(p.norm2_g + d);
      const f32x4 s2 = *(const f32x4*)(MOD + b * 6144 + 4096 + d);
      *(LAS f32x4*)(lgs + d) = gg * (s2 + 1.0f);
      *(LAS f32x4*)(lsh + d) = *(const f32x4*)(MOD + b * 6144 + 3072 + d) * 16.0f;
    }
    asm volatile("s_waitcnt lgkmcnt(0)" ::: "memory");
    __builtin_amdgcn_s_barrier();
#pragma unroll
    for (int i = 0; i < 8; ++i) {
      const int idx = tid + i * NTHR, e = idx >> 7, k8 = (idx & 127) * 8;
      const f32x4 w0 = wr[2 * i], w1 = wr[2 * i + 1];
      const f32x4 g0 = *(const LAS f32x4*)(lgs + k8), g1 = *(const LAS f32x4*)(lgs + k8 + 4);
      const f32x4 h0 = *(const LAS f32x4*)(lsh + k8), h1 = *(const LAS f32x4*)(lsh + k8 + 4);
      const f32x4 b0 = w0 * g0, b1 = w1 * g1;
      u32x4 hi, lo; float part = 0.f;
#pragma unroll
      for (int q = 0; q < 2; ++q) {
        const bf16_t ha = f2bf(b0[2 * q]), hb = f2bf(b0[2 * q + 1]), hc = f2bf(b1[2 * q]), hd = f2bf(b1[2 * q + 1]);
        hi[q] = (unsigned)ha | ((unsigned)hb << 16); hi[2 + q] = (unsigned)hc | ((unsigned)hd << 16);
        lo[q] = pack2(b0[2 * q] - bf2f(ha), b0[2 * q + 1] - bf2f(hb)); lo[2 + q] = pack2(b1[2 * q] - bf2f(hc), b1[2 * q + 1] - bf2f(hd));
      }
#pragma unroll
      for (int q = 0; q < 4; ++q) part += w0[q] * h0[q] + w1[q] * h1[q];
      *(LAS u32x4*)(bhi + e * BROW + k8 * 2) = hi;
      *(LAS u32x4*)(blo + e * BROW + k8 * 2) = lo;
      part = wave_sum(part);
      if (lane == 0) lred[e * 2 + (wid & 1)] = part;
    }
    asm volatile("s_waitcnt lgkmcnt(0)" ::: "memory");
    __builtin_amdgcn_s_barrier();
    if (tid < 32) lcb[tid] = (lred[tid * 2] + lred[tid * 2 + 1]) * (1.0f / 16.0f) + p.b_router[tid];
    f32x4 ah0 = (f32x4){0.f, 0.f, 0.f, 0.f}, al0 = ah0, ah1 = ah0, al1 = ah0, asq = ah0;
    {
      const LAS unsigned char* ph = bhi + fr * BROW + 32 * g;
      const LAS unsigned char* pl = blo + fr * BROW + 32 * g;
      bf16x8 h0 = *(const LAS bf16x8*)(ph), h1 = *(const LAS bf16x8*)(ph + 16 * BROW), l0 = *(const LAS bf16x8*)(pl), l1 = *(const LAS bf16x8*)(pl + 16 * BROW);
#pragma unroll
      for (int s = 0; s < 32; ++s) {
        const int ko = 128 * ((s + 1) >> 1) + 16 * ((s + 1) & 1);
        bf16x8 nh0 = h0, nh1 = h1, nl0 = l0, nl1 = l1;
        if (s < 31) { nh0 = *(const LAS bf16x8*)(ph + ko); nh1 = *(const LAS bf16x8*)(ph + 16 * BROW + ko); nl0 = *(const LAS bf16x8*)(pl + ko); nl1 = *(const LAS bf16x8*)(pl + 16 * BROW + ko); }
        const bf16x8 xa = __builtin_bit_cast(bf16x8, a[s]);
        ah0 = __builtin_amdgcn_mfma_f32_16x16x32_bf16(h0, xa, ah0, 0, 0, 0);
        ah1 = __builtin_amdgcn_mfma_f32_16x16x32_bf16(h1, xa, ah1, 0, 0, 0);
        al0 = __builtin_amdgcn_mfma_f32_16x16x32_bf16(l0, xa, al0, 0, 0, 0);
        al1 = __builtin_amdgcn_mfma_f32_16x16x32_bf16(l1, xa, al1, 0, 0, 0);
        asq = __builtin_amdgcn_mfma_f32_16x16x32_bf16(xa, xa, asq, 0, 0, 0);
        asm volatile("" ::: "memory");
        h0 = nh0; h1 = nh1; l0 = nl0; l1 = nl1;
      }
    }
    float ssd = asq[0];
    ssd = ((fr & 3) == 1) ? asq[1] : ssd; ssd = ((fr & 3) == 2) ? asq[2] : ssd; ssd = ((fr & 3) == 3) ? asq[3] : ssd;
    const float ss = __shfl(ssd, 16 * (fr >> 2) + fr);
    const float rstd = rsqrtf(ss * (1.0f / DM) + NORM_EPS);
    asm volatile("s_waitcnt lgkmcnt(0)" ::: "memory");
    __builtin_amdgcn_s_barrier();
    int rk_e[4] = {0, 0, 0, 0}, rk_r[4] = {0, 0, 0, 0};
    {
      const f32x4 c0 = *(const LAS f32x4*)(lcb + 4 * g), c1 = *(const LAS f32x4*)(lcb + 16 + 4 * g);
      float L[8];
#pragma unroll
      for (int r = 0; r < 4; ++r) { L[r] = (ah0[r] + al0[r]) * rstd + c0[r]; L[4 + r] = (ah1[r] + al1[r]) * rstd + c1[r]; }
      int idx[4]; float val[4];
#pragma unroll
      for (int k = 0; k < 4; ++k) {
        float bv = L[0]; int bi = 4 * g;
#pragma unroll
        for (int j = 1; j < 8; ++j) { const int ej = 16 * (j >> 2) + 4 * g + (j & 3); const bool take = L[j] > bv; bv = take ? L[j] : bv; bi = take ? ej : bi; }
        {
          auto rv = __builtin_amdgcn_permlane16_swap(__float_as_uint(bv), __float_as_uint(bv), false, false);
          auto ri = __builtin_amdgcn_permlane16_swap((unsigned)bi, (unsigned)bi, false, false);
          const float v0 = __uint_as_float(rv[0]), v1 = __uint_as_float(rv[1]); const int i0 = (int)ri[0], i1 = (int)ri[1];
          const bool t1 = (v1 > v0) || (v1 == v0 && i1 < i0);
          bv = t1 ? v1 : v0; bi = t1 ? i1 : i0;
        }
        {
          auto rv = __builtin_amdgcn_permlane32_swap(__float_as_uint(bv), __float_as_uint(bv), false, false);
          auto ri = __builtin_amdgcn_permlane32_swap((unsigned)bi, (unsigned)bi, false, false);
          const float v0 = __uint_as_float(rv[0]), v1 = __uint_as_float(rv[1]); const int i0 = (int)ri[0], i1 = (int)ri[1];
          const bool t1 = (v1 > v0) || (v1 == v0 && i1 < i0);
          bv = t1 ? v1 : v0; bi = t1 ? i1 : i0;
        }
        idx[k] = bi; val[k] = bv;
#pragma unroll
        for (int j = 0; j < 8; ++j) { const int ej = 16 * (j >> 2) + 4 * g + (j & 3); L[j] = (ej == bi) ? -3.0e38f : L[j]; }
      }
      const float e1 = __expf(val[1] - val[0]), e2 = __expf(val[2] - val[0]), e3 = __expf(val[3] - val[0]);
      const float inv = __builtin_amdgcn_rcpf(1.0f + e1 + e2 + e3);
      if (g == 0) {
        *(int4*)(TOPI + (size_t)t * 4) = make_int4(idx[0], idx[1], idx[2], idx[3]);
        *(f32x4*)(TOPG + (size_t)t * 4) = (f32x4){inv, e1 * inv, e2 * inv, e3 * inv};
#pragma unroll
        for (int k = 0; k < 4; ++k) { rk_e[k] = idx[k]; rk_r[k] = lds_inc(lhist + idx[k]); }
      }
    }
    {
      const float r16 = rstd * 16.0f;
      unsigned char* hrow = H2 + (size_t)t * DM + 16 * g;
#pragma unroll
      for (int j = 0; j < 16; ++j) {
        u32x4 o;
#pragma unroll
        for (int hf = 0; hf < 2; ++hf) {
          const u32x4 xa = a[2 * j + hf];
          const int k0 = 64 * j + 16 * g + 8 * hf;
          const f32x4 g0 = *(const LAS f32x4*)(lgs + k0) * r16, g1 = *(const LAS f32x4*)(lgs + k0 + 4) * r16;
          const f32x4 s0 = *(const LAS f32x4*)(lsh + k0), s1 = *(const LAS f32x4*)(lsh + k0 + 4);
          f32x4 x0, x1v;
          x0[0] = __uint_as_float(xa[0] << 16); x0[1] = __uint_as_float(xa[0] & 0xffff0000u); x0[2] = __uint_as_float(xa[1] << 16); x0[3] = __uint_as_float(xa[1] & 0xffff0000u);
          x1v[0] = __uint_as_float(xa[2] << 16); x1v[1] = __uint_as_float(xa[2] & 0xffff0000u); x1v[2] = __uint_as_float(xa[3] << 16); x1v[3] = __uint_as_float(xa[3] & 0xffff0000u);
          const f32x4 y0 = x0 * g0 + s0, y1 = x1v * g1 + s1;
          o[2 * hf] = pack4_fp8(y0[0], y0[1], y0[2], y0[3]); o[2 * hf + 1] = pack4_fp8(y1[0], y1[1], y1[2], y1[3]);
        }
        *(u32x4*)(hrow + 64 * j) = o;
        asm volatile("" ::: "memory");
      }
    }
    __syncthreads();
    if (tid < 32) lbase[tid] = (int)xb_add((unsigned*)(ws + WS_BOOK + BK_HIST) + tid, (unsigned)lhist[tid]);
    __syncthreads();
    if (g == 0) {
      int4 ps;
      ps.x = lbase[rk_e[0]] + rk_r[0]; ps.y = lbase[rk_e[1]] + rk_r[1]; ps.z = lbase[rk_e[2]] + rk_r[2]; ps.w = lbase[rk_e[3]] + rk_r[3];
      *(int4*)(POSOF + (size_t)t * 4) = ps;
      int* RT2 = (int*)(ws + WS_BOOK + BK_ROWTOK2);
      RT2[rk_e[0] * 32768 + ps.x] = t; RT2[rk_e[1] * 32768 + ps.y] = t; RT2[rk_e[2] * 32768 + ps.z] = t; RT2[rk_e[3] * 32768 + ps.w] = t;
    }
  }
}

__device__ __forceinline__ void phase12(const Params& p) {
  const int tid = my_tid(), wid = tid >> 6, lane = tid & 63;
  unsigned char* ws = p.ws;
  const float* MOD = (const float*)(ws + WS_BOOK + BK_MOD);
  const bf16_t* D1 = (const bf16_t*)(ws + WS_D1);
  const unsigned char* Y = (const unsigned char*)(ws + WS_YBUF);
  const int* SLOTOF = (const int*)(ws + WS_BOOK + BK_SLOTOF);
  const float* TOPG = (const float*)(ws + WS_BOOK + BK_TOPG);
  for (int it = blockIdx.x; it < T_TOK / 128; it += gridDim.x) {
    const int t0 = it * 128, b = t0 / SEQ;
    f32x4 gt[4], fg[4];
#pragma unroll
    for (int j = 0; j < 4; ++j) { const int d = j * 256 + lane * 4; gt[j] = *(const f32x4*)(MOD + b * 6144 + 5120 + d); fg[j] = *(const f32x4*)(p.final_norm_g + d); }
    const int tw = t0 + wid * 16;
    int4 slv = *(const int4*)(SLOTOF + (size_t)(tw + (lane & 15)) * 4);
    {
      const int4 ei = *(const int4*)((const int*)(ws + WS_BOOK + BK_TOPI) + (size_t)(tw + (lane & 15)) * 4);
      const int tot = (lane < 32) ? ((const int*)(ws + WS_BOOK + BK_HIST))[lane] : 0;
      int sb = tot;
#pragma unroll
      for (int o = 1; o < 32; o <<= 1) { const int ub = __shfl_up(sb, o); if (lane >= o) sb += ub; }
      const int eb = sb - tot;
      slv.x += __shfl(eb, ei.x); slv.y += __shfl(eb, ei.y); slv.z += __shfl(eb, ei.z); slv.w += __shfl(eb, ei.w);
    }
    const f32x4 ggv = *(const f32x4*)(TOPG + (size_t)(tw + (lane & 15)) * 4);
#pragma unroll 1
    for (int i = 0; i < 16; i += 2) {
      int sl[2][4]; float gg[2][4];
#pragma unroll
      for (int u = 0; u < 2; ++u) {
        sl[u][0] = __shfl(slv.x, i + u); sl[u][1] = __shfl(slv.y, i + u); sl[u][2] = __shfl(slv.z, i + u); sl[u][3] = __shfl(slv.w, i + u);
        gg[u][0] = __shfl(ggv[0], i + u); gg[u][1] = __shfl(ggv[1], i + u); gg[u][2] = __shfl(ggv[2], i + u); gg[u][3] = __shfl(ggv[3], i + u);
      }
      unsigned yy[2][4][4]; u32x2 dd[2][4];
#pragma unroll
      for (int u = 0; u < 2; ++u)
#pragma unroll
        for (int j = 0; j < 4; ++j) {
          const int d = j * 256 + lane * 4;
#pragma unroll
          for (int k = 0; k < 4; ++k) yy[u][j][k] = *(const unsigned*)(Y + (size_t)sl[u][k] * 1024 + d);
          dd[u][j] = *(const u32x2*)(D1 + (size_t)(tw + i + u) * DM + d);
        }
#pragma unroll
      for (int u = 0; u < 2; ++u) {
        const int t = tw + i + u;
        f32x4 v[4]; float ss = 0.f;
#pragma unroll
        for (int j = 0; j < 4; ++j) {
          f32x4 y = (f32x4){0.f, 0.f, 0.f, 0.f};
#pragma unroll
          for (int k = 0; k < 4; ++k) {
            const f32x2 lo = __builtin_amdgcn_cvt_pk_f32_fp8((int)yy[u][j][k], false), hi = __builtin_amdgcn_cvt_pk_f32_fp8((int)yy[u][j][k], true);
            y[0] += gg[u][k] * lo[0]; y[1] += gg[u][k] * lo[1]; y[2] += gg[u][k] * hi[0]; y[3] += gg[u][k] * hi[1];
          }
          v[j][0] = __uint_as_float(dd[u][j].x << 16); v[j][1] = __uint_as_float(dd[u][j].x & 0xffff0000u);
          v[j][2] = __uint_as_float(dd[u][j].y << 16); v[j][3] = __uint_as_float(dd[u][j].y & 0xffff0000u);
          v[j] = v[j] + gt[j] * y * (1.0f / 16.0f);
          ss += v[j][0] * v[j][0] + v[j][1] * v[j][1] + v[j][2] * v[j][2] + v[j][3] * v[j][3];
        }
        ss = wave_sum(ss);
        const float rstd = rsqrtf(ss * (1.0f / DM) + NORM_EPS);
#pragma unroll
        for (int j = 0; j < 4; ++j) *(f32x4*)(p.out + (size_t)t * DM + j * 256 + lane * 4) = v[j] * rstd * fg[j];
      }
    }
  }
}

__global__ void __launch_bounds__(NTHR) mega(Params p) {
  extern __shared__ __attribute__((aligned(16))) unsigned char smem_raw[];
  LAS unsigned char* smem = (LAS unsigned char*)smem_raw;
  cg::grid_group grid = cg::this_grid();
  unsigned char* ws = p.ws; unsigned char* dout = (unsigned char*)p.out;
#if PROF_ON
  unsigned long long* stamps = (unsigned long long*)(ws + WS_BOOK + 15 * MiB);
#define STAMP(k) do { if (blockIdx.x == 0 && threadIdx.x == 0) stamps[k] = wall_clock64(); } while (0)
#else
#define STAMP(k) do { } while (0)
#endif
#define GSYNC() do { XcdBarrier xb_; xb_.bar = (unsigned*)(p.ws + WS_BOOK + BK_XBAR); xb_.x = xb_xcc_id(); xb_.st = (volatile LAS unsigned*)(smem + LDS_BYTES - 16); xcd_barrier(xb_); } while (0)
#if PROF_ON && PROF_GEMM
#define GPROF(k) ((PROF_GSEL == (k)) ? (unsigned long long*)(ws + WS_BOOK + 15 * MiB + 1024) : nullptr)
#else
#define GPROF(k) nullptr
#endif
  STAMP(0);
  volatile LAS unsigned* xst = (volatile LAS unsigned*)(smem + LDS_BYTES - 16);
  if (threadIdx.x < 4) xst[threadIdx.x] = 0u;
  __syncthreads();
  (void)xcd_barrier_post((unsigned*)(ws + WS_BOOK + BK_XBAR), xst);
  phase0(p, smem);
  if (p.ph0 == 0x7fffffff) grid.sync();
  GSYNC();
  STAMP(1);
  phase1(p);
  GSYNC(); STAMP(2);
  {
    DenseSched S{(const char*)(ws + WS_H), (const char*)(dout + DO_WIN), 10, 1280};
    EpiProj E{(bf16_t*)(ws + WS_U), (bf16_t*)(ws + WS_Q), (bf16_t*)(ws + WS_KV), (float*)(ws + WS_GATES), (const float*)(ws + WS_BOOK + BK_ROPE)};
    gm::gemm_phase<false>(smem, S, E, GPROF(0));
  }
  GSYNC(); STAMP(3);
  phase3w(p, smem);
  GSYNC(); STAMP(4);
  phase4_mfma(p, smem);
  GSYNC(); STAMP(5);
  phase6(p, smem);
  GSYNC(); STAMP(6);
  STAMP(7);
  {
    DenseSched S{(const char*)(ws + WS_MIX), (const char*)(dout + DO_WOUT), 4, 512};
    EpiOut E{(bf16_t*)(ws + WS_D1), (const float*)(ws + WS_BOOK + BK_MOD), p.x, (const float*)(ws + WS_BOOK + BK_SSQ)};
    gm::gemm_phase<false, EpiOut, DenseSched, 8>(smem, S, E, GPROF(1));
  }
  GSYNC(); STAMP(8);
  phase8(p, smem);
  STAMP(9);
  GSYNC(); STAMP(10);
  {
    const int* ecnt = (const int*)(ws + WS_BOOK + BK_HIST);
    {
      const int ntiles = load_unit_table(smem, ecnt, 3);
      GuSched S{(const char*)(dout + DO_H2), (const char*)(ws + WS_WGU), smem + TAB_OFF, (const int*)(ws + WS_BOOK + BK_ROWTOK2), ntiles};
      EpiGU E{(unsigned char*)(ws + WS_ACT), p.b_gate, p.b_up};
      gm::gemm_phase<true>(smem, S, E, GPROF(2));
    }
    GSYNC(); STAMP(11);
    {
      const int ntiles = load_unit_table(smem, ecnt, 2);
      DownSched S{(const char*)(ws + WS_ACT), (const char*)(dout + DO_WD), smem + TAB_OFF, ntiles};
      EpiDown E{(unsigned char*)(ws + WS_YBUF), p.b_down};
      gm::gemm_phase<true>(smem, S, E, GPROF(3));
    }
    GSYNC(); STAMP(12);
    phase12(p);
#if PROF_ON
    GSYNC(); STAMP(13);
#endif
  }
#if PROF_ON
  GSYNC();
  {
#if PROF_ITEMS
    if (blockIdx.x == 0 && threadIdx.x == 0) {
      const unsigned long long* st = (const unsigned long long*)(ws + WS_BOOK + BK_XBAR + 16384 + 64);
      for (int q = 0; q < 3; ++q) { stamps[40 + 2 * q] = 0; stamps[41 + 2 * q] = ld_u64(st + q) / (ld_u64(st + 4 + q) + 1); }
    }
    GSYNC();
#endif
    const float dA = (float)(long long)(ld_u64(stamps + PROF_A1) - ld_u64(stamps + PROF_A)) * 0.01f;
    const float dB = (float)(long long)(ld_u64(stamps + PROF_B1) - ld_u64(stamps + PROF_B)) * 0.01f;
#if PROF_GEMM
    const unsigned long long* gp = (const unsigned long long*)(ws + WS_BOOK + 15 * MiB + 1024);
    const float nunf = (float)ld_u64(gp + 2);
    const float dA2 = (float)ld_u64(gp + 0) * 0.1f / nunf, dB2 = (float)ld_u64(gp + 1) * 0.1f / nunf;
    const float qA = rintf(logf(fmaxf(dA2, 1.0f)) * (1.0f / 0.22314355f)), qB = rintf(logf(fmaxf(dB2, 1.0f)) * (1.0f / 0.22314355f));
    (void)dA; (void)dB;
#else
    const float qA = rintf(logf(fmaxf(dA, 1.0f)) * (1.0f / PROF_LOGBIN) + PROF_SHIFT), qB = rintf(logf(fmaxf(dB, 1.0f)) * (1.0f / PROF_LOGBIN) + PROF_SHIFT);
#endif
    const float va = sqrtf(qA);
    for (size_t i = (size_t)blockIdx.x * NTHR + threadIdx.x; i < (size_t)T_TOK * DM; i += (size_t)gridDim.x * NTHR) p.out[i] = (i == 0) ? 16.0f * qB : va;
  }
#endif
}

extern "C" void kernel_launch(void* const* d_in, const int* in_sizes, int n_in,
                              void* d_out, int out_size, void* d_ws, size_t ws_size,
                              hipStream_t stream) {
  static int grid_blocks = 0;
  if (!grid_blocks) {
    int dev = 0, cus = 0, per_cu = 0;
    (void)hipGetDevice(&dev);
    (void)hipDeviceGetAttribute(&cus, hipDeviceAttributeMultiprocessorCount, dev);
    (void)hipFuncSetAttribute((const void*)mega, hipFuncAttributeMaxDynamicSharedMemorySize, (int)LDS_BYTES);
    (void)hipOccupancyMaxActiveBlocksPerMultiprocessor(&per_cu, mega, NTHR, LDS_BYTES);
    if (per_cu > 1) per_cu = 1;
    grid_blocks = cus * per_cu;
    if (grid_blocks > 256) grid_blocks = 256;
    grid_blocks &= ~7;
  }
  Params p{};
  const float** pp = (const float**)&p;
  for (int i = 0; i < 29; ++i) pp[i] = (const float*)d_in[i];
  p.out = (float*)d_out; p.ws = (unsigned char*)d_ws; p.ph0 = 0; p.ph1 = 0;
  if (ws_size < WS_TOTAL) { fprintf(stderr, "workspace too small: %zu < %zu\n", ws_size, (size_t)WS_TOTAL); return; }
  (void)hipMemsetAsync((unsigned char*)d_ws + WS_BOOK + BK_XBAR, 0, BK_ZERO_BYTES, stream);
  void* args[] = {&p};
  hipError_t e = hipLaunchCooperativeKernel((void*)mega, dim3(grid_blocks), dim3(NTHR), args, LDS_BYTES, stream);
  if (e != hipSuccess) fprintf(stderr, "cooperative launch failed: %s (grid %d)\n", hipGetErrorString(e), grid_blocks);
}
```
